# Optimizing an MI355X kernel written in HIP

```python
import math
import jax, jax.numpy as jnp
from jax import lax
import numpy as np

D_MODEL = 1024
BATCH = 2
SEQ = 16384
DEPTH = 2

BLOCK = 128
WINDOW = 128
H_A = 8
KV_A = 2
G_A = H_A // KV_A
DH_A = 64
H_B = 4
DH_B = 64
N_BUCKETS = 32
MAX_EXACT = N_BUCKETS // 2
REL_MAX_DIST = 128
N_BIAS_HEADS = H_A + H_B
N_EXPERTS = 32
TOP_K = 4
D_FF = D_MODEL
SWIGLU_ALPHA = 1.702
SWIGLU_LIMIT = 7.0
MOE_BLOCK = 128
NORM_EPS = 1e-6
SUBLN_EPS = 1e-5
QA_W = H_A * DH_A
KA_W = KV_A * DH_A
VA_W = KV_A * DH_A
QB_W = H_B * 2 * DH_B
KB_W = H_B * 2 * DH_B
VB_W = H_B * 2 * DH_B
SPLIT_SIZES = (QA_W, KA_W, VA_W, QB_W, KB_W, VB_W, D_MODEL, D_MODEL)
IN_W = QA_W + KA_W + VA_W + QB_W + KB_W + VB_W + 2 * D_MODEL
MIX_W = QA_W + H_B * 2 * DH_B

kernel_name = "hybrid_swa_sink_diffattn_moe_block"


def rms_norm(x, g, eps=NORM_EPS):
    xf = x.astype(jnp.float32)
    y = xf * lax.rsqrt(jnp.mean(xf * xf, axis=-1, keepdims=True) + eps)
    return (y * g.astype(jnp.float32)).astype(x.dtype)


def t5_bucket(dist):
    n = jnp.maximum(dist, 0)
    nf = jnp.maximum(n, 1).astype(jnp.float32)
    large = MAX_EXACT + (jnp.log(nf / MAX_EXACT) / math.log(REL_MAX_DIST / MAX_EXACT)
                         * (N_BUCKETS - MAX_EXACT)).astype(jnp.int32)
    large = jnp.minimum(large, N_BUCKETS - 1)
    return jnp.where(n < MAX_EXACT, n, large)


def sliding_window_attention(q, k, v, sinks, bias_table):
    b, s = q.shape[:2]
    nb = s // BLOCK
    qb = (q * DH_A ** -0.5).reshape(b, nb, BLOCK, KV_A, G_A, DH_A)

    def band(t):
        tp = jnp.pad(t, ((0, 0), (BLOCK, 0), (0, 0), (0, 0))).reshape(b, nb + 1, BLOCK, KV_A, DH_A)
        return jnp.concatenate([tp[:, :-1], tp[:, 1:]], axis=2)

    kb, vb = band(k), band(v)
    sc = jnp.einsum('bnqhgd,bnkhd->bnhgqk', qb, kb, preferred_element_type=jnp.float32)
    qi = jnp.arange(BLOCK)[:, None]
    kj = jnp.arange(2 * BLOCK)[None, :]
    dist = qi + BLOCK - kj
    bias = bias_table[t5_bucket(dist)].astype(jnp.float32)
    bias = bias.reshape(BLOCK, 2 * BLOCK, KV_A, G_A).transpose(2, 3, 0, 1)
    key_pos = jnp.arange(nb)[:, None, None] * BLOCK - BLOCK + kj[None]
    valid = (dist >= 0) & (dist < WINDOW) & (key_pos >= 0)
    sc = jnp.where(valid[None, :, None, None], sc + bias, -jnp.inf)
    sink = sinks.astype(jnp.float32).reshape(KV_A, G_A)[:, :, None, None]
    m = jnp.maximum(jnp.max(sc, axis=-1, keepdims=True), sink)
    e = jnp.exp(sc - m)
    p = e / (jnp.sum(e, axis=-1, keepdims=True) + jnp.exp(sink - m))
    o = jnp.einsum('bnhgqk,bnkhd->bnqhgd', p.astype(v.dtype), vb)
    return o.reshape(b, s, H_A * DH_A)


def differential_attention(q, k, v, lam, subln_g, lam_init, bias_table):
    b, s = q.shape[:2]
    nb = s // BLOCK
    qb = (q * DH_B ** -0.5).reshape(b, nb, BLOCK, H_B, 2, DH_B).transpose(1, 0, 3, 4, 2, 5)
    kt = k.transpose(0, 2, 3, 1, 4)
    vt = v.transpose(0, 2, 1, 3)
    k_pos = jnp.arange(s)

    def one_block(args):
        qblk, n = args
        sc = jnp.einsum('bhmqd,bhmkd->bhmqk', qblk, kt, preferred_element_type=jnp.float32)
        dist = n * BLOCK + jnp.arange(BLOCK)[:, None] - k_pos[None, :]
        bias = bias_table[t5_bucket(dist)].astype(jnp.float32).transpose(2, 0, 1)
        sc = jnp.where(dist >= 0, sc + bias[None, :, None], -jnp.inf)
        p = jax.nn.softmax(sc, axis=-1)
        a = p[:, :, 0] - lam * p[:, :, 1]
        return jnp.einsum('bhqk,bhkd->bhqd', a.astype(vt.dtype), vt)

    o = lax.map(one_block, (qb, jnp.arange(nb)))
    o = rms_norm(o, subln_g, SUBLN_EPS) * (1.0 - lam_init)
    return o.transpose(1, 0, 3, 2, 4).reshape(b, s, H_B * 2 * DH_B)


def clamped_swiglu(gu):
    gate = jnp.minimum(gu[..., :D_FF], SWIGLU_LIMIT)
    up = jnp.clip(gu[..., D_FF:], -SWIGLU_LIMIT, SWIGLU_LIMIT)
    return gate * jax.nn.sigmoid(SWIGLU_ALPHA * gate) * (up + 1.0)


def moe_ffn(h, w_router, b_router, w_gate_up, b_gate_up, w_down, b_down):
    b, s, d = h.shape
    t = b * s
    ht = h.reshape(t, d)
    logits = (ht @ w_router + b_router).astype(jnp.float32)
    top_val, top_idx = lax.top_k(logits, TOP_K)
    top_w = jax.nn.softmax(top_val, axis=-1)
    n_slots = t * TOP_K
    flat_e = top_idx.reshape(-1)
    order = jnp.argsort(flat_e).astype(jnp.int32)
    sorted_e = flat_e[order]
    counts = jnp.bincount(flat_e, length=N_EXPERTS).astype(jnp.int32)
    padded = (counts + MOE_BLOCK - 1) // MOE_BLOCK * MOE_BLOCK
    starts = jnp.cumsum(counts) - counts
    pends = jnp.cumsum(padded)
    pstarts = pends - padded
    dest = pstarts[sorted_e] + (jnp.arange(n_slots, dtype=jnp.int32) - starts[sorted_e])
    n_rows = n_slots + N_EXPERTS * MOE_BLOCK
    n_blocks = n_rows // MOE_BLOCK
    row_slot = jnp.full((n_rows,), n_slots, jnp.int32).at[dest].set(order)
    row_tok = row_slot // TOP_K
    row_w = jnp.concatenate([top_w.reshape(-1), jnp.zeros((1,), jnp.float32)])[row_slot]
    block_e = jnp.minimum(
        jnp.searchsorted(pends, jnp.arange(n_blocks, dtype=jnp.int32) * MOE_BLOCK, side='right'),
        N_EXPERTS - 1)
    xs = jnp.concatenate([ht, jnp.zeros((1, d), ht.dtype)])[row_tok].reshape(n_blocks, MOE_BLOCK, d)

    def expert_block(args):
        xb, e = args
        gu = xb @ w_gate_up[e] + b_gate_up[e]
        return clamped_swiglu(gu) @ w_down[e] + b_down[e]

    ys = lax.map(expert_block, (xs, block_e)).reshape(n_rows, d)
    ys = ys * row_w[:, None].astype(ys.dtype)
    out = jnp.zeros((t + 1, d), ys.dtype).at[row_tok].add(ys)[:t]
    return out.reshape(b, s, d)


def setup_inputs(seed: int = 0) -> dict:
    key = jax.random.key(seed)
    ks = jax.random.split(key, 22)
    nrm = jax.random.normal
    f32 = jnp.float32
    L, D, E, F = DEPTH, D_MODEL, N_EXPERTS, D_FF
    return {
        "x": nrm(ks[0], (BATCH, SEQ, D), f32),
        "c": nrm(ks[1], (BATCH, D), f32),
        "rel_bias_table": 0.2 * nrm(ks[2], (N_BUCKETS, N_BIAS_HEADS), f32),
        "w_ada": 0.5 * D ** -0.5 * nrm(ks[3], (L, D, 6 * D), f32),
        "b_ada": 0.01 * nrm(ks[4], (L, 6 * D), f32),
        "g_mix_pre": 1.0 + 0.05 * nrm(ks[5], (L, D), f32),
        "g_mix_post": 1.0 + 0.05 * nrm(ks[6], (L, D), f32),
        "g_ffn_pre": 1.0 + 0.05 * nrm(ks[7], (L, D), f32),
        "g_ffn_post": 1.0 + 0.05 * nrm(ks[8], (L, D), f32),
        "w_in": D ** -0.5 * nrm(ks[9], (L, D, IN_W), f32),
        "w_out": MIX_W ** -0.5 * nrm(ks[10], (L, MIX_W, D), f32),
        "attn_sinks": nrm(ks[11], (L, H_A), f32),
        "diff_lambda": 0.1 * nrm(ks[12], (L, 4, DH_B), f32),
        "diff_subln_g": 1.0 + 0.05 * nrm(ks[13], (L, 2 * DH_B), f32),
        "w_router": D ** -0.5 * nrm(ks[14], (L, D, E), f32),
        "b_router": 0.01 * nrm(ks[15], (L, E), f32),
        "w_gate_up": D ** -0.5 * nrm(ks[16], (L, E, D, 2 * F), f32),
        "b_gate_up": 0.01 * nrm(ks[17], (L, E, 2 * F), f32),
        "w_down": F ** -0.5 * nrm(ks[18], (L, E, F, D), f32),
        "b_down": 0.01 * nrm(ks[19], (L, E, D), f32),
    }


def reference(x, c, rel_bias_table, w_ada, b_ada, g_mix_pre, g_mix_post, g_ffn_pre, g_ffn_post,
              w_in, w_out, attn_sinks, diff_lambda, diff_subln_g, w_router, b_router,
              w_gate_up, b_gate_up, w_down, b_down):
    b, s, _ = x.shape
    split_idx = [int(v) for v in np.cumsum(SPLIT_SIZES)[:-1]]
    bias_a = rel_bias_table[:, :H_A]
    bias_b = rel_bias_table[:, H_A:]
    c_act = jax.nn.silu(c)
    for l in range(DEPTH):
        mod = (c_act @ w_ada[l] + b_ada[l])[:, None, :]
        sh_m, sc_m, gt_m, sh_f, sc_f, gt_f = jnp.split(mod, 6, axis=-1)

        h = rms_norm(x, g_mix_pre[l]) * (1.0 + sc_m) + sh_m
        proj = h @ w_in[l]
        qa, ka, va, qb, kb, vb, gza, gzb = jnp.split(proj, split_idx, axis=-1)
        o_a = sliding_window_attention(qa.reshape(b, s, H_A, DH_A), ka.reshape(b, s, KV_A, DH_A),
                                       va.reshape(b, s, KV_A, DH_A), attn_sinks[l], bias_a)
        lam_init = 0.8 - 0.6 * math.exp(-0.3 * l)
        lp = diff_lambda[l].astype(jnp.float32)
        lam = jnp.exp(jnp.sum(lp[0] * lp[1])) - jnp.exp(jnp.sum(lp[2] * lp[3])) + lam_init
        o_b = differential_attention(qb.reshape(b, s, H_B, 2, DH_B), kb.reshape(b, s, H_B, 2, DH_B),
                                     vb.reshape(b, s, H_B, 2 * DH_B), lam, diff_subln_g[l],
                                     lam_init, bias_b)
        y = (jax.nn.sigmoid(gza) * (o_a @ w_out[l][:QA_W])
             + jax.nn.sigmoid(gzb) * (o_b @ w_out[l][QA_W:]))
        x = x + gt_m * rms_norm(y, g_mix_post[l])

        h = rms_norm(x, g_ffn_pre[l]) * (1.0 + sc_f) + sh_f
        y = moe_ffn(h, w_router[l], b_router[l], w_gate_up[l], b_gate_up[l], w_down[l], b_down[l])
        x = x + gt_f * rms_norm(y, g_ffn_post[l])
    return x
```

```cpp
#include <hip/hip_runtime.h>
#include <cstdio>
#include <cstdint>
#include <cmath>

#ifndef MK_STOP
#define MK_STOP 0
#endif

constexpr int BATCH = 2, SEQ = 16384, D = 1024, M = BATCH * SEQ, DEPTH = 2;
constexpr int INW = 4352, PITCH = INW;
constexpr int C_QA = 0, C_KA = 512, C_VA = 640, C_QB = 768, C_KB = 1280, C_VB = 1792, C_GZA = 2304, C_GZB = 3328;
constexpr int NE = 32, TOPK = 4, FF = 1024, CAP = M;
constexpr int NBH = 12, HA = 8;
constexpr float LOG2E = 1.4426950408889634f, QSCALE = 0.125f * LOG2E;
constexpr float NORM_EPS = 1e-6f, SUBLN_EPS = 1e-5f;
constexpr int ACT_ROWS = M * TOPK + NE * 256;

#define LAS __attribute__((address_space(3)))
#define GAS __attribute__((address_space(1)))
typedef unsigned short bf16_t;
typedef short bf16x8 __attribute__((ext_vector_type(8)));
typedef float f32x4 __attribute__((ext_vector_type(4)));
typedef float f32x2 __attribute__((ext_vector_type(2)));
typedef unsigned u32x4 __attribute__((ext_vector_type(4)));
typedef unsigned u32x2 __attribute__((ext_vector_type(2)));
typedef int v4i_t __attribute__((ext_vector_type(4)));
typedef int v8i_t __attribute__((ext_vector_type(8)));
constexpr float F8_SW = 128.0f, F8_SH = 16.0f, F8_SACT = 4.0f, F8_MAX = 448.0f;
__device__ __forceinline__ float f8clamp(float v) { return fminf(fmaxf(v, -F8_MAX), F8_MAX); }
__device__ __forceinline__ unsigned pk4_fp8(float a, float b, float c, float d) { unsigned w = 0u; w = __builtin_amdgcn_cvt_pk_fp8_f32(f8clamp(a), f8clamp(b), w, false); w = __builtin_amdgcn_cvt_pk_fp8_f32(f8clamp(c), f8clamp(d), w, true); return w; }

__device__ __forceinline__ unsigned cvt_pk_bf16(float lo, float hi) { unsigned r; asm volatile("v_cvt_pk_bf16_f32 %0, %1, %2" : "=v"(r) : "v"(lo), "v"(hi)); return r; }
__device__ __forceinline__ float bf_lo(unsigned w) { return __uint_as_float(w << 16); }
__device__ __forceinline__ float bf_hi(unsigned w) { return __uint_as_float(w & 0xffff0000u); }
__device__ __forceinline__ float sigmoidf_(float v) { return __builtin_amdgcn_rcpf(1.0f + __builtin_amdgcn_exp2f(-v * LOG2E)); }

namespace pg8 {
constexpr int BM = 256, BK = 64, HALF = 128, HTB = HALF * BK * 2, STAGE_BYTES = 8 * HTB, NXCD = 8, WGM = 8;
__host__ __device__ __forceinline__ int lds_byte(int r, int c) { const int st = (r >> 4) * 2 + (c >> 5), rr = r & 15, cc = c & 31, ob = rr * 64 + cc * 2; return st * 1024 + (ob ^ (((ob >> 9) & 1) << 5)); }
__host__ __device__ __forceinline__ void stage_rc(int b, int& R, int& C) { const int st = b / 1024, sb = b % 1024, swz = sb ^ (((sb >> 9) & 1) << 5); R = (st >> 1) * 16 + swz / 64; C = (st & 1) * 32 + (swz % 64) / 2; }
__host__ __device__ __forceinline__ int perm32(int rho) { const int n = rho >> 4, i = rho & 15; return 8 * (i >> 2) + 4 * n + (i & 3); }

struct Unit { int pm, pn, e, lrow, nvalid; };
struct Gemm { const bf16_t* A; const bf16_t* Bt; int K; size_t estride; const int* rows; };

struct StaticOrder {
    int nM, nN, nwg, G, c, skew;
    __device__ void init(int Mr, int N, int G_, int c_, int skew_ = 0) { nM = Mr / BM; nN = N / BM; nwg = nM * nN; G = G_; c = c_; skew = (skew_ && G_ == 256 && nwg == 1024) ? 1 : 0; }
    __device__ bool next(int i, Unit& u) const {
        long L = (long)i * G + c;
        if (skew) { if (c >= 128) { if (i >= 5) return false; L = (c - 128) + 128 * i; } else { if (i >= 3) return false; L = 640 + c + 128 * i; } }
        if (L >= nwg) return false;
        int wgid = (int)L; { const int q = nwg / NXCD, r = nwg % NXCD, xcd = wgid % NXCD, off = wgid / NXCD; wgid = (xcd < r ? xcd * (q + 1) : r * (q + 1) + (xcd - r) * q) + off; }
        const int nig = WGM * nN, gid = wgid / nig, fm = gid * WGM, gsz = (nM - fm) < WGM ? (nM - fm) : WGM;
        u.pm = fm + ((wgid % nig) % gsz); u.pn = (wgid % nig) / gsz; u.e = 0; u.lrow = 0; u.nvalid = 256; return true;
    }
};
struct MoeOrder {
    const LAS int* toff; const LAS int* cl; int nN, G, c;
    __device__ bool next(int i, Unit& u) const {
        const int ntile = toff[NE]; int gt, pn;
        if ((G & 7) == 0) { const int x = c & 7, s = c >> 3, per = G >> 3, t0 = (ntile * x) >> 3, t1 = (ntile * (x + 1)) >> 3, Lx = i * per + s;
            if (Lx >= (t1 - t0) * nN) return false;
            const int q = Lx / nN; gt = t0 + q; pn = Lx - q * nN; }
        else { const int L = i * G + c; if (L >= ntile * nN) return false; gt = L / nN; pn = L - gt * nN; }
        int e = 0;
#pragma unroll
        for (int k = 16; k >= 1; k >>= 1) if (toff[e + k] <= gt) e += k;
        const int rt = gt - toff[e]; int nv = cl[e] - rt * 256; nv = nv > 256 ? 256 : nv;
        u.pm = __builtin_amdgcn_readfirstlane(gt); u.pn = __builtin_amdgcn_readfirstlane(pn); u.e = __builtin_amdgcn_readfirstlane(e);
        u.lrow = __builtin_amdgcn_readfirstlane(e * CAP + rt * 256); u.nvalid = __builtin_amdgcn_readfirstlane(nv); return true;
    }
};

#ifndef MK_NT
#define MK_NT 1
#endif
#if MK_NT
#define NT_STORE(v, p) __builtin_nontemporal_store(v, p)
#else
#define NT_STORE(v, p) (*(p) = (v))
#endif
struct EpiBf16 {
    static constexpr bool PERM = true;
    bf16_t* O; int ldc; float sc;
    __device__ __forceinline__ void operator()(const f32x4 (&acc)[2][2][4][2], const Unit& u, int wr, int wc, int fr, int fq) const {
        const int row0 = u.pm * BM + wr * 64 + fr, col0 = u.pn * BM + wc * 32 + 8 * fq;
#pragma unroll
        for (int ai = 0; ai < 2; ++ai)
#pragma unroll
            for (int m = 0; m < 4; ++m) { bf16_t* rowp = O + (size_t)(row0 + ai * HALF + m * 16) * ldc + col0;
#pragma unroll
                for (int bj = 0; bj < 2; ++bj) { const f32x4 v0 = acc[ai][bj][m][0] * sc, v1 = acc[ai][bj][m][1] * sc;
                    u32x4 w; w.x = cvt_pk_bf16(v0[0], v0[1]); w.y = cvt_pk_bf16(v0[2], v0[3]); w.z = cvt_pk_bf16(v1[0], v1[1]); w.w = cvt_pk_bf16(v1[2], v1[3]);
                    NT_STORE(w, (u32x4*)(rowp + bj * HALF)); } }
    }
};
template <bool FIRST> struct EpiGate {
    static constexpr bool PERM = true;
    bf16_t* O; const bf16_t* prev; const bf16_t* P; int gcol;
    __device__ __forceinline__ void operator()(const f32x4 (&acc)[2][2][4][2], const Unit& u, int wr, int wc, int fr, int fq) const {
        const int row0 = u.pm * BM + wr * 64 + fr, col0 = u.pn * BM + wc * 32 + 8 * fq;
#pragma unroll
        for (int ai = 0; ai < 2; ++ai)
#pragma unroll
            for (int m = 0; m < 4; ++m) { const size_t row = (size_t)(row0 + ai * HALF + m * 16);
#pragma unroll
                for (int bj = 0; bj < 2; ++bj) { const int col = col0 + bj * HALF;
                    const u32x4 gz = *(const u32x4*)(P + row * PITCH + gcol + col);
                    const f32x4 v0 = acc[ai][bj][m][0], v1 = acc[ai][bj][m][1];
                    float o[8];
                    o[0] = v0[0] * sigmoidf_(bf_lo(gz.x)); o[1] = v0[1] * sigmoidf_(bf_hi(gz.x)); o[2] = v0[2] * sigmoidf_(bf_lo(gz.y)); o[3] = v0[3] * sigmoidf_(bf_hi(gz.y));
                    o[4] = v1[0] * sigmoidf_(bf_lo(gz.z)); o[5] = v1[1] * sigmoidf_(bf_hi(gz.z)); o[6] = v1[2] * sigmoidf_(bf_lo(gz.w)); o[7] = v1[3] * sigmoidf_(bf_hi(gz.w));
                    if (!FIRST) { const u32x4 pv = *(const u32x4*)(prev + row * D + col);
                        o[0] += bf_lo(pv.x); o[1] += bf_hi(pv.x); o[2] += bf_lo(pv.y); o[3] += bf_hi(pv.y); o[4] += bf_lo(pv.z); o[5] += bf_hi(pv.z); o[6] += bf_lo(pv.w); o[7] += bf_hi(pv.w); }
                    u32x4 w; w.x = cvt_pk_bf16(o[0], o[1]); w.y = cvt_pk_bf16(o[2], o[3]); w.z = cvt_pk_bf16(o[4], o[5]); w.w = cvt_pk_bf16(o[6], o[7]);
                    *(u32x4*)(O + row * D + col) = w; } }
    }
};
struct EpiRouter {
    static constexpr bool PERM = false;
    float* L; const float* bias;
    __device__ __forceinline__ void operator()(const f32x4 (&acc)[2][2][4][2], const Unit& u, int wr, int wc, int fr, int fq) const {
        if (wc != 0) return;
        const int row0 = u.pm * BM + wr * 64 + fr, col0 = 4 * fq;
        const f32x4 b0 = *(const f32x4*)(bias + col0), b1 = *(const f32x4*)(bias + col0 + 16);
#pragma unroll
        for (int ai = 0; ai < 2; ++ai)
#pragma unroll
            for (int m = 0; m < 4; ++m) { float* rowp = L + (size_t)(row0 + ai * HALF + m * 16) * NE + col0;
                *(f32x4*)(rowp) = acc[ai][0][m][0] + b0; *(f32x4*)(rowp + 16) = acc[ai][0][m][1] + b1; }
    }
};
struct EpiSwiglu {
    static constexpr bool PERM = true;
    bf16_t* ACT; const float* bgu;
    __device__ __forceinline__ void operator()(const f32x4 (&acc)[2][2][4][2], const Unit& u, int wr, int wc, int fr, int fq) const {
        const int row0 = u.pm * BM + wr * 64 + fr, j0 = u.pn * HALF + wc * 32 + 8 * fq;
        const float* bg = bgu + (size_t)u.e * 2 * FF + j0;
        float g_b[8], u_b[8];
        { const f32x4 a = *(const f32x4*)bg, b = *(const f32x4*)(bg + 4), c = *(const f32x4*)(bg + FF), d = *(const f32x4*)(bg + FF + 4);
#pragma unroll
          for (int i = 0; i < 4; ++i) { g_b[i] = a[i]; g_b[4 + i] = b[i]; u_b[i] = c[i]; u_b[4 + i] = d[i]; } }
#pragma unroll
        for (int ai = 0; ai < 2; ++ai)
#pragma unroll
            for (int m = 0; m < 4; ++m) { bf16_t* rowp = ACT + (size_t)(row0 + ai * HALF + m * 16) * FF + j0;
                float o[8];
#pragma unroll
                for (int n = 0; n < 2; ++n)
#pragma unroll
                    for (int i = 0; i < 4; ++i) { float gt = acc[ai][0][m][n][i] + g_b[4 * n + i], up = acc[ai][1][m][n][i] + u_b[4 * n + i];
                        gt = fminf(gt, 7.0f); up = fminf(fmaxf(up, -7.0f), 7.0f);
                        o[4 * n + i] = gt * __builtin_amdgcn_rcpf(1.0f + __builtin_amdgcn_exp2f(-1.702f * LOG2E * gt)) * (up + 1.0f); }
                u32x4 w; w.x = cvt_pk_bf16(o[0], o[1]); w.y = cvt_pk_bf16(o[2], o[3]); w.z = cvt_pk_bf16(o[4], o[5]); w.w = cvt_pk_bf16(o[6], o[7]);
                *(u32x4*)rowp = w; }
    }
};
struct EpiSwiglu8 {
    static constexpr bool PERM = true;
    unsigned char* ACT; const float* bgu;
    struct Pre { f32x4 a, b, c, d; };
    __device__ __forceinline__ Pre pre(const Unit& u, int wr, int wc, int fr, int fq) const {
        const float* bg = bgu + (size_t)u.e * 2 * FF + u.pn * HALF + wc * 32 + 8 * fq;
        Pre q; q.a = *(const f32x4*)bg; q.b = *(const f32x4*)(bg + 4); q.c = *(const f32x4*)(bg + FF); q.d = *(const f32x4*)(bg + FF + 4); return q; }
    __device__ __forceinline__ void post(const f32x4 (&acc)[2][2][4][2], const Pre& q, const Unit& u, int wr, int wc, int fr, int fq) const {
        constexpr float DS = 1.0f / (F8_SH * F8_SW);
        const int row0 = u.pm * BM + wr * 64 + fr, j0 = u.pn * HALF + wc * 32 + 8 * fq;
        float g_b[8], u_b[8];
#pragma unroll
        for (int i = 0; i < 4; ++i) { g_b[i] = q.a[i]; g_b[4 + i] = q.b[i]; u_b[i] = q.c[i]; u_b[4 + i] = q.d[i]; }
#pragma unroll
        for (int ai = 0; ai < 2; ++ai)
#pragma unroll
            for (int m = 0; m < 4; ++m) { unsigned char* rowp = ACT + (size_t)(row0 + ai * HALF + m * 16) * FF + j0;
                float o[8];
#pragma unroll
                for (int n = 0; n < 2; ++n)
#pragma unroll
                    for (int i = 0; i < 4; ++i) { float gt = acc[ai][0][m][n][i] * DS + g_b[4 * n + i], up = acc[ai][1][m][n][i] * DS + u_b[4 * n + i];
                        gt = fminf(gt, 7.0f); up = fminf(fmaxf(up, -7.0f), 7.0f);
                        o[4 * n + i] = gt * __builtin_amdgcn_rcpf(1.0f + __builtin_amdgcn_exp2f(-1.702f * LOG2E * gt)) * (up + 1.0f) * F8_SACT; }
                u32x2 w; w.x = pk4_fp8(o[0], o[1], o[2], o[3]); w.y = pk4_fp8(o[4], o[5], o[6], o[7]);
                NT_STORE(w, (u32x2*)rowp); }
    }
    __device__ __forceinline__ void operator()(const f32x4 (&acc)[2][2][4][2], const Unit& u, int wr, int wc, int fr, int fq) const { const Pre q = pre(u, wr, wc, fr, fq); post(acc, q, u, wr, wc, fr, fq); }
};
struct EpiDown {
    static constexpr bool PERM = true;
    bf16_t* YS; const float* bd; const float* listw; float ds;
    struct Pre { float ws[8]; f32x4 bv[2][2]; };
    __device__ __forceinline__ Pre pre(const Unit& u, int wr, int wc, int fr, int fq) const {
        const int r0 = wr * 64 + fr, col0 = u.pn * BM + wc * 32 + 8 * fq;
        const float* bp = bd + (size_t)u.e * D + col0;
        Pre q;
#pragma unroll
        for (int g = 0; g < 8; ++g) { const int r = r0 + (g >> 2) * HALF + (g & 3) * 16; q.ws[g] = (r < u.nvalid) ? listw[u.lrow + r] : 0.f; }
#pragma unroll
        for (int bj = 0; bj < 2; ++bj) { q.bv[bj][0] = *(const f32x4*)(bp + bj * HALF); q.bv[bj][1] = *(const f32x4*)(bp + bj * HALF + 4); }
        return q; }
    __device__ __forceinline__ void post(const f32x4 (&acc)[2][2][4][2], const Pre& q, const Unit& u, int wr, int wc, int fr, int fq) const {
        const int r0 = wr * 64 + fr, col0 = u.pn * BM + wc * 32 + 8 * fq;
#pragma unroll
        for (int ai = 0; ai < 2; ++ai)
#pragma unroll
            for (int m = 0; m < 4; ++m) { const float w_ = q.ws[ai * 4 + m]; bf16_t* rowp = YS + (size_t)(u.pm * BM + r0 + ai * HALF + m * 16) * D + col0;
#pragma unroll
                for (int bj = 0; bj < 2; ++bj) { const f32x4 v0 = (acc[ai][bj][m][0] * ds + q.bv[bj][0]) * w_, v1 = (acc[ai][bj][m][1] * ds + q.bv[bj][1]) * w_;
                    u32x4 w; w.x = cvt_pk_bf16(v0[0], v0[1]); w.y = cvt_pk_bf16(v0[2], v0[3]); w.z = cvt_pk_bf16(v1[0], v1[1]); w.w = cvt_pk_bf16(v1[2], v1[3]);
                    NT_STORE(w, (u32x4*)(rowp + bj * HALF)); } }
    }
    __device__ __forceinline__ void operator()(const f32x4 (&acc)[2][2][4][2], const Unit& u, int wr, int wc, int fr, int fq) const { const Pre q = pre(u, wr, wc, fr, fq); post(acc, q, u, wr, wc, fr, fq); }
};

struct EpiNull {
    static constexpr bool PERM = true;
    __device__ __forceinline__ void operator()(const f32x4 (&acc)[2][2][4][2], const Unit& u, int wr, int wc, int fr, int fq) const {
#pragma unroll
        for (int ai = 0; ai < 2; ++ai)
#pragma unroll
            for (int bj = 0; bj < 2; ++bj)
#pragma unroll
                for (int m = 0; m < 4; ++m) asm volatile("" :: "v"(acc[ai][bj][m][0]), "v"(acc[ai][bj][m][1]));
    }
};
template <class Epi, class Sched, bool GATHER, bool ALIGN_EPI, bool F8 = false, bool PFA = false>
__device__ __forceinline__ void gemm_phase(LAS unsigned char* lds, const Gemm g, const Sched& S, const Epi& E) {
    int tid = threadIdx.x; asm volatile("" : "+v"(tid));
    const int wid = __builtin_amdgcn_readfirstlane(tid >> 6), lane = tid & 63, wr = wid >> 2, wc = wid & 3, fr = lane & 15, fq = lane >> 4;
    const int K = g.K, nt = K / BK;
    unsigned voffA[2], voffB[2]; int Rg[2], Cg[2];
#pragma unroll
    for (int i = 0; i < 2; ++i) { int R, C; stage_rc(tid * 16 + i * 8192, R, C); const int Rb = Epi::PERM ? ((R & ~31) + perm32(R & 31)) : R;
        voffA[i] = (unsigned)(R * K + C) * 2u; voffB[i] = (unsigned)(Rb * K + C) * 2u; Rg[i] = R; Cg[i] = C; }
    const size_t kstep = (size_t)(BK * 2);
    const size_t hstep = (size_t)HALF * K * 2;
    const size_t tstep = 2 * hstep;
    const unsigned ldsw = (unsigned)wid * 1024u;
    const int aoff = lds_byte(wr * 64 + fr, fq * 8), boff = lds_byte(wc * 32 + fr, fq * 8);
    unsigned vAc[2][2], vAn[2][2];
#define PG8_SA(b, h) (((b) * 2 + (h)) * HTB)
#define PG8_SB(b, h) ((4 + (b) * 2 + (h)) * HTB)
#define PG8_STAGE2(bufoff, gbase, v0, v1) do { \
        __builtin_amdgcn_global_load_lds((const unsigned*)((const char*)(gbase) + (v0)), (LAS unsigned*)(lds + (bufoff) + ldsw), 16, 0, 0); \
        __builtin_amdgcn_global_load_lds((const unsigned*)((const char*)(gbase) + (v1)), (LAS unsigned*)(lds + (bufoff) + ldsw + 8192), 16, 0, 0); } while (0)
#define PG8_STA(bufoff, ap, h, usen) do { if constexpr (GATHER) { const unsigned o0_ = (usen) ? vAn[h][0] : vAc[h][0], o1_ = (usen) ? vAn[h][1] : vAc[h][1]; PG8_STAGE2(bufoff, ap, o0_, o1_); } \
        else { PG8_STAGE2(bufoff, (ap) + (h) * hstep, voffA[0], voffA[1]); } } while (0)
#define PG8_STB(bufoff, bp, h) PG8_STAGE2(bufoff, (bp) + (h) * hstep, voffB[0], voffB[1])
#define PG8_ROWS(u, v) do { _Pragma("unroll") for (int h_ = 0; h_ < 2; ++h_) _Pragma("unroll") for (int i_ = 0; i_ < 2; ++i_) { const int rr_ = h_ * HALF + Rg[i_]; \
        const int idx_ = (rr_ < (u).nvalid) ? g.rows[(u).lrow + rr_] : 0; v[h_][i_] = (unsigned)((idx_ >> 2) * K + Cg[i_]) * 2u; } \
        asm volatile("" : "+v"(v[0][0]), "+v"(v[0][1]), "+v"(v[1][0]), "+v"(v[1][1])); } while (0)
#define PG8_LDA(dst, b, h) do { _Pragma("unroll") for (int m = 0; m < 4; ++m) _Pragma("unroll") for (int k = 0; k < 2; ++k) dst[m][k] = *(const LAS bf16x8*)(lds + PG8_SA(b, h) + aoff + m * 2048 + k * 1024); } while (0)
#define PG8_LDB(dst, b, h) do { _Pragma("unroll") for (int n = 0; n < 2; ++n) _Pragma("unroll") for (int k = 0; k < 2; ++k) dst[n][k] = *(const LAS bf16x8*)(lds + PG8_SB(b, h) + boff + n * 2048 + k * 1024); } while (0)
#define PG8_CAT(x, y) __builtin_shufflevector(__builtin_bit_cast(v4i_t, x), __builtin_bit_cast(v4i_t, y), 0, 1, 2, 3, 4, 5, 6, 7)
#define PG8_MMA(ai, bj, At, Bt) do { __builtin_amdgcn_s_setprio(1); if constexpr (F8) { \
        _Pragma("unroll") for (int m = 0; m < 4; ++m) _Pragma("unroll") for (int n = 0; n < 2; ++n) \
            { const v8i_t b8_ = PG8_CAT(Bt[n][0], Bt[n][1]), a8_ = PG8_CAT(At[m][0], At[m][1]);     \
              asm volatile("v_mfma_scale_f32_16x16x128_f8f6f4 %0, %1, %2, %0, %3, %3 op_sel_hi:[0,0,0]" : "+v"(acc[ai][bj][m][n]) : "v"(b8_), "v"(a8_), "v"(f8one)); } \
        } else { _Pragma("unroll") for (int m = 0; m < 4; ++m) _Pragma("unroll") for (int n = 0; n < 2; ++n) _Pragma("unroll") for (int k = 0; k < 2; ++k) \
        acc[ai][bj][m][n] = __builtin_amdgcn_mfma_f32_16x16x32_bf16(Bt[n][k], At[m][k], acc[ai][bj][m][n], 0, 0, 0); } __builtin_amdgcn_s_setprio(0); } while (0)
#define PG8_WAIT_V(n) asm volatile("s_waitcnt vmcnt(" #n ")" ::: "memory")
#define PG8_WAIT_L(n) asm volatile("s_waitcnt lgkmcnt(" #n ")" ::: "memory")
#define PG8_BAR __builtin_amdgcn_s_barrier()
#define PG8_SCHED __builtin_amdgcn_sched_barrier(0)
    Unit cur, nxt; int ui = 0;
    if (!S.next(0, cur)) return;
    f32x4 acc[2][2][4][2];
#pragma unroll
    for (int a = 0; a < 2; ++a)
#pragma unroll
        for (int b = 0; b < 2; ++b)
#pragma unroll
            for (int m = 0; m < 4; ++m)
#pragma unroll
                for (int n = 0; n < 2; ++n) acc[a][b][m][n] = (f32x4){0.f, 0.f, 0.f, 0.f};
    bf16x8 At[4][2], B0[2][2], B1[2][2];
    const int f8one = 0x7f7f7f7f;
    const char* cA = GATHER ? (const char*)g.A : (const char*)g.A + (size_t)cur.pm * tstep;
    const char* cB = (const char*)g.Bt + ((size_t)cur.e * g.estride) * 2 + (size_t)cur.pn * tstep;
    if constexpr (GATHER) { PG8_ROWS(cur, vAc); }
    PG8_STB(PG8_SB(0, 0), cB, 0); PG8_STB(PG8_SB(0, 1), cB, 1); PG8_STA(PG8_SA(0, 0), cA, 0, false); PG8_STA(PG8_SA(0, 1), cA, 1, false);
    if (wr == 1) PG8_BAR;
    PG8_WAIT_V(2); PG8_BAR;
    PG8_STB(PG8_SB(1, 0), cB + kstep, 0); PG8_STA(PG8_SA(1, 0), cA + kstep, 0, false); PG8_STB(PG8_SB(1, 1), cB + kstep, 1);
    PG8_WAIT_V(6); PG8_BAR;
    for (;;) {
        const bool has_next = S.next(ui + 1, nxt);
        const char* nA = GATHER ? (const char*)g.A : (has_next ? (const char*)g.A + (size_t)nxt.pm * tstep : cA);
        const char* nB = has_next ? (const char*)g.Bt + ((size_t)nxt.e * g.estride) * 2 + (size_t)nxt.pn * tstep : cB;
        if constexpr (GATHER) { if (has_next) { PG8_ROWS(nxt, vAn); } else {
#pragma unroll
            for (int h = 0; h < 2; ++h) { vAn[h][0] = vAc[h][0]; vAn[h][1] = vAc[h][1]; } } }
        for (int t = 0; t < nt; t += 2) {
            const bool last = (t == nt - 2);
            const char* a1 = cA + (size_t)(t + 1) * kstep;
            const char* a2 = last ? nA : cA + (size_t)(t + 2) * kstep; const char* b2 = last ? nB : cB + (size_t)(t + 2) * kstep;
            const char* a3 = a2 + kstep; const char* b3 = b2 + kstep;
            PG8_LDB(B0, 0, 0); PG8_LDB(B1, 0, 1); PG8_SCHED; PG8_LDA(At, 0, 0); PG8_STA(PG8_SA(1, 1), a1, 1, false);
            PG8_WAIT_V(8); PG8_WAIT_L(0); PG8_BAR; PG8_MMA(0, 0, At, B0); PG8_MMA(0, 1, At, B1); PG8_BAR; PG8_SCHED;
            PG8_LDA(At, 0, 1); PG8_STB(PG8_SB(0, 0), b2, 0); PG8_STB(PG8_SB(0, 1), b2, 1); PG8_STA(PG8_SA(0, 0), a2, 0, last);
            PG8_WAIT_V(8); PG8_WAIT_L(0); PG8_BAR; PG8_MMA(1, 0, At, B0); PG8_MMA(1, 1, At, B1); PG8_BAR; PG8_SCHED;
            PG8_LDB(B0, 1, 0); PG8_LDB(B1, 1, 1); PG8_SCHED; PG8_LDA(At, 1, 0); PG8_STA(PG8_SA(0, 1), a2, 1, last);
            PG8_WAIT_V(8); PG8_WAIT_L(0); PG8_BAR; PG8_MMA(0, 0, At, B0); PG8_MMA(0, 1, At, B1); PG8_BAR; PG8_SCHED;
            PG8_LDA(At, 1, 1); PG8_STB(PG8_SB(1, 0), b3, 0); PG8_STB(PG8_SB(1, 1), b3, 1); PG8_STA(PG8_SA(1, 0), a3, 0, last);
            PG8_WAIT_V(8); PG8_WAIT_L(0); PG8_BAR; PG8_MMA(1, 0, At, B0); PG8_MMA(1, 1, At, B1); PG8_BAR; PG8_SCHED;
        }
        if constexpr (ALIGN_EPI) { if (wr == 0) PG8_BAR; }
        if constexpr (F8) asm volatile("s_nop 15\n\ts_nop 15" ::: "memory");
        if constexpr (PFA) {
            const auto q_ = E.pre(cur, wr, wc, fr, fq);
            PG8_SCHED;
            if (has_next) { LAS unsigned* dump_ = (LAS unsigned*)(lds + STAGE_BYTES + 8192 + ldsw / 4);
                for (int kb = 0; kb < nt * 128; kb += 1024) if (kb > 0 || Cg[0] >= 16) {
#pragma unroll
                    for (int h = 0; h < 2; ++h)
#pragma unroll
                        for (int i = 0; i < 2; ++i) { const char* pa_ = GATHER ? nA + vAn[h][i] : nA + h * hstep + voffA[i];
                            __builtin_amdgcn_global_load_lds((const unsigned*)(pa_ + Cg[i] * 14 + kb), dump_, 4, 0, 0); } } }
            PG8_SCHED;
            E.post(acc, q_, cur, wr, wc, fr, fq);
        } else E(acc, cur, wr, wc, fr, fq);
        if (!has_next) break;
#pragma unroll
        for (int a = 0; a < 2; ++a)
#pragma unroll
            for (int b = 0; b < 2; ++b)
#pragma unroll
                for (int m = 0; m < 4; ++m)
#pragma unroll
                    for (int n = 0; n < 2; ++n) acc[a][b][m][n] = (f32x4){0.f, 0.f, 0.f, 0.f};
        cur = nxt; cA = nA; cB = nB; ++ui;
        if constexpr (GATHER) {
#pragma unroll
            for (int h = 0; h < 2; ++h) { vAc[h][0] = vAn[h][0]; vAc[h][1] = vAn[h][1]; } }
        if constexpr (ALIGN_EPI) { if (wr == 1) PG8_BAR; }
    }
    PG8_WAIT_V(0);
    if constexpr (!ALIGN_EPI) { if (wr == 0) PG8_BAR; }
    PG8_BAR;
#undef PG8_SA
#undef PG8_SB
#undef PG8_STAGE2
#undef PG8_STA
#undef PG8_STB
#undef PG8_ROWS
#undef PG8_LDA
#undef PG8_LDB
#undef PG8_MMA
#undef PG8_CAT
#undef PG8_WAIT_V
#undef PG8_WAIT_L
#undef PG8_BAR
#undef PG8_SCHED
}
}
namespace attn_body {
using bf16x8 = __attribute__((ext_vector_type(8))) short;
using s16x4 = __attribute__((ext_vector_type(4))) short;
using f32x16 = __attribute__((ext_vector_type(16))) float;
constexpr int NW = 8, QBLK = 32, QB = QBLK * NW, KVBLK = 64;
__device__ __forceinline__ int crow(int r, int hi) { return (r & 3) + 8 * (r >> 2) + 4 * hi; }
#define SBAR() __builtin_amdgcn_sched_barrier(0)
constexpr int NSLOT = 4, SLOTK = 8192, SLOTV = 16384;
constexpr int LDS_K = 0, LDS_V = NSLOT * SLOTK, LDS_WS = LDS_V + NSLOT * SLOTV, LDS_TAB = LDS_WS + NW * 64 * 4, TAB_N = 640, LDS_BYTES = LDS_TAB + TAB_N * 4;
__device__ __forceinline__ void glds16(const void* gsrc, unsigned lds_dst) { unsigned keep;
  asm volatile("s_mov_b32 %0, m0\n\ts_mov_b32 m0, %2\n\ts_nop 0\n\tglobal_load_lds_dwordx4 %1, off\n\ts_mov_b32 m0, %0" : "=&s"(keep) : "v"(gsrc), "s"(lds_dst) : "memory"); }
typedef float f32x2_t __attribute__((ext_vector_type(2))); typedef __bf16 bf16x2_t __attribute__((ext_vector_type(2)));
__device__ __forceinline__ unsigned cvtpk_s(float lo, float hi) { f32x2_t v = {lo, hi}; bf16x2_t b = __builtin_convertvector(v, bf16x2_t); return __builtin_bit_cast(unsigned, b); }
#define WAIT_BAR(N) asm volatile("s_waitcnt vmcnt(" #N ") lgkmcnt(0)\n\ts_barrier" ::: "memory")

__device__ __forceinline__ void qkt(f32x16& p0, f32x16& p1, const LAS char* Kslot, const bf16x8* qr, const f32x16& negm, int r32, int hi) {
  const LAS char* kb = Kslot + hi * 1024 + r32 * 16;
  #pragma unroll
  for (int d0 = 0; d0 < 4; ++d0) {
    const bf16x8 b0 = *(const LAS bf16x8*)(kb + d0 * 2048);
    const bf16x8 b1 = *(const LAS bf16x8*)(kb + d0 * 2048 + 512);
    if (d0 == 0) { p0 = __builtin_amdgcn_mfma_f32_32x32x16_bf16(b0, qr[0], negm, 0, 0, 0); p1 = __builtin_amdgcn_mfma_f32_32x32x16_bf16(b1, qr[0], negm, 0, 0, 0); }
    else { p0 = __builtin_amdgcn_mfma_f32_32x32x16_bf16(b0, qr[d0], p0, 0, 0, 0); p1 = __builtin_amdgcn_mfma_f32_32x32x16_bf16(b1, qr[d0], p1, 0, 0, 0); } }
}
__device__ __forceinline__ float fadd_s(float a, float b) { float r; asm("v_add_f32_e32 %0, %1, %2" : "=v"(r) : "v"(a), "v"(b)); return r; }
__device__ __forceinline__ void kload8(bf16x8* kf, const LAS char* Kslot, int r32, int hi) {
  const LAS char* kb = Kslot + hi * 1024 + r32 * 16;
  #pragma unroll
  for (int d0 = 0; d0 < 4; ++d0) { kf[2 * d0] = *(const LAS bf16x8*)(kb + d0 * 2048); kf[2 * d0 + 1] = *(const LAS bf16x8*)(kb + d0 * 2048 + 512); }
}
__device__ __forceinline__ void qkt_r(f32x16& p0, f32x16& p1, const bf16x8* kf, const bf16x8* qr, const f32x16& negm) {
  p0 = __builtin_amdgcn_mfma_f32_32x32x16_bf16(kf[0], qr[0], negm, 0, 0, 0); p1 = __builtin_amdgcn_mfma_f32_32x32x16_bf16(kf[1], qr[0], negm, 0, 0, 0);
  #pragma unroll
  for (int d0 = 1; d0 < 4; ++d0) { p0 = __builtin_amdgcn_mfma_f32_32x32x16_bf16(kf[2 * d0], qr[d0], p0, 0, 0, 0); p1 = __builtin_amdgcn_mfma_f32_32x32x16_bf16(kf[2 * d0 + 1], qr[d0], p1, 0, 0, 0); }
}
#define MX3(a, b, c) __builtin_fmaxf(__builtin_fmaxf((a), (b)), (c))
__device__ __forceinline__ float rowmax(const f32x16& p0, const f32x16& p1) {
  float a = MX3(p0[0], p0[1], p1[0]), b = MX3(p0[2], p0[3], p1[1]); a = MX3(a, p1[2], p1[3]);
  #pragma unroll
  for (int r = 4; r < 16; r += 4) { a = MX3(a, p0[r], p0[r + 1]); b = MX3(b, p0[r + 2], p0[r + 3]); a = MX3(a, p1[r], p1[r + 1]); b = MX3(b, p1[r + 2], p1[r + 3]); }
  float rm = __builtin_fmaxf(a, b);
  auto rr = __builtin_amdgcn_permlane32_swap(__float_as_uint(rm), __float_as_uint(rm), false, false);
  return __builtin_fmaxf(__uint_as_float(rr[0]), __uint_as_float(rr[1]));
}
__device__ __forceinline__ void bmask(f32x16& p0, f32x16& p1, int jb, int qrel, int hi, const LAS float* tab) {
  const unsigned ta = (unsigned)(uintptr_t)(tab + (255 + qrel - 64 * jb - 4 * hi - 59));
  #pragma unroll
  for (int g = 0; g < 4; ++g) {
    float a0, a1, a2, a3, b0, b1, b2, b3;
    asm volatile("ds_read_b32 %0, %8 offset:%c9\n\tds_read_b32 %1, %8 offset:%c10\n\tds_read_b32 %2, %8 offset:%c11\n\tds_read_b32 %3, %8 offset:%c12\n\t"
                 "ds_read_b32 %4, %8 offset:%c13\n\tds_read_b32 %5, %8 offset:%c14\n\tds_read_b32 %6, %8 offset:%c15\n\tds_read_b32 %7, %8 offset:%c16\n\ts_waitcnt lgkmcnt(0)"
                 : "=&v"(a0), "=&v"(a1), "=&v"(a2), "=&v"(a3), "=&v"(b0), "=&v"(b1), "=&v"(b2), "=&v"(b3)
                 : "v"(ta), "i"(4 * (59 - 8 * g)), "i"(4 * (59 - 8 * g - 1)), "i"(4 * (59 - 8 * g - 2)), "i"(4 * (59 - 8 * g - 3)),
                   "i"(4 * (59 - 8 * g - 32)), "i"(4 * (59 - 8 * g - 33)), "i"(4 * (59 - 8 * g - 34)), "i"(4 * (59 - 8 * g - 35)) : "memory");
    p0[4 * g] += a0; p0[4 * g + 1] += a1; p0[4 * g + 2] += a2; p0[4 * g + 3] += a3;
    p1[4 * g] += b0; p1[4 * g + 1] += b1; p1[4 * g + 2] += b2; p1[4 * g + 3] += b3;
  }
}
template <int ND>
__device__ __forceinline__ void pv(f32x16* o, int vb, bf16x8 pa0, bf16x8 pa1, bf16x8 pa2, bf16x8 pa3) {
  #pragma unroll
  for (int d0 = 0; d0 < ND; d0 += 2) { s16x4 lo[2][4], hi[2][4];
    #pragma unroll
    for (int e = 0; e < 2; ++e)
      #pragma unroll
      for (int ks = 0; ks < 4; ++ks) {
        asm volatile("ds_read_b64_tr_b16 %0,%1 offset:%c2" : "=&v"(lo[e][ks]) : "v"(vb), "i"((d0 + e) * 4096 + ks * 1024) : "memory");
        asm volatile("ds_read_b64_tr_b16 %0,%1 offset:%c2" : "=&v"(hi[e][ks]) : "v"(vb), "i"((d0 + e) * 4096 + ks * 1024 + 512) : "memory"); }
    asm volatile("s_waitcnt lgkmcnt(0)" ::: "memory"); SBAR();
    #define PK(e, k) (bf16x8){lo[e][k][0], lo[e][k][1], lo[e][k][2], lo[e][k][3], hi[e][k][0], hi[e][k][1], hi[e][k][2], hi[e][k][3]}
    o[d0]     = __builtin_amdgcn_mfma_f32_32x32x16_bf16(pa0, PK(0, 0), o[d0], 0, 0, 0);
    o[d0 + 1] = __builtin_amdgcn_mfma_f32_32x32x16_bf16(pa0, PK(1, 0), o[d0 + 1], 0, 0, 0);
    o[d0]     = __builtin_amdgcn_mfma_f32_32x32x16_bf16(pa1, PK(0, 1), o[d0], 0, 0, 0);
    o[d0 + 1] = __builtin_amdgcn_mfma_f32_32x32x16_bf16(pa1, PK(1, 1), o[d0 + 1], 0, 0, 0);
    o[d0]     = __builtin_amdgcn_mfma_f32_32x32x16_bf16(pa2, PK(0, 2), o[d0], 0, 0, 0);
    o[d0 + 1] = __builtin_amdgcn_mfma_f32_32x32x16_bf16(pa2, PK(1, 2), o[d0 + 1], 0, 0, 0);
    o[d0]     = __builtin_amdgcn_mfma_f32_32x32x16_bf16(pa3, PK(0, 3), o[d0], 0, 0, 0);
    o[d0 + 1] = __builtin_amdgcn_mfma_f32_32x32x16_bf16(pa3, PK(1, 3), o[d0 + 1], 0, 0, 0);
    #undef PK
    SBAR();
  }
}

template <int THRL, int PQ, int PO, int NV>
__device__ __forceinline__ void attn_unit(const bf16_t* Qp, const bf16_t* __restrict__ Kp, const bf16_t* __restrict__ Vp, bf16_t* Op, const int NT, const float mfloor, const float sink2, char* shm, const int dbg = 0,
                                          const bf16_t* O1p = nullptr, const float lam = 0.f, const float* gsub = nullptr, const float post = 0.f) {
  constexpr int ND = 2 * NV;
  int tid = threadIdx.x; asm volatile("" : "+v"(tid));
  const int lane = tid & 63, r32 = lane & 31, hi = lane >> 5; const int wid = __builtin_amdgcn_readfirstlane(tid >> 6);
  const unsigned lds0 = (unsigned)(uintptr_t)shm;
  const LAS char* shm3 = (const LAS char*)shm;
  LAS float* wsf = (LAS float*)((LAS char*)shm + LDS_WS) + wid * 64;
  const LAS float* tab = (const LAS float*)((LAS char*)shm + LDS_TAB);
  const bf16_t* Qw = Qp + (long)(wid * QBLK) * PQ;
  bf16x8 qr[4];
  #pragma unroll
  for (int d0 = 0; d0 < 4; ++d0) qr[d0] = *reinterpret_cast<const bf16x8*>(&Qw[(long)r32 * PQ + d0 * 16 + hi * 8]);
  const bf16_t* ksrc = Kp + (long)lane * PQ + wid * 8;
  const bf16_t* vsrc = Vp + (long)(16 * (wid & 3) + (lane >> 2)) * PQ + (wid >> 2) * 32 + (lane & 3) * 8;
  const unsigned kdst = lds0 + LDS_K + wid * 1024, vdst = lds0 + LDS_V + wid * 1024;
  #define DMA_K(t, sl) glds16(ksrc + (long)(t) * KVBLK * PQ, (unsigned)__builtin_amdgcn_readfirstlane(kdst + (sl) * SLOTK))
  #define DMA_V(t, sl) do { const long go_ = (long)(t) * KVBLK * PQ; glds16(vsrc + go_, (unsigned)__builtin_amdgcn_readfirstlane(vdst + (sl) * SLOTV)); \
      if (NV == 2) glds16(vsrc + go_ + 64, (unsigned)__builtin_amdgcn_readfirstlane(vdst + (sl) * SLOTV + 8192)); } while (0)
  const int vb0 = (int)(lds0 + LDS_V) + ((lane >> 4) & 1) * 32 + (lane & 3) * 8 + (4 * hi + ((lane & 15) >> 2)) * 64;
  float mhat = mfloor, l_reg = 0.f; f32x16 o[ND], negm;
  { float zf = 0.f; asm volatile("" : "+v"(zf));
    _Pragma("unroll") for (int r = 0; r < 16; ++r) { _Pragma("unroll") for (int d = 0; d < ND; ++d) o[d][r] = zf; negm[r] = -mhat; } }
  const int qrel = wid * QBLK + r32;
  DMA_K(0, 0); DMA_V(0, 3); DMA_K(1, 1); DMA_V(0, 0); DMA_K(2, 2); DMA_V(1, 1);
  asm volatile("" :: "v"(qr[0]), "v"(qr[1]), "v"(qr[2]), "v"(qr[3]));
  const int grp = wid >> 2;
  u32x4 pw0, pw1, pw2, pw3; pw0 = pw1 = pw2 = pw3 = (u32x4){0u, 0u, 0u, 0u};
  bool resc = false;
  f32x16 c0, c1;
#ifndef ATT_STAGGER
#define ATT_STAGGER 0
#endif
  if (ATT_STAGGER && grp == 1) { if (NV == 2) WAIT_BAR(6); else WAIT_BAR(4); }
  bf16x8 kf[8];
  if (!ATT_STAGGER) { if (NV == 2) WAIT_BAR(8); else WAIT_BAR(5); kload8(kf, shm3 + LDS_K, r32, hi); }
  #pragma unroll 1
  for (int t = 0; t <= NT; ++t) {
    if (dbg & 32) { } else if (ATT_STAGGER) { if (NV == 2) WAIT_BAR(6); else WAIT_BAR(4); } else { if (NV == 2) WAIT_BAR(5); else WAIT_BAR(3); }
    if (!ATT_STAGGER) { const int tk = t + 3 < NT ? t + 3 : NT - 1, tv = t + 2 < NT ? t + 2 : NT - 1;
      if (!(dbg & 4)) { DMA_K(tk, (t + 3) & 3); DMA_V(tv, (t + 2) & 3); } }
    { const int tq = t < NT ? t : NT - 1;
      if (!(dbg & 8)) { if (ATT_STAGGER) qkt(c0, c1, shm3 + LDS_K + (tq & 3) * SLOTK, qr, negm, r32, hi); else { qkt_r(c0, c1, kf, qr, negm); SBAR(); kload8(kf, shm3 + LDS_K + ((t + 1) & 3) * SLOTK, r32, hi); } } else { _Pragma("unroll") for (int r = 0; r < 16; ++r) { c0[r] = -1.0f; c1[r] = -1.0f; } } }
    SBAR();
    const int jb = t - (NT - 4);
    if (jb >= -2 && jb <= 3) bmask(c0, c1, jb, qrel, hi, tab);
    const float rm = rowmax(c0, c1);
    if (t < NT && __any(rm > (float)THRL)) {
      const float dl = __builtin_fmaxf(rm, 0.f);
      mhat += dl;
      #pragma unroll
      for (int r = 0; r < 16; ++r) { c0[r] -= dl; c1[r] -= dl; negm[r] = -mhat; }
      const float f = __builtin_amdgcn_exp2f(-dl); l_reg *= f;
      if (hi == 0) wsf[r32] = f;
      resc = true;
    }
    if ((dbg & 32) || !ATT_STAGGER) { } else if (NV == 2) WAIT_BAR(5); else WAIT_BAR(3);
    if (ATT_STAGGER) { const int tk = t + 3 < NT ? t + 3 : NT - 1, tv = t + 2 < NT ? t + 2 : NT - 1;
      if (!(dbg & 4)) { DMA_K(tk, (t + 3) & 3); DMA_V(tv, (t + 2) & 3); } }
    { const int vb = vb0 + ((t + 3) & 3) * SLOTV;
      s16x4 lo[2][4], hi_[2][4];
      #define RD(b, d0) do { _Pragma("unroll") for (int ks = 0; ks < 4; ++ks) { \
          asm volatile("ds_read_b64_tr_b16 %0,%1 offset:%c2" : "=v"(lo[b][ks]) : "v"(vb), "i"((d0) * 4096 + ks * 1024) : "memory"); \
          asm volatile("ds_read_b64_tr_b16 %0,%1 offset:%c2" : "=v"(hi_[b][ks]) : "v"(vb), "i"((d0) * 4096 + ks * 1024 + 512) : "memory"); } } while (0)
      #define WT(b) asm volatile("s_waitcnt lgkmcnt(0)" : "+v"(lo[b][0]), "+v"(lo[b][1]), "+v"(lo[b][2]), "+v"(lo[b][3]), "+v"(hi_[b][0]), "+v"(hi_[b][1]), "+v"(hi_[b][2]), "+v"(hi_[b][3]) :: "memory")
      #define PK(b, k) (bf16x8){lo[b][k][0], lo[b][k][1], lo[b][k][2], lo[b][k][3], hi_[b][k][0], hi_[b][k][1], hi_[b][k][2], hi_[b][k][3]}
      #define EXQ(e) do { if (dbg & 1) { if ((e) < 16) c0[(e)] = 0.25f; else c1[(e) - 16] = 0.25f; } else if ((e) < 16) { c0[(e)] = __builtin_amdgcn_exp2f(c0[(e)]); } else { c1[(e) - 16] = __builtin_amdgcn_exp2f(c1[(e) - 16]); } } while (0)
      constexpr int EPM = 32 / (4 * ND);
      #define MM(b, d0) do { _Pragma("unroll") for (int k = 0; k < 4; ++k) { \
          const bf16x8 pa_ = __builtin_bit_cast(bf16x8, k == 0 ? pw0 : k == 1 ? pw1 : k == 2 ? pw2 : pw3); \
          if (!(dbg & 2)) o[d0] = __builtin_amdgcn_mfma_f32_32x32x16_bf16(pa_, PK(b, k), o[d0], 0, 0, 0); \
          _Pragma("unroll") for (int x = 0; x < EPM; ++x) EXQ(((d0) * 4 + k) * EPM + x); \
          asm volatile("" : "+v"(c0), "+v"(c1)); SBAR(); } } while (0)
      if (!(dbg & 16)) { RD(0, 0); WT(0); } else { _Pragma("unroll") for (int b_ = 0; b_ < 2; ++b_) _Pragma("unroll") for (int k_ = 0; k_ < 4; ++k_) { lo[b_][k_] = (s16x4){0, 0, 0, 0}; hi_[b_][k_] = (s16x4){0, 0, 0, 0}; } }
      #pragma unroll
      for (int d0 = 0; d0 < ND; ++d0) {
        if (d0 + 1 < ND && !(dbg & 16)) { if ((d0 & 1) == 0) RD(1, d0 + 1); else RD(0, d0 + 1); }
        SBAR();
        if ((d0 & 1) == 0) MM(0, d0); else MM(1, d0);
        if (d0 + 1 < ND && !(dbg & 16)) { if ((d0 & 1) == 0) WT(1); else WT(0); }
      }
      #undef RD
      #undef WT
      #undef PK
      #undef EXQ
      #undef MM
    }
    if (resc) { resc = false;
      asm volatile("s_waitcnt lgkmcnt(0)" ::: "memory");
      #pragma unroll
      for (int c8 = 0; c8 < 2; ++c8) { float fr_[8];
        #pragma unroll
        for (int r = 0; r < 8; ++r) fr_[r] = wsf[crow(8 * c8 + r, hi)];
        asm volatile("s_waitcnt lgkmcnt(0)" ::: "memory");
        #pragma unroll
        for (int r = 0; r < 8; ++r)
          #pragma unroll
          for (int d = 0; d < ND; ++d) o[d][8 * c8 + r] *= fr_[r]; } }
    if (t < NT) {
      float sa = c0[0], sb = c1[0];
      #pragma unroll
      for (int r = 1; r < 16; ++r) { sa = fadd_s(sa, c0[r]); sb = fadd_s(sb, c1[r]); }
      l_reg += sa + sb;
      #define PKW(P, B) cvtpk_s(P[B], P[B + 1])
      pw0 = (u32x4){PKW(c0, 0), PKW(c0, 2), PKW(c0, 4), PKW(c0, 6)}; pw1 = (u32x4){PKW(c0, 8), PKW(c0, 10), PKW(c0, 12), PKW(c0, 14)};
      pw2 = (u32x4){PKW(c1, 0), PKW(c1, 2), PKW(c1, 4), PKW(c1, 6)}; pw3 = (u32x4){PKW(c1, 8), PKW(c1, 10), PKW(c1, 12), PKW(c1, 14)};
      #undef PKW
    }
  }
  if (ATT_STAGGER && grp == 0) asm volatile("s_barrier" ::: "memory");
  { auto rr = __builtin_amdgcn_permlane32_swap(__float_as_uint(l_reg), __float_as_uint(l_reg), false, false); l_reg = __uint_as_float(rr[0]) + __uint_as_float(rr[1]); }
  l_reg += __builtin_amdgcn_exp2f(sink2 - mhat);
  if (hi == 0) wsf[32 + r32] = l_reg;
  asm volatile("s_waitcnt vmcnt(0) lgkmcnt(0)\n\ts_barrier" ::: "memory");
  float rli[16];
  #pragma unroll
  for (int c8 = 0; c8 < 2; ++c8) {
    #pragma unroll
    for (int r = 0; r < 8; ++r) rli[8 * c8 + r] = wsf[32 + crow(8 * c8 + r, hi)];
    asm volatile("s_waitcnt lgkmcnt(0)" ::: "memory"); }
  #pragma unroll
  for (int r = 0; r < 16; ++r) rli[r] = __builtin_amdgcn_rcpf(rli[r]);
  bf16_t* Ow = Op + (long)(wid * QBLK) * PO;
  { LAS bf16_t* stg = (LAS bf16_t*)((LAS char*)shm) + wid * (32 * 64 * NV);
    #pragma unroll
    for (int r = 0; r < 16; ++r) { const int orow = crow(r, hi);
      #pragma unroll
      for (int d0 = 0; d0 < ND; ++d0) stg[orow * (64 * NV) + d0 * 32 + r32] = (bf16_t)(cvtpk_s(o[d0][r] * rli[r], 0.f) & 0xffffu); }
    asm volatile("s_waitcnt lgkmcnt(0)" ::: "memory");
    constexpr int CPR = 8 * NV, RPI = 64 / CPR;
    if (NV == 2 && O1p != nullptr) {
      const bf16_t* O1w = O1p + (long)(wid * QBLK) * PO; const int ch = lane % CPR;
      float gv[8];
      { const f32x4 ga = *(const f32x4*)(gsub + ch * 8), gb = *(const f32x4*)(gsub + ch * 8 + 4);
        gv[0] = ga[0] * post; gv[1] = ga[1] * post; gv[2] = ga[2] * post; gv[3] = ga[3] * post; gv[4] = gb[0] * post; gv[5] = gb[1] * post; gv[6] = gb[2] * post; gv[7] = gb[3] * post; }
      #pragma unroll
      for (int i = 0; i < 32 / RPI; ++i) { const int row = i * RPI + lane / CPR;
        const u32x4 q = *(const LAS u32x4*)(stg + row * (64 * NV) + ch * 8); const u32x4 p = *(const u32x4*)(O1w + (long)row * PO + ch * 8);
        float x[8];
        x[0] = bf_lo(p.x) - lam * bf_lo(q.x); x[1] = bf_hi(p.x) - lam * bf_hi(q.x); x[2] = bf_lo(p.y) - lam * bf_lo(q.y); x[3] = bf_hi(p.y) - lam * bf_hi(q.y);
        x[4] = bf_lo(p.z) - lam * bf_lo(q.z); x[5] = bf_hi(p.z) - lam * bf_hi(q.z); x[6] = bf_lo(p.w) - lam * bf_lo(q.w); x[7] = bf_hi(p.w) - lam * bf_hi(q.w);
        float ss = 0.f;
        #pragma unroll
        for (int k = 0; k < 8; ++k) ss += x[k] * x[k];
        #pragma unroll
        for (int sh = 1; sh < 16; sh <<= 1) ss += __int_as_float(__builtin_amdgcn_ds_bpermute((lane ^ sh) << 2, __float_as_int(ss)));
        const float rn = 1.0f / sqrtf(ss * (1.0f / 128.0f) + SUBLN_EPS);
        u32x4 w; w.x = cvtpk_s(x[0] * rn * gv[0], x[1] * rn * gv[1]); w.y = cvtpk_s(x[2] * rn * gv[2], x[3] * rn * gv[3]);
        w.z = cvtpk_s(x[4] * rn * gv[4], x[5] * rn * gv[5]); w.w = cvtpk_s(x[6] * rn * gv[6], x[7] * rn * gv[7]);
        *(u32x4*)(Ow + (long)row * PO + ch * 8) = w; }
    } else {
    #pragma unroll
    for (int i = 0; i < 32 / RPI; ++i) { const int row = i * RPI + lane / CPR, ch = lane % CPR; const u32x4 v = *(const LAS u32x4*)(stg + row * (64 * NV) + ch * 8); *(u32x4*)(Ow + (long)row * PO + ch * 8) = v; } } }
  asm volatile("s_waitcnt lgkmcnt(0)\n\ts_barrier" ::: "memory");
  #undef DMA_K
  #undef DMA_V
}
#undef SBAR
#undef WAIT_BAR
#undef MX3
}
constexpr size_t MiB = 1u << 20;
constexpr size_t WS_CTL = 0, CTL_ZERO_BYTES = 1 * MiB;
constexpr size_t WS_MOD = 1 * MiB;
constexpr size_t WS_LAM = WS_MOD + 512 * 1024;
constexpr size_t WS_WIN = 2 * MiB;
constexpr size_t WS_WOA = 20 * MiB, WS_WOB = 22 * MiB;
constexpr size_t WS_WR = 24 * MiB;
constexpr size_t WS_WGU = 32 * MiB;
constexpr size_t WS_WD = 288 * MiB;
constexpr size_t WS_H = 416 * MiB;
constexpr size_t WS_P = 480 * MiB;
constexpr size_t WS_OA = 752 * MiB, WS_OD = 784 * MiB, WS_OB = 848 * MiB;
constexpr size_t WS_YA = 880 * MiB, WS_Y = 944 * MiB;
constexpr size_t WS_LOG = 1008 * MiB;
constexpr size_t WS_LIST = 1012 * MiB;
constexpr size_t WS_WSLOT = 1016 * MiB;
constexpr size_t WS_LISTW = 1017 * MiB;
constexpr size_t WS_ACT = 1024 * MiB;
constexpr size_t WS_YS = 1296 * MiB;
constexpr size_t WS_SPOS = 1021 * MiB;
constexpr size_t WS_H8 = 1568 * MiB;
constexpr size_t WS_H8M = 1600 * MiB;
constexpr size_t WS_WIN8 = 14 * MiB;
constexpr size_t WS_END = 1632 * MiB;
static_assert((size_t)ACT_ROWS * D * 2 <= WS_H8 - WS_YS && (size_t)ACT_ROWS * FF * 2 <= WS_YS - WS_ACT && (size_t)M * INW * 2 <= WS_OA - WS_P, "ws map");
constexpr int CW_BAR = 4096;
constexpr int CW_CNT = 8192;

constexpr int RING_OFF = 0, RING_BYTES = 131072;
constexpr int LDSCTL_OFF = RING_BYTES;
constexpr int LW_TOFF = 64, LW_CL = 128, LW_LCNT = 192, LW_LBASE = 256;
constexpr int LDS_BYTES = 147456;
static_assert(attn_body::LDS_BYTES <= RING_BYTES && pg8::STAGE_BYTES <= RING_BYTES, "ring");

#define RLX_AGENT __ATOMIC_RELAXED, __HIP_MEMORY_SCOPE_AGENT
#define LDS_WAIT() asm volatile("s_waitcnt lgkmcnt(0)" ::: "memory")
__device__ __forceinline__ unsigned f2bf(float f) { unsigned u = __builtin_bit_cast(unsigned, f); return (u + 0x7fffu + ((u >> 16) & 1u)) >> 16; }
__device__ __forceinline__ unsigned pk2(float lo, float hi) { return f2bf(lo) | (f2bf(hi) << 16); }

#define XB_TMO      128
#define XB_XCNT(j)  (256  + 64 * (j))
#define XB_XSUB(j)  (1280 + 64 * (j))
#define XB_XGEN(j)  (2304 + 64 * (j))
#define XB_TOP      3328
#define XB_TOPGEN   3392
#define XCD_BAR_WORDS 3456
#define XB_SPIN_CAP (1u << 18)
__device__ __forceinline__ unsigned xb_ld(unsigned* p)              { return __hip_atomic_load(p, __ATOMIC_RELAXED, __HIP_MEMORY_SCOPE_AGENT); }
__device__ __forceinline__ unsigned xb_add(unsigned* p, unsigned v) { return __hip_atomic_fetch_add(p, v, __ATOMIC_RELAXED, __HIP_MEMORY_SCOPE_AGENT); }
__device__ __forceinline__ unsigned xb_xcc_id() { return (unsigned)__builtin_amdgcn_s_getreg((3 << 11) | 20) & 0xFu; }
#define XB_SPIN(cond, bar) do { unsigned _sp = 0; while (cond) { __builtin_amdgcn_s_sleep(1); \
    if ((++_sp & 255u) == 0u) { if (xb_ld(&(bar)[XB_TMO])) break; if (_sp > XB_SPIN_CAP) { atomicAdd(&(bar)[XB_TMO], 1u); break; } } } } while (0)
struct XcdBarrier { unsigned* bar; unsigned x; volatile LAS unsigned* st; };
__device__ __forceinline__ XcdBarrier xcd_barrier_post(unsigned* bar, volatile LAS unsigned* st) {
    XcdBarrier b; b.bar = bar; b.x = xb_xcc_id(); b.st = st;
    if (threadIdx.x == 0) (void)xb_add(&bar[XB_XCNT(b.x)], 1u);
    return b;
}
__device__ __forceinline__ void xcd_barrier_complete(unsigned* bar, unsigned x, unsigned& nloc, unsigned& nx) {
    const unsigned G = gridDim.x * gridDim.y * gridDim.z;
    unsigned sum, cnt, mine, sp = 0u;
    for (;;) {
        sum = 0u; cnt = 0u; mine = 0u;
#pragma unroll
        for (unsigned j = 0; j < 16; ++j) { const unsigned c = xb_ld(&bar[XB_XCNT(j)]); sum += c; cnt += (c > 0u) ? 1u : 0u; mine = (j == x) ? c : mine; }
        if (sum == G) break;
        __builtin_amdgcn_s_sleep(1);
        if ((++sp & 255u) == 0u) { if (xb_ld(&bar[XB_TMO])) break; if (sp > XB_SPIN_CAP) { atomicAdd(&bar[XB_TMO], 1u); break; } }
    }
    nloc = mine > 0u ? mine : 1u; nx = cnt > 0u ? cnt : 1u;
}
__device__ __forceinline__ void xcd_barrier(const XcdBarrier& b) {
    asm volatile("s_waitcnt vmcnt(0)" ::: "memory");
    __syncthreads();
    if (threadIdx.x == 0) {
        unsigned* bar = b.bar; unsigned bx_ = b.x;
        asm volatile("" : "+s"(bar), "+s"(bx_));
        __builtin_amdgcn_s_waitcnt(0);
        unsigned nloc = b.st[0], nx = b.st[1];
        if (nloc == 0u) { xcd_barrier_complete(bar, bx_, nloc, nx); b.st[0] = nloc; b.st[1] = nx; }
        const unsigned old = xb_add(&bar[XB_XSUB(bx_)], 1u);
        const unsigned gen = old / nloc;
        if (old + 1u == (gen + 1u) * nloc) {
            __builtin_amdgcn_fence(__ATOMIC_RELEASE, "agent");
            asm volatile("s_waitcnt vmcnt(0)" ::: "memory");
            const unsigned og = xb_add(&bar[XB_TOP], 1u);
            const unsigned tg = og / nx;
            if (og + 1u == (tg + 1u) * nx) xb_add(&bar[XB_TOPGEN], 1u);
            else XB_SPIN(xb_ld(&bar[XB_TOPGEN]) == tg, bar);
            __builtin_amdgcn_fence(__ATOMIC_ACQUIRE, "agent");
            xb_add(&bar[XB_XGEN(bx_)], 1u);
            asm volatile("s_waitcnt vmcnt(0)" ::: "memory");
        } else {
            XB_SPIN(xb_ld(&bar[XB_XGEN(bx_)]) == gen, bar);
            __builtin_amdgcn_fence(__ATOMIC_ACQUIRE, "agent");
            asm volatile("s_waitcnt vmcnt(0)" ::: "memory");
        }
    }
    __syncthreads();
}

struct Args { const float* in[20]; float* out; unsigned char* ws; };
typedef const __attribute__((address_space(4))) Args* CArgs;
__device__ __forceinline__ CArgs launder(CArgs p) { asm volatile("" : "+s"(p)); return p; }
__device__ __forceinline__ Args load_args(CArgs p) { Args a;
#pragma unroll
    for (int i = 0; i < 20; ++i) a.in[i] = p->in[i];
    a.out = p->out; a.ws = p->ws; return a; }
constexpr int NWAVES = 8;
__device__ __forceinline__ int tid_now() { int t = threadIdx.x; asm volatile("" : "+v"(t)); return t; }
__device__ __forceinline__ float shfl_xor_l(float v, int o, int lane) { return __int_as_float(__builtin_amdgcn_ds_bpermute((lane ^ o) << 2, __float_as_int(v))); }
__device__ __forceinline__ float wave_sum(float v, int lane) {
#pragma unroll
    for (int o = 1; o < 64; o <<= 1) v += shfl_xor_l(v, o, lane);
    return v;
}
__device__ __forceinline__ float lam_init_of(int l) { return 0.8f - 0.6f * expf(-0.3f * (float)l); }
__device__ __forceinline__ int t5_bucket(int n) {
    if (n < 16) return n;
    const float v = logf((float)n / 16.0f) / 2.0794415416798357f * 16.0f;
    const int lg = 16 + (int)v; return lg < 31 ? lg : 31;
}
__device__ __forceinline__ void p0_transpose_item(const float* W, int K, int N, bf16_t* WT, int drow0, float scale, LAS float* scr, int kb, int nb, int lane) {
    const int k0 = 64 * kb, n0 = 32 * nb;
#pragma unroll 8
    for (int i = 0; i < 32; ++i) { const int kk = 2 * i + (lane >> 5); scr[kk * 33 + (lane & 31)] = W[(size_t)(k0 + kk) * N + n0 + (lane & 31)] * scale; }
    LDS_WAIT(); asm volatile("" ::: "memory");
    const int c = lane & 7;
#pragma unroll
    for (int j = 0; j < 4; ++j) { const int n = (lane >> 3) + 8 * j; const LAS float* s = scr + (8 * c) * 33 + n;
        u32x4 o; o.x = pk2(s[0 * 33], s[1 * 33]); o.y = pk2(s[2 * 33], s[3 * 33]); o.z = pk2(s[4 * 33], s[5 * 33]); o.w = pk2(s[6 * 33], s[7 * 33]);
        *(u32x4*)(WT + (size_t)(drow0 + n) * K + k0 + 8 * c) = o; }
    LDS_WAIT(); asm volatile("" ::: "memory");
}

__device__ __forceinline__ void p0_transpose64(const float* W, int K, int N, bf16_t* WT, int drow0, float scale, LAS unsigned* scr, int kb, int nb, int lane) {
    const int k0 = 64 * kb, n0 = 64 * nb, q = lane & 15, kk = lane >> 4;
    f32x4 v[16];
#pragma unroll
    for (int t = 0; t < 16; ++t) { const int k = 8 * (t >> 1) + 2 * kk + (t & 1); v[t] = *(const f32x4*)(W + (size_t)(k0 + k) * N + n0 + 4 * q); }
#pragma unroll
    for (int u = 0; u < 8; ++u)
#pragma unroll
        for (int i = 0; i < 4; ++i) scr[(4 * q + i) * 33 + 4 * u + kk] = cvt_pk_bf16(v[2 * u][i] * scale, v[2 * u + 1][i] * scale);
    LDS_WAIT(); asm volatile("" ::: "memory");
    const int nr = lane >> 3, c = lane & 7;
#pragma unroll
    for (int p = 0; p < 8; ++p) { const int n = 8 * p + nr; const LAS unsigned* s_ = scr + n * 33 + 4 * c;
        u32x4 o; o.x = s_[0]; o.y = s_[1]; o.z = s_[2]; o.w = s_[3];
        *(u32x4*)(WT + (size_t)(drow0 + n) * K + k0 + 8 * c) = o; }
    LDS_WAIT(); asm volatile("" ::: "memory");
}

__device__ __forceinline__ void p0_transpose64_f8(const float* W, int K, int N, unsigned char* WT, int drow0, float scale, LAS unsigned* scr, int kb, int nb, int lane) {
    const int k0 = 64 * kb, n0 = 64 * nb, q = lane & 15, kk = lane >> 4;
    f32x4 v[16];
#pragma unroll
    for (int t = 0; t < 16; ++t) { const int k = 16 * (t >> 2) + 4 * kk + (t & 3); v[t] = *(const f32x4*)(W + (size_t)(k0 + k) * N + n0 + 4 * q); }
#pragma unroll
    for (int u = 0; u < 4; ++u)
#pragma unroll
        for (int i = 0; i < 4; ++i) scr[(4 * q + i) * 17 + 4 * u + kk] = pk4_fp8(v[4 * u][i] * scale, v[4 * u + 1][i] * scale, v[4 * u + 2][i] * scale, v[4 * u + 3][i] * scale);
    LDS_WAIT(); asm volatile("" ::: "memory");
    const int nr = lane >> 2, c = lane & 3;
#pragma unroll
    for (int p = 0; p < 4; ++p) { const int n = 16 * p + nr; const LAS unsigned* s_ = scr + n * 17 + 4 * c;
        u32x4 o; o.x = s_[0]; o.y = s_[1]; o.z = s_[2]; o.w = s_[3];
        *(u32x4*)(WT + (size_t)(drow0 + n) * K + k0 + 16 * c) = o; }
    LDS_WAIT(); asm volatile("" ::: "memory");
}

template <int MODE>
__device__ __forceinline__ void row_pass(CArgs ap, int l, int vcu, int G, const LAS int* toffl = nullptr) {
    ap = launder(ap); const int tid_ = tid_now(), lane = tid_ & 63, wave = __builtin_amdgcn_readfirstlane(tid_ >> 6); const Args a = load_args(ap);
    unsigned char* ws = a.ws;
    const float* mod = (const float*)(ws + WS_MOD);
    const bf16_t* Y = (const bf16_t*)(ws + WS_Y); const bf16_t* YS = (const bf16_t*)(ws + WS_YS); bf16_t* H = (bf16_t*)(ws + WS_H);
    const float* xin = (MODE == 0 || (MODE == 1 && l == 0)) ? a.in[0] : a.out;
    const bool need_h = (MODE != 2) || (l + 1 < DEPTH);
    const int lh = (MODE == 2) ? l + 1 : l;
    const float* gpre = (MODE == 1) ? a.in[7] + (size_t)l * D : a.in[5] + (size_t)(lh < DEPTH ? lh : 0) * D;
    const float* gpost = (MODE == 1) ? a.in[6] + (size_t)l * D : a.in[8] + (size_t)l * D;
    const int gw = vcu * NWAVES + wave, NGW = G * NWAVES, RPW = (M + NGW - 1) / NGW;
    int m0 = gw * RPW, m1 = m0 + RPW; if (m1 > M) m1 = M;
    f32x4 a_r[4], a_h[4], s_h[4]; int curb = -1;
    for (int m = m0; m < m1; ++m) {
        const int b = m / SEQ;
        if (b != curb) { curb = b;
            const float* mb = mod + (size_t)((l * BATCH + b) * 6) * D; const float* mh = mod + (size_t)(((lh < DEPTH ? lh : 0) * BATCH + b) * 6) * D;
#pragma unroll
            for (int j = 0; j < 4; ++j) { const int c = 4 * lane + 256 * j;
                if (MODE == 1) { a_r[j] = *(const f32x4*)(mb + 2 * D + c) * *(const f32x4*)(gpost + c); a_h[j] = *(const f32x4*)(gpre + c) * (*(const f32x4*)(mb + 4 * D + c) + 1.0f); s_h[j] = *(const f32x4*)(mb + 3 * D + c); }
                else { if (MODE == 2) a_r[j] = *(const f32x4*)(mb + 5 * D + c) * *(const f32x4*)(gpost + c);
                       a_h[j] = *(const f32x4*)(gpre + c) * (*(const f32x4*)(mh + 1 * D + c) + 1.0f); s_h[j] = *(const f32x4*)(mh + 0 * D + c); } } }
        f32x4 xv[4];
#pragma unroll
        for (int j = 0; j < 4; ++j) xv[j] = *(const f32x4*)(xin + (size_t)m * D + 4 * lane + 256 * j);
        if (MODE != 0) {
            f32x4 yv[4];
            int srow[TOPK];
            if (MODE == 2) { const u32x4 sp = *(const u32x4*)(ws + WS_SPOS + (size_t)m * TOPK * 4);
                srow[0] = toffl[sp.x >> 16] * 256 + (int)(sp.x & 0xffffu); srow[1] = toffl[sp.y >> 16] * 256 + (int)(sp.y & 0xffffu);
                srow[2] = toffl[sp.z >> 16] * 256 + (int)(sp.z & 0xffffu); srow[3] = toffl[sp.w >> 16] * 256 + (int)(sp.w & 0xffffu); }
            if (MODE == 1) {
#pragma unroll
                for (int j = 0; j < 4; ++j) { const u32x2 w = *(const u32x2*)(Y + (size_t)m * D + 4 * lane + 256 * j); yv[j] = (f32x4){bf_lo(w.x), bf_hi(w.x), bf_lo(w.y), bf_hi(w.y)}; }
            } else {
#pragma unroll
                for (int j = 0; j < 4; ++j) { yv[j] = (f32x4){0.f, 0.f, 0.f, 0.f};
#pragma unroll
                    for (int k = 0; k < TOPK; ++k) { const u32x2 w = *(const u32x2*)(YS + (size_t)srow[k] * D + 4 * lane + 256 * j); yv[j] += (f32x4){bf_lo(w.x), bf_hi(w.x), bf_lo(w.y), bf_hi(w.y)}; } }
            }
            float ss = 0.f;
#pragma unroll
            for (int j = 0; j < 4; ++j) ss += (yv[j].x * yv[j].x + yv[j].y * yv[j].y) + (yv[j].z * yv[j].z + yv[j].w * yv[j].w);
            const float r = 1.0f / sqrtf(wave_sum(ss, lane) * (1.0f / D) + NORM_EPS);
#pragma unroll
            for (int j = 0; j < 4; ++j) { xv[j] = xv[j] + a_r[j] * (yv[j] * r); *(f32x4*)(a.out + (size_t)m * D + 4 * lane + 256 * j) = xv[j]; }
        }
        if (need_h) {
            float ss = 0.f;
#pragma unroll
            for (int j = 0; j < 4; ++j) ss += (xv[j].x * xv[j].x + xv[j].y * xv[j].y) + (xv[j].z * xv[j].z + xv[j].w * xv[j].w);
            const float r = 1.0f / sqrtf(wave_sum(ss, lane) * (1.0f / D) + NORM_EPS);
#pragma unroll
            for (int j = 0; j < 4; ++j) { const f32x4 h = (xv[j] * r) * a_h[j] + s_h[j]; u32x2 w; w.x = cvt_pk_bf16(h.x, h.y); w.y = cvt_pk_bf16(h.z, h.w);
                *(u32x2*)(H + (size_t)m * D + 4 * lane + 256 * j) = w;
                *(unsigned*)(ws + (MODE == 1 ? WS_H8 : WS_H8M) + (size_t)m * D + 4 * lane + 256 * j) = pk4_fp8(h.x * F8_SH, h.y * F8_SH, h.z * F8_SH, h.w * F8_SH); }
        }
    }
}

__device__ __forceinline__ void diff_combine(CArgs ap, int l, int vcu, int G) {
    ap = launder(ap); const int tid_ = tid_now(), lane = tid_ & 63, wave = __builtin_amdgcn_readfirstlane(tid_ >> 6);
    unsigned char* ws = ap->ws; struct { const float* in[14]; } a; a.in[13] = ap->in[13];
    const bf16_t* O1 = (const bf16_t*)(ws + WS_OD); const bf16_t* O2 = O1 + (size_t)M * 512; bf16_t* OB = (bf16_t*)(ws + WS_OB);
    const float lam = ((const float*)(ws + WS_LAM))[l]; const float post = 1.0f - lam_init_of(l);
    const float* g = a.in[13] + (size_t)l * 128 + (8 * lane) % 128;
    float gv[8];
#pragma unroll
    for (int i = 0; i < 8; ++i) gv[i] = g[i] * post;
    const int gw = vcu * NWAVES + wave, NGW = G * NWAVES;
    for (int m = gw; m < M; m += NGW) {
        const u32x4 p = *(const u32x4*)(O1 + (size_t)m * 512 + 8 * lane), q = *(const u32x4*)(O2 + (size_t)m * 512 + 8 * lane);
        float o[8];
        o[0] = bf_lo(p.x) - lam * bf_lo(q.x); o[1] = bf_hi(p.x) - lam * bf_hi(q.x); o[2] = bf_lo(p.y) - lam * bf_lo(q.y); o[3] = bf_hi(p.y) - lam * bf_hi(q.y);
        o[4] = bf_lo(p.z) - lam * bf_lo(q.z); o[5] = bf_hi(p.z) - lam * bf_hi(q.z); o[6] = bf_lo(p.w) - lam * bf_lo(q.w); o[7] = bf_hi(p.w) - lam * bf_hi(q.w);
        float ss = 0.f;
#pragma unroll
        for (int i = 0; i < 8; ++i) ss += o[i] * o[i];
        ss += shfl_xor_l(ss, 1, lane); ss += shfl_xor_l(ss, 2, lane); ss += shfl_xor_l(ss, 4, lane); ss += shfl_xor_l(ss, 8, lane);
        const float r = 1.0f / sqrtf(ss * (1.0f / 128.0f) + SUBLN_EPS);
        u32x4 w; w.x = cvt_pk_bf16(o[0] * r * gv[0], o[1] * r * gv[1]); w.y = cvt_pk_bf16(o[2] * r * gv[2], o[3] * r * gv[3]);
        w.z = cvt_pk_bf16(o[4] * r * gv[4], o[5] * r * gv[5]); w.w = cvt_pk_bf16(o[6] * r * gv[6], o[7] * r * gv[7]);
        *(u32x4*)(OB + (size_t)m * 512 + 8 * lane) = w;
    }
}

__device__ __forceinline__ void topk_lists(CArgs ap, int l, int G, volatile LAS unsigned* LW) {
    ap = launder(ap);
    unsigned char* ws = ap->ws;
    const float* LOG = (const float*)(ws + WS_LOG); int* LIST = (int*)(ws + WS_LIST); float* WSLOT = (float*)(ws + WS_WSLOT);
    unsigned* CNT = (unsigned*)(ws + WS_CTL) + CW_CNT + l * NE;
    int tid = threadIdx.x; asm volatile("" : "+v"(tid)); const int TPW = (M + G - 1) / G;
    for (int base = blockIdx.x * TPW, done = 0; done < TPW; done += 512) {
        if (tid < NE) LW[LW_LCNT + tid] = 0u;
        __syncthreads();
        const int m = base + done + tid; const bool act = (done + tid < TPW) && (m < M);
        int ek[TOPK]; float wk[TOPK]; unsigned lp[TOPK];
        if (act) {
            float v[NE];
#pragma unroll
            for (int q = 0; q < NE / 4; ++q) { const f32x4 t = *(const f32x4*)(LOG + (size_t)m * NE + 4 * q); v[4 * q] = t.x; v[4 * q + 1] = t.y; v[4 * q + 2] = t.z; v[4 * q + 3] = t.w; }
            unsigned taken = 0u;
#pragma unroll
            for (int k = 0; k < TOPK; ++k) { float best = -INFINITY; int bi = 0;
#pragma unroll
                for (int e = 0; e < NE; ++e) { const bool ok = !((taken >> e) & 1u) && (v[e] > best); best = ok ? v[e] : best; bi = ok ? e : bi; }
                taken |= 1u << bi; ek[k] = bi; wk[k] = best; }
            float s = 0.f; const float mx = wk[0];
#pragma unroll
            for (int k = 0; k < TOPK; ++k) { wk[k] = expf(wk[k] - mx > -80.f ? wk[k] - mx : -80.f); s += wk[k]; }
#pragma unroll
            for (int k = 0; k < TOPK; ++k) { wk[k] = wk[k] / s; lp[k] = __hip_atomic_fetch_add((LAS unsigned*)&LW[LW_LCNT + ek[k]], 1u, __ATOMIC_RELAXED, __HIP_MEMORY_SCOPE_WORKGROUP); }
        }
        __syncthreads();
        if (tid < NE) { const unsigned c = LW[LW_LCNT + tid]; LW[LW_LBASE + tid] = c ? __hip_atomic_fetch_add(CNT + tid, c, RLX_AGENT) : 0u; }
        __syncthreads();
        if (act) {
#pragma unroll
            for (int k = 0; k < TOPK; ++k) { const unsigned pos = LW[LW_LBASE + ek[k]] + lp[k]; __hip_atomic_store(LIST + (size_t)ek[k] * CAP + pos, m * TOPK + k, RLX_AGENT);
                __hip_atomic_store((float*)(ws + WS_LISTW) + (size_t)ek[k] * CAP + pos, wk[k], RLX_AGENT);
                ((unsigned*)(ws + WS_SPOS))[(size_t)m * TOPK + k] = ((unsigned)ek[k] << 16) | pos; }
        }
        __syncthreads();
    }
}

__device__ __forceinline__ void p0_prologue(CArgs ap, LAS unsigned char* lds, int vcu, int G) {
    ap = launder(ap); const Args a = load_args(ap);
    unsigned char* ws = a.ws; const int tid = tid_now(), lane = tid & 63, wave = __builtin_amdgcn_readfirstlane(tid >> 6);
    LAS float* ca = (LAS float*)(lds + RING_OFF); LAS float* red = (LAS float*)(lds + RING_OFF + 8192);
    for (int i = tid; i < BATCH * D; i += NWAVES * 64) { const float v = a.in[1][i]; ca[i] = v / (1.0f + expf(-v)); }
    __syncthreads();
    float* mod = (float*)(ws + WS_MOD);
    for (int it = blockIdx.x; it < DEPTH * (6 * D / 32); it += G) {
        const int l = it / (6 * D / 32), cg = it % (6 * D / 32), c = tid & 31, kc = tid >> 5;
        const float* w = a.in[3] + (size_t)l * D * 6 * D + cg * 32 + c;
        float s0 = 0.f, s1 = 0.f;
#pragma unroll 8
        for (int k = kc * 64; k < kc * 64 + 64; ++k) { const float wv = w[(size_t)k * 6 * D]; s0 += ca[k] * wv; s1 += ca[D + k] * wv; }
        red[(kc * 32 + c) * 2] = s0; red[(kc * 32 + c) * 2 + 1] = s1;
        __syncthreads();
        if (tid < 64) { const int cc = tid & 31, b = tid >> 5; float s = 0.f;
#pragma unroll
            for (int k = 0; k < 16; ++k) s += red[(k * 32 + cc) * 2 + b];
            mod[(size_t)(l * BATCH + b) * 6 * D + cg * 32 + cc] = s + a.in[4][(size_t)l * 6 * D + cg * 32 + cc]; }
        __syncthreads();
    }
    if (blockIdx.x == 0 && wave == 0) {
        for (int l = 0; l < DEPTH; ++l) { const float* lp = a.in[12] + (size_t)l * 256;
            const float s01 = wave_sum(lp[lane] * lp[64 + lane], lane), s23 = wave_sum(lp[128 + lane] * lp[192 + lane], lane);
            if (lane == 0) ((float*)(ws + WS_LAM))[l] = expf(s01) - expf(s23) + lam_init_of(l); }
    }
    { u32x4* z = (u32x4*)(ws + WS_WR); const u32x4 zero = {0u, 0u, 0u, 0u};
      for (int l = 0; l < DEPTH; ++l) for (int i = blockIdx.x * NWAVES * 64 + tid; i < 224 * D * 2 / 16; i += G * NWAVES * 64) z[(size_t)l * (256 * D * 2 / 16) + 32 * D * 2 / 16 + i] = zero; }
    LAS float* scr = (LAS float*)(lds + RING_OFF + wave * 16384); LAS unsigned* scru = (LAS unsigned*)scr;
    const int gw = vcu * NWAVES + wave, NGW = G * NWAVES;
    constexpr int I_IN = 16 * (INW / 64), I_O = 8 * (D / 64), I_R = 16, I_GU1 = 16 * (2 * FF / 64), I_GU = NE * I_GU1, I_D1 = 16 * (D / 64), I_DN = NE * I_D1;
    constexpr int I_LAYER = I_IN + 2 * I_O + I_R + I_GU + I_DN;
    for (int it = gw; it < DEPTH * I_LAYER; it += NGW) {
        const int l = it / I_LAYER; int r = it - l * I_LAYER;
        if (r < I_IN) { const int nblk = INW / 64, kb = r / nblk, nb = r % nblk, n0 = 64 * nb;
            const float sc = (n0 < C_KA || (n0 >= C_QB && n0 < C_KB)) ? QSCALE : 1.0f;
            if (n0 < C_GZA) p0_transpose64(a.in[9] + (size_t)l * D * INW, D, INW, (bf16_t*)(ws + WS_WIN) + (size_t)l * C_GZA * D, n0, sc, scru, kb, nb, lane);
            else p0_transpose64_f8(a.in[9] + (size_t)l * D * INW, D, INW, ws + WS_WIN8 + (size_t)l * (INW - C_GZA) * D, n0 - C_GZA, F8_SW, scru, kb, nb, lane);
            continue; }
        r -= I_IN;
        if (r < 2 * I_O) { const int half = r / I_O; r -= half * I_O; const int nblk = D / 64, kb = r / nblk, nb = r % nblk;
            p0_transpose64(a.in[10] + (size_t)l * D * D + (size_t)half * 512 * D, 512, D, (bf16_t*)(ws + (half ? WS_WOB : WS_WOA)) + (size_t)l * D * 512, 64 * nb, 1.0f, scru, kb, nb, lane); continue; }
        r -= 2 * I_O;
        if (r < I_R) { p0_transpose_item(a.in[14] + (size_t)l * D * NE, D, NE, (bf16_t*)(ws + WS_WR) + (size_t)l * 256 * D, 0, 1.0f, scr, r, 0, lane); continue; }
        r -= I_R;
        if (r < I_GU) { const int e = r / I_GU1; r -= e * I_GU1; const int nblk = 2 * FF / 64, kb = r / nblk, nb = r % nblk, n0 = 64 * nb;
            const int j = n0 % FF, drow = (j / 128) * 256 + (n0 >= FF ? 128 : 0) + (j % 128);
            p0_transpose64_f8(a.in[16] + ((size_t)l * NE + e) * D * 2 * FF, D, 2 * FF, ws + WS_WGU + ((size_t)l * NE + e) * 2 * FF * D, drow, F8_SW, scru, kb, nb, lane); continue; }
        r -= I_GU;
        { const int e = r / I_D1; r -= e * I_D1; const int nblk = D / 64, kb = r / nblk, nb = r % nblk;
            p0_transpose64_f8(a.in[18] + ((size_t)l * NE + e) * FF * D, FF, D, ws + WS_WD + ((size_t)l * NE + e) * D * FF, 64 * nb, F8_SW, scru, kb, nb, lane); }
    }
}

__device__ __forceinline__ void attn_fill_tab(const float* rel, int col, bool swa, LAS float* tab) {
    for (int j = tid_now(); j < attn_body::TAB_N; j += NWAVES * 64) {
        const int dist = j - 255; float v;
        if (dist < 0) v = -INFINITY;
        else if (swa) v = dist >= 128 ? -INFINITY : rel[t5_bucket(dist) * NBH + col] * LOG2E;
        else v = (rel[t5_bucket(dist < 127 ? dist : 127) * NBH + col] - rel[31 * NBH + col]) * LOG2E;
        tab[j] = v;
    }
}
#ifndef MK_ADBG
#define MK_ADBG 0
#endif
__device__ __forceinline__ void attn_phase(CArgs ap, int l, char* lds, int vcu, int G, int rep = 0) {
    ap = launder(ap);
    unsigned char* ws = ap->ws; struct { const float* in[14]; } a; a.in[2] = ap->in[2]; a.in[11] = ap->in[11]; a.in[13] = ap->in[13];
    const int dbg = rep ? MK_ADBG : 0;
    const bf16_t* P = (const bf16_t*)(ws + WS_P); bf16_t* OA = (bf16_t*)(ws + (rep ? WS_YA : WS_OA)); bf16_t* OD = (bf16_t*)(ws + (rep ? WS_YA + 32 * MiB : WS_OD)); bf16_t* OBo = (bf16_t*)(ws + (rep ? WS_Y : WS_OB));
    LAS float* tab = (LAS float*)((LAS char*)lds + attn_body::LDS_TAB);
    const float* rel = a.in[2];
    for (int v = vcu; v < 256; v += G) {
        const int u = v & 31, h = (v >> 5) & 3, b = v >> 7;
        attn_fill_tab(rel, HA + h, false, tab);
        const float lam = ((const float*)(ws + WS_LAM))[l], post = 1.0f - lam_init_of(l);
        const float* gsub = a.in[13] + (size_t)l * 128;
#pragma unroll 1
        for (int i = 0; i < 4; ++i) {
            const int mp = i & 1, qb = (i >> 1) ? u : 63 - u;
            const size_t row0 = (size_t)b * SEQ + (size_t)qb * 256;
            const bf16_t* Kp = P + (size_t)b * SEQ * PITCH + C_KB + h * 128 + mp * 64;
            const bf16_t* Vp = P + (size_t)b * SEQ * PITCH + C_VB + h * 128;
            bf16_t* O1 = OD + row0 * 512 + h * 128;
            attn_body::attn_unit<8, PITCH, 512, 2>(P + row0 * PITCH + C_QB + h * 128 + mp * 64, Kp, Vp, mp ? OBo + row0 * 512 + h * 128 : O1,
                                                   (dbg & 64) ? 4 : 4 * (qb + 1), -30.0f, -INFINITY, lds, dbg, mp ? O1 : nullptr, lam, gsub, post);
        }
#pragma unroll 1
        for (int i = 0; i < 4; ++i) {
            const int id = v * 4 + i, qb = id & 63, ha = (id >> 6) & 7, bb = id >> 9;
            if (i == 0) attn_fill_tab(rel, ha, true, tab);
            const size_t row0 = (size_t)bb * SEQ + (size_t)qb * 256, krow = row0 - (qb ? 128 : 0);
            const float sink2 = a.in[11][l * HA + ha] * LOG2E;
            attn_body::attn_unit<8, PITCH, 512, 1>(P + row0 * PITCH + C_QA + ha * 64, P + krow * PITCH + C_KA + (ha >> 2) * 64, P + krow * PITCH + C_VA + (ha >> 2) * 64,
                                                   OA + row0 * 512 + ha * 64, qb ? 6 : 4, sink2, sink2, lds, dbg);
        }
    }
}

#ifndef MK_PROBE
#define MK_PROBE 0
#endif
#ifndef MK_PFA
#define MK_PFA 0
#endif
constexpr bool PFA_ON = MK_PFA != 0;
#ifndef MK_DUP
#define MK_DUP 0
#endif
constexpr int CW_DIG = 12288;
__device__ __forceinline__ void probe_rows(CArgs ap, const bf16_t* base, int nrows_total, bool by_tile, const LAS int* toff, const LAS int* cl, int vcu, int G) {
    unsigned* DIG = (unsigned*)(launder(ap)->ws + WS_CTL) + CW_DIG;
    const int tid = tid_now(), lane = tid & 63, wave = tid >> 6;
    if (by_tile) {
        const int ntile = toff[NE];
        for (int gt = vcu; gt < ntile; gt += G) {
            int e = 0;
            for (int k = 16; k >= 1; k >>= 1) if (toff[e + k] <= gt) e += k;
            const int rt = gt - toff[e]; int nv = cl[e] - rt * 256; nv = nv > 256 ? 256 : nv;
            unsigned s = 0u;
            for (int r = wave; r < nv; r += NWAVES) { const u32x4* p = (const u32x4*)(base + ((size_t)gt * 256 + r) * 1024 + lane * 16); const u32x4 a = p[0], b = p[1];
                s += (a.x & 0xffffu) + (a.x >> 16) + (a.y & 0xffffu) + (a.y >> 16) + (a.z & 0xffffu) + (a.z >> 16) + (a.w & 0xffffu) + (a.w >> 16);
                s += (b.x & 0xffffu) + (b.x >> 16) + (b.y & 0xffffu) + (b.y >> 16) + (b.z & 0xffffu) + (b.z >> 16) + (b.w & 0xffffu) + (b.w >> 16); }
            __hip_atomic_fetch_add(DIG + e, s, RLX_AGENT);
        }
    } else {
        for (int r = vcu * NWAVES + wave; r < nrows_total; r += G * NWAVES) { const u32x4* p = (const u32x4*)(base + (size_t)r * 1024 + lane * 16); const u32x4 a = p[0], b = p[1];
            unsigned s = (a.x & 0xffffu) + (a.x >> 16) + (a.y & 0xffffu) + (a.y >> 16) + (a.z & 0xffffu) + (a.z >> 16) + (a.w & 0xffffu) + (a.w >> 16);
            s += (b.x & 0xffffu) + (b.x >> 16) + (b.y & 0xffffu) + (b.y >> 16) + (b.z & 0xffffu) + (b.z >> 16) + (b.w & 0xffffu) + (b.w >> 16);
            __hip_atomic_fetch_add(DIG + (r & 31), s, RLX_AGENT); }
    }
}
__device__ __forceinline__ void probe_lists(CArgs ap, int l, int vcu, int G) {
    unsigned char* ws = launder(ap)->ws; unsigned* DIG = (unsigned*)(ws + WS_CTL) + CW_DIG; const int* LIST = (const int*)(ws + WS_LIST);
    const int tid = tid_now();
    for (int e = vcu; e < NE; e += G) { const int cnt = (int)__hip_atomic_load((unsigned*)(ws + WS_CTL) + CW_CNT + l * NE + e, RLX_AGENT);
        unsigned s1 = 0u, s2 = 0u;
        for (int i = tid; i < cnt; i += NWAVES * 64) { const unsigned v = (unsigned)LIST[(size_t)e * CAP + i]; s1 += v; s2 += (v * 2654435761u) >> 9; }
        __hip_atomic_fetch_add(DIG + e, s1, RLX_AGENT); __hip_atomic_fetch_add(DIG + 32 + e, s2 + (unsigned)cnt * 7919u, RLX_AGENT); }
}
__device__ __forceinline__ void probe_dump(CArgs ap) {
    const CArgs aq = launder(ap); const unsigned* DIG = (const unsigned*)(aq->ws + WS_CTL) + CW_DIG; float* out = aq->out; const int tid = tid_now();
    if (blockIdx.x == 0 && tid < 64) out[tid] = (float)(__hip_atomic_load((unsigned*)DIG + tid, RLX_AGENT) & 0x7fffffu) * (1.0f / 65536.0f);
}

__device__ __forceinline__ void probe_region(CArgs ap, size_t off, size_t nwords, int G) {
    unsigned char* ws = launder(ap)->ws; unsigned* DIG = (unsigned*)(ws + WS_CTL) + CW_DIG; const unsigned* src = (const unsigned*)(ws + off);
    const int t = tid_now(); unsigned sacc = 0u;
    for (size_t i = (size_t)blockIdx.x * NWAVES * 64 + t; i < nwords; i += (size_t)G * NWAVES * 64) { const unsigned v = src[i]; sacc += (v & 0xffffu) + (v >> 16); }
    __hip_atomic_fetch_add(DIG + (t & 63), sacc, RLX_AGENT);
}
#define PROBE_AT(id, off, nwords) do { if (MK_PROBE == (id)) { probe_region(ap, off, nwords, G); GRID_BAR(); probe_dump(ap); return; } } while (0)

__global__ void __launch_bounds__(NWAVES * 64, 2) mk_fwd(Args a) {
    extern __shared__ __attribute__((aligned(16))) unsigned char lds_raw[];
    LAS unsigned char* lds = (LAS unsigned char*)lds_raw;
    volatile LAS unsigned* LW = (volatile LAS unsigned*)(lds + LDSCTL_OFF);
    const int tid = tid_now();
    const int G = gridDim.x; const int bx = blockIdx.x; const int vcu = (G % 8 == 0) ? (bx % 8) * (G / 8) + bx / 8 : bx;
    const CArgs ap = (CArgs)__builtin_amdgcn_kernarg_segment_ptr();
    for (int u = tid; u < (LDS_BYTES - LDSCTL_OFF) / 4; u += NWAVES * 64) ((LAS unsigned*)(lds + LDSCTL_OFF))[u] = 0u;
    __syncthreads();
    XcdBarrier bar = xcd_barrier_post((unsigned*)(ap->ws + WS_CTL) + CW_BAR, LW + 8);
#define GRID_BAR() xcd_barrier(bar)

#ifndef PH_MASK
#define PH_MASK 0xFFFF
#endif
#define PH(k) ((PH_MASK >> (k)) & 1)
#pragma unroll 1
    for (int rep = 0; rep < ((MK_DUP & 1) ? 2 : 1); ++rep) {
    if (PH(0)) p0_prologue(ap, lds, vcu, G);
    GRID_BAR(); }
    PROBE_AT(10, WS_MOD, (size_t)DEPTH * BATCH * 6 * D);
    PROBE_AT(11, WS_WIN, (size_t)DEPTH * INW * D / 2);
    PROBE_AT(12, WS_WOA, (size_t)4 * MiB / 4);
    if (PH(0)) row_pass<0>(ap, 0, vcu, G);
    GRID_BAR();
    PROBE_AT(13, WS_H, (size_t)M * D / 2);

#pragma unroll 1
    for (int l = 0; l < DEPTH; ++l) {
#pragma unroll 1
        for (int rep = 0; rep < ((MK_DUP & 2) ? 2 : 1); ++rep) {
        if (PH(1)) { unsigned char* ws = launder(ap)->ws; bf16_t* H = (bf16_t*)(ws + WS_H); bf16_t* P = (bf16_t*)(ws + WS_P);
          { pg8::Gemm g{H, (const bf16_t*)(ws + WS_WIN) + (size_t)l * C_GZA * D, D, 0, nullptr}; pg8::StaticOrder S; S.init(M, C_GZA, G, bx);
            pg8::EpiBf16 E{P, PITCH, 1.0f};
            pg8::gemm_phase<pg8::EpiBf16, pg8::StaticOrder, false, true>(lds + RING_OFF, g, S, E); }
          { pg8::Gemm g{(const bf16_t*)(ws + WS_H8M), (const bf16_t*)(ws + WS_WIN8 + (size_t)l * (INW - C_GZA) * D), D / 2, 0, nullptr}; pg8::StaticOrder S; S.init(M, INW - C_GZA, G, bx, 1);
            pg8::EpiBf16 E{P + C_GZA, PITCH, 1.0f / (F8_SH * F8_SW)};
            pg8::gemm_phase<pg8::EpiBf16, pg8::StaticOrder, false, true, true>(lds + RING_OFF, g, S, E); } }
        GRID_BAR(); }
        PROBE_AT(14, WS_P, (size_t)M * INW / 2);
#pragma unroll 1
        for (int rep = 0; rep < ((MK_DUP & 4) ? 2 : 1); ++rep) {
        if (PH(2)) attn_phase(ap, l, (char*)lds_raw + RING_OFF, vcu, G, rep);
        GRID_BAR(); }
        PROBE_AT(15, WS_OA, (size_t)M * 512 / 2);
        PROBE_AT(16, WS_OD, (size_t)M * 512);
        PROBE_AT(17, WS_OB, (size_t)M * 512 / 2);
        if (PH(4)) { unsigned char* ws = launder(ap)->ws; bf16_t* P = (bf16_t*)(ws + WS_P); pg8::Gemm g{(const bf16_t*)(ws + WS_OA), (const bf16_t*)(ws + WS_WOA) + (size_t)l * D * 512, 512, 0, nullptr}; pg8::StaticOrder S; S.init(M, D, G, bx);
          pg8::EpiGate<true> E{(bf16_t*)(ws + WS_YA), nullptr, P, C_GZA};
          pg8::gemm_phase<pg8::EpiGate<true>, pg8::StaticOrder, false, true>(lds + RING_OFF, g, S, E); }
        GRID_BAR();
        PROBE_AT(18, WS_YA, (size_t)M * D / 2);
        if (PH(5)) { unsigned char* ws = launder(ap)->ws; bf16_t* P = (bf16_t*)(ws + WS_P); pg8::Gemm g{(const bf16_t*)(ws + WS_OB), (const bf16_t*)(ws + WS_WOB) + (size_t)l * D * 512, 512, 0, nullptr}; pg8::StaticOrder S; S.init(M, D, G, bx);
          pg8::EpiGate<false> E{(bf16_t*)(ws + WS_Y), (const bf16_t*)(ws + WS_YA), P, C_GZB};
          pg8::gemm_phase<pg8::EpiGate<false>, pg8::StaticOrder, false, true>(lds + RING_OFF, g, S, E); }
        GRID_BAR();
        PROBE_AT(19, WS_Y, (size_t)M * D / 2);
        if (PH(6)) row_pass<1>(ap, l, vcu, G);
        if (MK_STOP == 1 || (MK_STOP == 3 && l == 1)) return;
        GRID_BAR();
        if (PH(7)) { const CArgs aq = launder(ap); unsigned char* ws = aq->ws; bf16_t* H = (bf16_t*)(ws + WS_H); pg8::Gemm g{H, (const bf16_t*)(ws + WS_WR) + (size_t)l * 256 * D, D, 0, nullptr}; pg8::StaticOrder S; S.init(M, 256, G, bx);
          pg8::EpiRouter E{(float*)(ws + WS_LOG), aq->in[15] + (size_t)l * NE};
          pg8::gemm_phase<pg8::EpiRouter, pg8::StaticOrder, false, true>(lds + RING_OFF, g, S, E); }
        GRID_BAR();
        if (MK_PROBE == 4 || MK_PROBE == 5) { unsigned char* ws = launder(ap)->ws; unsigned* DIG = (unsigned*)(ws + WS_CTL) + CW_DIG; const unsigned* src = (const unsigned*)(ws + (MK_PROBE == 4 ? WS_LOG : WS_H));
            const int n = MK_PROBE == 4 ? M * NE : M * D / 2; const int t = tid_now(); unsigned sacc = 0u;
            for (int i = blockIdx.x * NWAVES * 64 + t; i < n; i += G * NWAVES * 64) { const unsigned v = src[i]; sacc += (v & 0xffffu) + (v >> 16); }
            __hip_atomic_fetch_add(DIG + (t & 63), sacc, RLX_AGENT); GRID_BAR(); probe_dump(ap); return; }
        if (PH(8)) topk_lists(ap, l, G, LW);
        GRID_BAR();
        if (MK_PROBE == 1) { probe_lists(ap, l, vcu, G); GRID_BAR(); probe_dump(ap); return; }
        { unsigned char* ws = launder(ap)->ws; const int tid = tid_now(); if (tid < NE) LW[LW_CL + tid] = __hip_atomic_load((unsigned*)(ws + WS_CTL) + CW_CNT + l * NE + tid, RLX_AGENT);
          __syncthreads();
          if (tid == 0) { unsigned acc = 0u; for (int e = 0; e < NE; ++e) { LW[LW_TOFF + e] = acc; acc += (LW[LW_CL + e] + 255u) >> 8; } LW[LW_TOFF + NE] = acc; }
          __syncthreads(); }
#pragma unroll 1
        for (int rep = 0; rep < ((MK_DUP & 32) ? 2 : 1); ++rep) {
        if (PH(9)) { const CArgs aq = launder(ap); unsigned char* ws = aq->ws; bf16_t* H = (bf16_t*)(ws + WS_H); pg8::Gemm g{(const bf16_t*)(ws + WS_H8), (const bf16_t*)(ws + WS_WGU + (size_t)l * NE * 2 * FF * D), D / 2, (size_t)2 * FF * D / 2, (const int*)(ws + WS_LIST)};
          pg8::MoeOrder S{(const LAS int*)(lds + LDSCTL_OFF) + LW_TOFF, (const LAS int*)(lds + LDSCTL_OFF) + LW_CL, 2 * FF / 256, G, bx};
          pg8::EpiSwiglu8 E{ws + WS_ACT, aq->in[17] + (size_t)l * NE * 2 * FF};
          pg8::gemm_phase<pg8::EpiSwiglu8, pg8::MoeOrder, true, true, true, PFA_ON>(lds + RING_OFF, g, S, E); }
        GRID_BAR(); }
        if (MK_PROBE == 2) { probe_rows(ap, (const bf16_t*)(launder(ap)->ws + WS_ACT), 0, true, (const LAS int*)(lds + LDSCTL_OFF) + LW_TOFF, (const LAS int*)(lds + LDSCTL_OFF) + LW_CL, vcu, G); GRID_BAR(); probe_dump(ap); return; }
#pragma unroll 1
        for (int rep = 0; rep < ((MK_DUP & 64) ? 2 : 1); ++rep) {
        if (PH(10)) { const CArgs aq = launder(ap); unsigned char* ws = aq->ws; pg8::Gemm g{(const bf16_t*)(ws + WS_ACT), (const bf16_t*)(ws + WS_WD + (size_t)l * NE * D * FF), FF / 2, (size_t)D * FF / 2, nullptr};
          pg8::MoeOrder S{(const LAS int*)(lds + LDSCTL_OFF) + LW_TOFF, (const LAS int*)(lds + LDSCTL_OFF) + LW_CL, D / 256, G, bx};
          pg8::EpiDown E{(bf16_t*)(ws + WS_YS), aq->in[19] + (size_t)l * NE * D, (const float*)(ws + WS_LISTW), 1.0f / (F8_SACT * F8_SW)};
#if defined(MK_NULLEPI)
          if (rep) { pg8::EpiNull EN; pg8::gemm_phase<pg8::EpiNull, pg8::MoeOrder, false, true, true>(lds + RING_OFF, g, S, EN); } else
#endif
          pg8::gemm_phase<pg8::EpiDown, pg8::MoeOrder, false, true, true, PFA_ON>(lds + RING_OFF, g, S, E); }
        GRID_BAR(); }
        if (MK_PROBE == 3) { probe_rows(ap, (const bf16_t*)(launder(ap)->ws + WS_YS), M * TOPK, false, nullptr, nullptr, vcu, G); GRID_BAR(); probe_dump(ap); return; }
        if (PH(11)) row_pass<2>(ap, l, vcu, G, (const LAS int*)(lds + LDSCTL_OFF) + LW_TOFF);
        if (MK_STOP == 2) return;
        if (l + 1 < DEPTH) GRID_BAR();
    }
}

extern "C" void kernel_launch(void* const* d_in, const int* in_sizes, int n_in, void* d_out, int out_size, void* d_ws, size_t ws_size, hipStream_t stream) {
    static int grid = 0;
    if (grid == 0) {
        if (n_in != 20 || in_sizes[0] != M * D || out_size != M * D || ws_size < WS_END) { fprintf(stderr, "kernel_launch: unexpected shapes (n_in %d, in0 %d, out %d, ws %zu < %zu); nothing launched\n", n_in, n_in > 0 ? in_sizes[0] : -1, out_size, ws_size, (size_t)WS_END); grid = -1; return; }
        int dev = 0, cus = 0, per_cu = 0;
        if (hipGetDevice(&dev) != hipSuccess || hipDeviceGetAttribute(&cus, hipDeviceAttributeMultiprocessorCount, dev) != hipSuccess) { grid = -1; return; }
        if (hipFuncSetAttribute((const void*)mk_fwd, hipFuncAttributeMaxDynamicSharedMemorySize, LDS_BYTES) != hipSuccess) { fprintf(stderr, "kernel_launch: hipFuncSetAttribute failed\n"); grid = -1; return; }
        if (hipOccupancyMaxActiveBlocksPerMultiprocessor(&per_cu, (const void*)mk_fwd, NWAVES * 64, LDS_BYTES) != hipSuccess || per_cu < 1)
            fprintf(stderr, "kernel_launch: note: occupancy query reports %d workgroups per CU\n", per_cu);
        (void)hipGetLastError();
        grid = cus > 256 ? 256 : cus;
    }
    if (grid < 0) return;
    if (hipMemsetAsync((char*)d_ws + WS_CTL, 0, CTL_ZERO_BYTES, stream) != hipSuccess) return;
    Args a{};
    for (int i = 0; i < 20; ++i) a.in[i] = (const float*)d_in[i];
    a.out = (float*)d_out; a.ws = (unsigned char*)d_ws;
    hipLaunchKernelGGL(mk_fwd, dim3(grid), dim3(NWAVES * 64), LDS_BYTES, stream, a);
}
```

```cpp
#include <hip/hip_runtime.h>
#include <cstdio>
#include <cstdint>
#include <cmath>

#ifndef MK_STOP
#define MK_STOP 0
#endif

constexpr int BATCH = 2, SEQ = 16384, D = 1024, M = BATCH * SEQ, DEPTH = 2;
constexpr int INW = 4352, PITCH = INW;
constexpr int C_QA = 0, C_KA = 512, C_VA = 640, C_QB = 768, C_KB = 1280, C_VB = 1792, C_GZA = 2304, C_GZB = 3328;
constexpr int NE = 32, TOPK = 4, FF = 1024, CAP = M;
constexpr int NBH = 12, HA = 8;
constexpr float LOG2E = 1.4426950408889634f, QSCALE = 0.125f * LOG2E;
constexpr float NORM_EPS = 1e-6f, SUBLN_EPS = 1e-5f;
constexpr int ACT_ROWS = M * TOPK + NE * 256;

#define LAS __attribute__((address_space(3)))
#define GAS __attribute__((address_space(1)))
typedef unsigned short bf16_t;
typedef short bf16x8 __attribute__((ext_vector_type(8)));
typedef float f32x4 __attribute__((ext_vector_type(4)));
typedef float f32x2 __attribute__((ext_vector_type(2)));
typedef unsigned u32x4 __attribute__((ext_vector_type(4)));
typedef unsigned u32x2 __attribute__((ext_vector_type(2)));
typedef int v4i_t __attribute__((ext_vector_type(4)));
typedef int v8i_t __attribute__((ext_vector_type(8)));
constexpr float F8_SW = 128.0f, F8_SH = 16.0f, F8_SACT = 4.0f, F8_SY = 32.0f, F8_MAX = 448.0f;
__device__ __forceinline__ float f8clamp(float v) { return fminf(fmaxf(v, -F8_MAX), F8_MAX); }
__device__ __forceinline__ unsigned pk4_fp8(float a, float b, float c, float d) { unsigned w = 0u; w = __builtin_amdgcn_cvt_pk_fp8_f32(f8clamp(a), f8clamp(b), w, false); w = __builtin_amdgcn_cvt_pk_fp8_f32(f8clamp(c), f8clamp(d), w, true); return w; }

__device__ __forceinline__ unsigned cvt_pk_bf16(float lo, float hi) { unsigned r; asm volatile("v_cvt_pk_bf16_f32 %0, %1, %2" : "=v"(r) : "v"(lo), "v"(hi)); return r; }
__device__ __forceinline__ float bf_lo(unsigned w) { return __uint_as_float(w << 16); }
__device__ __forceinline__ float bf_hi(unsigned w) { return __uint_as_float(w & 0xffff0000u); }
__device__ __forceinline__ float sigmoidf_(float v) { return __builtin_amdgcn_rcpf(1.0f + __builtin_amdgcn_exp2f(-v * LOG2E)); }

namespace pg8 {
constexpr int BM = 256, BK = 64, HALF = 128, HTB = HALF * BK * 2, STAGE_BYTES = 8 * HTB, NXCD = 8, WGM = 8;
__host__ __device__ __forceinline__ int lds_byte(int r, int c) { const int st = (r >> 4) * 2 + (c >> 5), rr = r & 15, cc = c & 31, ob = rr * 64 + cc * 2; return st * 1024 + (ob ^ (((ob >> 9) & 1) << 5)); }
__host__ __device__ __forceinline__ void stage_rc(int b, int& R, int& C) { const int st = b / 1024, sb = b % 1024, swz = sb ^ (((sb >> 9) & 1) << 5); R = (st >> 1) * 16 + swz / 64; C = (st & 1) * 32 + (swz % 64) / 2; }
__host__ __device__ __forceinline__ int perm32(int rho) { const int n = rho >> 4, i = rho & 15; return 8 * (i >> 2) + 4 * n + (i & 3); }

template <class E, class = void> struct Perm16 { static constexpr bool v = false; };
template <class E> struct Perm16<E, decltype((void)E::PERM16)> { static constexpr bool v = E::PERM16; };
__host__ __device__ __forceinline__ int perm16x(int R) { return 64 * (R >> 5) + 16 * ((R >> 2) & 3) + 4 * ((R >> 4) & 1) + (R & 3); }
struct Unit { int pm, pn, e, lrow, nvalid; };
struct Gemm { const bf16_t* A; const bf16_t* Bt; int K; size_t estride; const int* rows; };

struct StaticOrder {
    int nM, nN, nwg, G, c, skew;
    __device__ void init(int Mr, int N, int G_, int c_, int skew_ = 0) { nM = Mr / BM; nN = N / BM; nwg = nM * nN; G = G_; c = c_; skew = (skew_ && G_ == 256 && nwg == 1024) ? 1 : 0; }
    __device__ bool next(int i, Unit& u) const {
        long L = (long)i * G + c;
        if (skew) { if (c >= 128) { if (i >= 5) return false; L = (c - 128) + 128 * i; } else { if (i >= 3) return false; L = 640 + c + 128 * i; } }
        if (L >= nwg) return false;
        int wgid = (int)L; { const int q = nwg / NXCD, r = nwg % NXCD, xcd = wgid % NXCD, off = wgid / NXCD; wgid = (xcd < r ? xcd * (q + 1) : r * (q + 1) + (xcd - r) * q) + off; }
        const int nig = WGM * nN, gid = wgid / nig, fm = gid * WGM, gsz = (nM - fm) < WGM ? (nM - fm) : WGM;
        u.pm = fm + ((wgid % nig) % gsz); u.pn = (wgid % nig) / gsz; u.e = 0; u.lrow = 0; u.nvalid = 256; return true;
    }
};
struct MoeOrder {
    const LAS int* toff; const LAS int* cl; int nN, G, c;
    __device__ bool next(int i, Unit& u) const {
        const int ntile = toff[NE]; int gt, pn;
        if ((G & 7) == 0) { const int x = c & 7, s = c >> 3, per = G >> 3, t0 = (ntile * x) >> 3, t1 = (ntile * (x + 1)) >> 3, Lx = i * per + s;
            if (Lx >= (t1 - t0) * nN) return false;
            const int q = Lx / nN; gt = t0 + q; pn = Lx - q * nN; }
        else { const int L = i * G + c; if (L >= ntile * nN) return false; gt = L / nN; pn = L - gt * nN; }
        int e = 0;
#pragma unroll
        for (int k = 16; k >= 1; k >>= 1) if (toff[e + k] <= gt) e += k;
        const int rt = gt - toff[e]; int nv = cl[e] - rt * 256; nv = nv > 256 ? 256 : nv;
        u.pm = __builtin_amdgcn_readfirstlane(gt); u.pn = __builtin_amdgcn_readfirstlane(pn); u.e = __builtin_amdgcn_readfirstlane(e);
        u.lrow = __builtin_amdgcn_readfirstlane(e * CAP + rt * 256); u.nvalid = __builtin_amdgcn_readfirstlane(nv); return true;
    }
};

#ifndef MK_NT
#define MK_NT 1
#endif
#if MK_NT
#define NT_STORE(v, p) __builtin_nontemporal_store(v, p)
#else
#define NT_STORE(v, p) (*(p) = (v))
#endif
struct EpiBf16 {
    static constexpr bool PERM = true;
    bf16_t* O; int ldc; float sc;
    __device__ __forceinline__ void operator()(const f32x4 (&acc)[2][2][4][2], const Unit& u, int wr, int wc, int fr, int fq) const {
        const int row0 = u.pm * BM + wr * 64 + fr, col0 = u.pn * BM + wc * 32 + 8 * fq;
#pragma unroll
        for (int ai = 0; ai < 2; ++ai)
#pragma unroll
            for (int m = 0; m < 4; ++m) { bf16_t* rowp = O + (size_t)(row0 + ai * HALF + m * 16) * ldc + col0;
#pragma unroll
                for (int bj = 0; bj < 2; ++bj) { const f32x4 v0 = acc[ai][bj][m][0] * sc, v1 = acc[ai][bj][m][1] * sc;
                    u32x4 w; w.x = cvt_pk_bf16(v0[0], v0[1]); w.y = cvt_pk_bf16(v0[2], v0[3]); w.z = cvt_pk_bf16(v1[0], v1[1]); w.w = cvt_pk_bf16(v1[2], v1[3]);
                    NT_STORE(w, (u32x4*)(rowp + bj * HALF)); } }
    }
};
template <bool FIRST> struct EpiGate {
    static constexpr bool PERM = true;
    bf16_t* O; const bf16_t* prev; const bf16_t* P; int gcol;
    __device__ __forceinline__ void operator()(const f32x4 (&acc)[2][2][4][2], const Unit& u, int wr, int wc, int fr, int fq) const {
        const int row0 = u.pm * BM + wr * 64 + fr, col0 = u.pn * BM + wc * 32 + 8 * fq;
#pragma unroll
        for (int ai = 0; ai < 2; ++ai)
#pragma unroll
            for (int m = 0; m < 4; ++m) { const size_t row = (size_t)(row0 + ai * HALF + m * 16);
#pragma unroll
                for (int bj = 0; bj < 2; ++bj) { const int col = col0 + bj * HALF;
                    const u32x4 gz = *(const u32x4*)(P + row * PITCH + gcol + col);
                    const f32x4 v0 = acc[ai][bj][m][0], v1 = acc[ai][bj][m][1];
                    float o[8];
                    o[0] = v0[0] * sigmoidf_(bf_lo(gz.x)); o[1] = v0[1] * sigmoidf_(bf_hi(gz.x)); o[2] = v0[2] * sigmoidf_(bf_lo(gz.y)); o[3] = v0[3] * sigmoidf_(bf_hi(gz.y));
                    o[4] = v1[0] * sigmoidf_(bf_lo(gz.z)); o[5] = v1[1] * sigmoidf_(bf_hi(gz.z)); o[6] = v1[2] * sigmoidf_(bf_lo(gz.w)); o[7] = v1[3] * sigmoidf_(bf_hi(gz.w));
                    if (!FIRST) { const u32x4 pv = *(const u32x4*)(prev + row * D + col);
                        o[0] += bf_lo(pv.x); o[1] += bf_hi(pv.x); o[2] += bf_lo(pv.y); o[3] += bf_hi(pv.y); o[4] += bf_lo(pv.z); o[5] += bf_hi(pv.z); o[6] += bf_lo(pv.w); o[7] += bf_hi(pv.w); }
                    u32x4 w; w.x = cvt_pk_bf16(o[0], o[1]); w.y = cvt_pk_bf16(o[2], o[3]); w.z = cvt_pk_bf16(o[4], o[5]); w.w = cvt_pk_bf16(o[6], o[7]);
                    *(u32x4*)(O + row * D + col) = w; } }
    }
};
struct EpiRouter {
    static constexpr bool PERM = false;
    float* L; const float* bias;
    __device__ __forceinline__ void operator()(const f32x4 (&acc)[2][2][4][2], const Unit& u, int wr, int wc, int fr, int fq) const {
        if (wc != 0) return;
        const int row0 = u.pm * BM + wr * 64 + fr, col0 = 4 * fq;
        const f32x4 b0 = *(const f32x4*)(bias + col0), b1 = *(const f32x4*)(bias + col0 + 16);
#pragma unroll
        for (int ai = 0; ai < 2; ++ai)
#pragma unroll
            for (int m = 0; m < 4; ++m) { float* rowp = L + (size_t)(row0 + ai * HALF + m * 16) * NE + col0;
                *(f32x4*)(rowp) = acc[ai][0][m][0] + b0; *(f32x4*)(rowp + 16) = acc[ai][0][m][1] + b1; }
    }
};
struct EpiSwiglu {
    static constexpr bool PERM = true;
    bf16_t* ACT; const float* bgu;
    __device__ __forceinline__ void operator()(const f32x4 (&acc)[2][2][4][2], const Unit& u, int wr, int wc, int fr, int fq) const {
        const int row0 = u.pm * BM + wr * 64 + fr, j0 = u.pn * HALF + wc * 32 + 8 * fq;
        const float* bg = bgu + (size_t)u.e * 2 * FF + j0;
        float g_b[8], u_b[8];
        { const f32x4 a = *(const f32x4*)bg, b = *(const f32x4*)(bg + 4), c = *(const f32x4*)(bg + FF), d = *(const f32x4*)(bg + FF + 4);
#pragma unroll
          for (int i = 0; i < 4; ++i) { g_b[i] = a[i]; g_b[4 + i] = b[i]; u_b[i] = c[i]; u_b[4 + i] = d[i]; } }
#pragma unroll
        for (int ai = 0; ai < 2; ++ai)
#pragma unroll
            for (int m = 0; m < 4; ++m) { bf16_t* rowp = ACT + (size_t)(row0 + ai * HALF + m * 16) * FF + j0;
                float o[8];
#pragma unroll
                for (int n = 0; n < 2; ++n)
#pragma unroll
                    for (int i = 0; i < 4; ++i) { float gt = acc[ai][0][m][n][i] + g_b[4 * n + i], up = acc[ai][1][m][n][i] + u_b[4 * n + i];
                        gt = fminf(gt, 7.0f); up = fminf(fmaxf(up, -7.0f), 7.0f);
                        o[4 * n + i] = gt * __builtin_amdgcn_rcpf(1.0f + __builtin_amdgcn_exp2f(-1.702f * LOG2E * gt)) * (up + 1.0f); }
                u32x4 w; w.x = cvt_pk_bf16(o[0], o[1]); w.y = cvt_pk_bf16(o[2], o[3]); w.z = cvt_pk_bf16(o[4], o[5]); w.w = cvt_pk_bf16(o[6], o[7]);
                *(u32x4*)rowp = w; }
    }
};
struct EpiSwiglu8 {
    static constexpr bool PERM = true;
    unsigned char* ACT; const float* bgu;
    struct Pre { f32x4 a, b, c, d; };
    __device__ __forceinline__ Pre pre(const Unit& u, int wr, int wc, int fr, int fq) const {
        const float* bg = bgu + (size_t)u.e * 2 * FF + u.pn * HALF + wc * 32 + 8 * fq;
        Pre q; q.a = *(const f32x4*)bg; q.b = *(const f32x4*)(bg + 4); q.c = *(const f32x4*)(bg + FF); q.d = *(const f32x4*)(bg + FF + 4); return q; }
    __device__ __forceinline__ void post(const f32x4 (&acc)[2][2][4][2], const Pre& q, const Unit& u, int wr, int wc, int fr, int fq) const {
        constexpr float DS = 1.0f / (F8_SH * F8_SW);
        const int row0 = u.pm * BM + wr * 64 + fr, j0 = u.pn * HALF + wc * 32 + 8 * fq;
        float g_b[8], u_b[8];
#pragma unroll
        for (int i = 0; i < 4; ++i) { g_b[i] = q.a[i]; g_b[4 + i] = q.b[i]; u_b[i] = q.c[i]; u_b[4 + i] = q.d[i]; }
#pragma unroll
        for (int ai = 0; ai < 2; ++ai)
#pragma unroll
            for (int m = 0; m < 4; ++m) { unsigned char* rowp = ACT + (size_t)(row0 + ai * HALF + m * 16) * FF + j0;
                float o[8];
#pragma unroll
                for (int n = 0; n < 2; ++n)
#pragma unroll
                    for (int i = 0; i < 4; ++i) { float gt = acc[ai][0][m][n][i] * DS + g_b[4 * n + i], up = acc[ai][1][m][n][i] * DS + u_b[4 * n + i];
                        gt = fminf(gt, 7.0f); up = fminf(fmaxf(up, -7.0f), 7.0f);
                        o[4 * n + i] = gt * __builtin_amdgcn_rcpf(1.0f + __builtin_amdgcn_exp2f(-1.702f * LOG2E * gt)) * (up + 1.0f) * F8_SACT; }
                u32x2 w; w.x = pk4_fp8(o[0], o[1], o[2], o[3]); w.y = pk4_fp8(o[4], o[5], o[6], o[7]);
                NT_STORE(w, (u32x2*)rowp); }
    }
    __device__ __forceinline__ void operator()(const f32x4 (&acc)[2][2][4][2], const Unit& u, int wr, int wc, int fr, int fq) const { const Pre q = pre(u, wr, wc, fr, fq); post(acc, q, u, wr, wc, fr, fq); }
};
struct EpiDown {
    static constexpr bool PERM = true;
    bf16_t* YS; const float* bd; const float* listw; float ds;
    struct Pre { float ws[8]; f32x4 bv[2][2]; };
    __device__ __forceinline__ Pre pre(const Unit& u, int wr, int wc, int fr, int fq) const {
        const int r0 = wr * 64 + fr, col0 = u.pn * BM + wc * 32 + 8 * fq;
        const float* bp = bd + (size_t)u.e * D + col0;
        Pre q;
#pragma unroll
        for (int g = 0; g < 8; ++g) { const int r = r0 + (g >> 2) * HALF + (g & 3) * 16; q.ws[g] = (r < u.nvalid) ? listw[u.lrow + r] : 0.f; }
#pragma unroll
        for (int bj = 0; bj < 2; ++bj) { q.bv[bj][0] = *(const f32x4*)(bp + bj * HALF); q.bv[bj][1] = *(const f32x4*)(bp + bj * HALF + 4); }
        return q; }
    __device__ __forceinline__ void post(const f32x4 (&acc)[2][2][4][2], const Pre& q, const Unit& u, int wr, int wc, int fr, int fq) const {
        const int r0 = wr * 64 + fr, col0 = u.pn * BM + wc * 32 + 8 * fq;
#pragma unroll
        for (int ai = 0; ai < 2; ++ai)
#pragma unroll
            for (int m = 0; m < 4; ++m) { const float w_ = q.ws[ai * 4 + m]; bf16_t* rowp = YS + (size_t)(u.pm * BM + r0 + ai * HALF + m * 16) * D + col0;
#pragma unroll
                for (int bj = 0; bj < 2; ++bj) { const f32x4 v0 = (acc[ai][bj][m][0] * ds + q.bv[bj][0]) * w_, v1 = (acc[ai][bj][m][1] * ds + q.bv[bj][1]) * w_;
                    u32x4 w; w.x = cvt_pk_bf16(v0[0], v0[1]); w.y = cvt_pk_bf16(v0[2], v0[3]); w.z = cvt_pk_bf16(v1[0], v1[1]); w.w = cvt_pk_bf16(v1[2], v1[3]);
                    NT_STORE(w, (u32x4*)(rowp + bj * HALF)); } }
    }
    __device__ __forceinline__ void operator()(const f32x4 (&acc)[2][2][4][2], const Unit& u, int wr, int wc, int fr, int fq) const { const Pre q = pre(u, wr, wc, fr, fq); post(acc, q, u, wr, wc, fr, fq); }
};

struct EpiDown8 {
    static constexpr bool PERM = true; static constexpr bool PERM16 = true;
    unsigned char* YS; const float* bd; const float* listw; float ds;
    struct Pre { float ws[8]; f32x4 bv[4]; };
    __device__ __forceinline__ Pre pre(const Unit& u, int wr, int wc, int fr, int fq) const {
        const int r0 = wr * 64 + fr, col0 = u.pn * BM + wc * 64 + 16 * fq;
        const float* bp = bd + (size_t)u.e * D + col0;
        Pre q;
#pragma unroll
        for (int g = 0; g < 8; ++g) { const int r = r0 + (g >> 2) * HALF + (g & 3) * 16; q.ws[g] = (r < u.nvalid) ? listw[u.lrow + r] * F8_SY : 0.f; }
#pragma unroll
        for (int j = 0; j < 4; ++j) q.bv[j] = *(const f32x4*)(bp + 4 * j);
        return q; }
    __device__ __forceinline__ void post(const f32x4 (&acc)[2][2][4][2], const Pre& q, const Unit& u, int wr, int wc, int fr, int fq) const {
        const int r0 = wr * 64 + fr, col0 = u.pn * BM + wc * 64 + 16 * fq;
#pragma unroll
        for (int ai = 0; ai < 2; ++ai)
#pragma unroll
            for (int m = 0; m < 4; ++m) { const float w_ = q.ws[ai * 4 + m]; unsigned char* rowp = YS + (size_t)(u.pm * BM + r0 + ai * HALF + m * 16) * D + col0;
                u32x4 w;
#pragma unroll
                for (int bj = 0; bj < 2; ++bj)
#pragma unroll
                    for (int n = 0; n < 2; ++n) { const f32x4 v = (acc[ai][bj][m][n] * ds + q.bv[2 * bj + n]) * w_; w[2 * bj + n] = pk4_fp8(v[0], v[1], v[2], v[3]); }
                NT_STORE(w, (u32x4*)rowp); }
    }
    __device__ __forceinline__ void operator()(const f32x4 (&acc)[2][2][4][2], const Unit& u, int wr, int wc, int fr, int fq) const { const Pre q = pre(u, wr, wc, fr, fq); post(acc, q, u, wr, wc, fr, fq); }
};
#ifdef MK_EPIX
template <int MODE> struct EpiDownX {
    static constexpr bool PERM = true;
    bf16_t* YS; const float* bd; const float* listw; float ds;
    __device__ __forceinline__ void operator()(const f32x4 (&acc)[2][2][4][2], const Unit& u, int wr, int wc, int fr, int fq) const {
        const int r0 = wr * 64 + fr, col0 = u.pn * BM + wc * 32 + 8 * fq;
        const float* bp = bd + (size_t)u.e * D + col0;
        float ws[8]; f32x4 bv[2][2];
        if (MODE != 2) {
#pragma unroll
        for (int g = 0; g < 8; ++g) { const int r = r0 + (g >> 2) * HALF + (g & 3) * 16; ws[g] = (r < u.nvalid) ? listw[u.lrow + r] : 0.f; }
#pragma unroll
        for (int bj = 0; bj < 2; ++bj) { bv[bj][0] = *(const f32x4*)(bp + bj * HALF); bv[bj][1] = *(const f32x4*)(bp + bj * HALF + 4); }
        } else {
#pragma unroll
        for (int g = 0; g < 8; ++g) ws[g] = ds;
#pragma unroll
        for (int bj = 0; bj < 2; ++bj) { bv[bj][0] = (f32x4){ds, ds, ds, ds}; bv[bj][1] = bv[bj][0]; } }
#pragma unroll
        for (int ai = 0; ai < 2; ++ai)
#pragma unroll
            for (int m = 0; m < 4; ++m) { const float w_ = ws[ai * 4 + m]; bf16_t* rowp = YS + (size_t)(u.pm * BM + r0 + ai * HALF + m * 16) * D + col0;
#pragma unroll
                for (int bj = 0; bj < 2; ++bj) { const f32x4 v0 = (acc[ai][bj][m][0] * ds + bv[bj][0]) * w_, v1 = (acc[ai][bj][m][1] * ds + bv[bj][1]) * w_;
                    u32x4 w; w.x = cvt_pk_bf16(v0[0], v0[1]); w.y = cvt_pk_bf16(v0[2], v0[3]); w.z = cvt_pk_bf16(v1[0], v1[1]); w.w = cvt_pk_bf16(v1[2], v1[3]);
                    if (MODE != 1) *(u32x4*)(rowp + bj * HALF) = w; else asm volatile("" :: "v"(w)); } }
    }
};
#endif
struct EpiNull {
    static constexpr bool PERM = true;
    __device__ __forceinline__ void operator()(const f32x4 (&acc)[2][2][4][2], const Unit& u, int wr, int wc, int fr, int fq) const {
#pragma unroll
        for (int ai = 0; ai < 2; ++ai)
#pragma unroll
            for (int bj = 0; bj < 2; ++bj)
#pragma unroll
                for (int m = 0; m < 4; ++m) asm volatile("" :: "v"(acc[ai][bj][m][0]), "v"(acc[ai][bj][m][1]));
    }
};
template <class Epi, class Sched, bool GATHER, bool ALIGN_EPI, bool F8 = false, bool PFA = false>
__device__ __forceinline__ void gemm_phase(LAS unsigned char* lds, const Gemm g, const Sched& S, const Epi& E) {
    int tid = threadIdx.x; asm volatile("" : "+v"(tid));
    const int wid = __builtin_amdgcn_readfirstlane(tid >> 6), lane = tid & 63, wr = wid >> 2, wc = wid & 3, fr = lane & 15, fq = lane >> 4;
    const int K = g.K, nt = K / BK;
    unsigned voffA[2], voffB[2]; int Rg[2], Cg[2];
#pragma unroll
    for (int i = 0; i < 2; ++i) { int R, C; stage_rc(tid * 16 + i * 8192, R, C); const int Rb = Perm16<Epi>::v ? perm16x(R) : Epi::PERM ? ((R & ~31) + perm32(R & 31)) : R;
        voffA[i] = (unsigned)(R * K + C) * 2u; voffB[i] = (unsigned)(Rb * K + C) * 2u; Rg[i] = R; Cg[i] = C; }
    const size_t kstep = (size_t)(BK * 2);
    const size_t hstep = (size_t)HALF * K * 2;
    const size_t tstep = 2 * hstep;
    const unsigned ldsw = (unsigned)wid * 1024u;
    const int aoff = lds_byte(wr * 64 + fr, fq * 8), boff = lds_byte(wc * 32 + fr, fq * 8);
    unsigned vAc[2][2], vAn[2][2];
#define PG8_SA(b, h) (((b) * 2 + (h)) * HTB)
#define PG8_SB(b, h) ((4 + (b) * 2 + (h)) * HTB)
#define PG8_STAGE2(bufoff, gbase, v0, v1) do { \
        __builtin_amdgcn_global_load_lds((const unsigned*)((const char*)(gbase) + (v0)), (LAS unsigned*)(lds + (bufoff) + ldsw), 16, 0, 0); \
        __builtin_amdgcn_global_load_lds((const unsigned*)((const char*)(gbase) + (v1)), (LAS unsigned*)(lds + (bufoff) + ldsw + 8192), 16, 0, 0); } while (0)
#define PG8_STA(bufoff, ap, h, usen) do { if constexpr (GATHER) { const unsigned o0_ = (usen) ? vAn[h][0] : vAc[h][0], o1_ = (usen) ? vAn[h][1] : vAc[h][1]; PG8_STAGE2(bufoff, ap, o0_, o1_); } \
        else { PG8_STAGE2(bufoff, (ap) + (h) * hstep, voffA[0], voffA[1]); } } while (0)
#define PG8_STB(bufoff, bp, h) PG8_STAGE2(bufoff, (bp) + (h) * (Perm16<Epi>::v ? (size_t)8 * K * 2 : hstep), voffB[0], voffB[1])
#define PG8_ROWS(u, v) do { _Pragma("unroll") for (int h_ = 0; h_ < 2; ++h_) _Pragma("unroll") for (int i_ = 0; i_ < 2; ++i_) { const int rr_ = h_ * HALF + Rg[i_]; \
        const int idx_ = (rr_ < (u).nvalid) ? g.rows[(u).lrow + rr_] : 0; v[h_][i_] = (unsigned)((idx_ >> 2) * K + Cg[i_]) * 2u; } \
        asm volatile("" : "+v"(v[0][0]), "+v"(v[0][1]), "+v"(v[1][0]), "+v"(v[1][1])); } while (0)
#define PG8_LDA(dst, b, h) do { _Pragma("unroll") for (int m = 0; m < 4; ++m) _Pragma("unroll") for (int k = 0; k < 2; ++k) dst[m][k] = *(const LAS bf16x8*)(lds + PG8_SA(b, h) + aoff + m * 2048 + k * 1024); } while (0)
#define PG8_LDB(dst, b, h) do { _Pragma("unroll") for (int n = 0; n < 2; ++n) _Pragma("unroll") for (int k = 0; k < 2; ++k) dst[n][k] = *(const LAS bf16x8*)(lds + PG8_SB(b, h) + boff + n * 2048 + k * 1024); } while (0)
#define PG8_CAT(x, y) __builtin_shufflevector(__builtin_bit_cast(v4i_t, x), __builtin_bit_cast(v4i_t, y), 0, 1, 2, 3, 4, 5, 6, 7)
#define PG8_MMA(ai, bj, At, Bt) do { __builtin_amdgcn_s_setprio(1); if constexpr (F8) { \
        _Pragma("unroll") for (int m = 0; m < 4; ++m) _Pragma("unroll") for (int n = 0; n < 2; ++n) \
            { const v8i_t b8_ = PG8_CAT(Bt[n][0], Bt[n][1]), a8_ = PG8_CAT(At[m][0], At[m][1]);     \
              asm volatile("v_mfma_scale_f32_16x16x128_f8f6f4 %0, %1, %2, %0, %3, %3 op_sel_hi:[0,0,0]" : "+v"(acc[ai][bj][m][n]) : "v"(b8_), "v"(a8_), "v"(f8one)); } \
        } else { _Pragma("unroll") for (int m = 0; m < 4; ++m) _Pragma("unroll") for (int n = 0; n < 2; ++n) _Pragma("unroll") for (int k = 0; k < 2; ++k) \
        acc[ai][bj][m][n] = __builtin_amdgcn_mfma_f32_16x16x32_bf16(Bt[n][k], At[m][k], acc[ai][bj][m][n], 0, 0, 0); } __builtin_amdgcn_s_setprio(0); } while (0)
#define PG8_WAIT_V(n) asm volatile("s_waitcnt vmcnt(" #n ")" ::: "memory")
#define PG8_WAIT_L(n) asm volatile("s_waitcnt lgkmcnt(" #n ")" ::: "memory")
#define PG8_BAR __builtin_amdgcn_s_barrier()
#define PG8_SCHED __builtin_amdgcn_sched_barrier(0)
    Unit cur, nxt; int ui = 0;
    if (!S.next(0, cur)) return;
    f32x4 acc[2][2][4][2];
#pragma unroll
    for (int a = 0; a < 2; ++a)
#pragma unroll
        for (int b = 0; b < 2; ++b)
#pragma unroll
            for (int m = 0; m < 4; ++m)
#pragma unroll
                for (int n = 0; n < 2; ++n) acc[a][b][m][n] = (f32x4){0.f, 0.f, 0.f, 0.f};
    bf16x8 At[4][2], B0[2][2], B1[2][2];
    const int f8one = 0x7f7f7f7f;
    const char* cA = GATHER ? (const char*)g.A : (const char*)g.A + (size_t)cur.pm * tstep;
    const char* cB = (const char*)g.Bt + ((size_t)cur.e * g.estride) * 2 + (size_t)cur.pn * tstep;
    if constexpr (GATHER) { PG8_ROWS(cur, vAc); }
    PG8_STB(PG8_SB(0, 0), cB, 0); PG8_STB(PG8_SB(0, 1), cB, 1); PG8_STA(PG8_SA(0, 0), cA, 0, false); PG8_STA(PG8_SA(0, 1), cA, 1, false);
    if (wr == 1) PG8_BAR;
    PG8_WAIT_V(2); PG8_BAR;
    PG8_STB(PG8_SB(1, 0), cB + kstep, 0); PG8_STA(PG8_SA(1, 0), cA + kstep, 0, false); PG8_STB(PG8_SB(1, 1), cB + kstep, 1);
    PG8_WAIT_V(6); PG8_BAR;
    for (;;) {
        const bool has_next = S.next(ui + 1, nxt);
        const char* nA = GATHER ? (const char*)g.A : (has_next ? (const char*)g.A + (size_t)nxt.pm * tstep : cA);
        const char* nB = has_next ? (const char*)g.Bt + ((size_t)nxt.e * g.estride) * 2 + (size_t)nxt.pn * tstep : cB;
        if constexpr (GATHER) { if (has_next) { PG8_ROWS(nxt, vAn); } else {
#pragma unroll
            for (int h = 0; h < 2; ++h) { vAn[h][0] = vAc[h][0]; vAn[h][1] = vAc[h][1]; } } }
        for (int t = 0; t < nt; t += 2) {
            const bool last = (t == nt - 2);
            const char* a1 = cA + (size_t)(t + 1) * kstep;
            const char* a2 = last ? nA : cA + (size_t)(t + 2) * kstep; const char* b2 = last ? nB : cB + (size_t)(t + 2) * kstep;
            const char* a3 = a2 + kstep; const char* b3 = b2 + kstep;
            PG8_LDB(B0, 0, 0); PG8_LDB(B1, 0, 1); PG8_SCHED; PG8_LDA(At, 0, 0); PG8_STA(PG8_SA(1, 1), a1, 1, false);
            PG8_WAIT_V(8); PG8_WAIT_L(0); PG8_BAR; PG8_MMA(0, 0, At, B0); PG8_MMA(0, 1, At, B1); PG8_BAR; PG8_SCHED;
            PG8_LDA(At, 0, 1); PG8_STB(PG8_SB(0, 0), b2, 0); PG8_STB(PG8_SB(0, 1), b2, 1); PG8_STA(PG8_SA(0, 0), a2, 0, last);
            PG8_WAIT_V(8); PG8_WAIT_L(0); PG8_BAR; PG8_MMA(1, 0, At, B0); PG8_MMA(1, 1, At, B1); PG8_BAR; PG8_SCHED;
            PG8_LDB(B0, 1, 0); PG8_LDB(B1, 1, 1); PG8_SCHED; PG8_LDA(At, 1, 0); PG8_STA(PG8_SA(0, 1), a2, 1, last);
            PG8_WAIT_V(8); PG8_WAIT_L(0); PG8_BAR; PG8_MMA(0, 0, At, B0); PG8_MMA(0, 1, At, B1); PG8_BAR; PG8_SCHED;
            PG8_LDA(At, 1, 1); PG8_STB(PG8_SB(1, 0), b3, 0); PG8_STB(PG8_SB(1, 1), b3, 1); PG8_STA(PG8_SA(1, 0), a3, 0, last);
            PG8_WAIT_V(8); PG8_WAIT_L(0); PG8_BAR; PG8_MMA(1, 0, At, B0); PG8_MMA(1, 1, At, B1); PG8_BAR; PG8_SCHED;
        }
        if constexpr (ALIGN_EPI) { if (wr == 0) PG8_BAR; }
        if constexpr (F8) asm volatile("s_nop 15\n\ts_nop 15" ::: "memory");
        if constexpr (PFA) {
            const auto q_ = E.pre(cur, wr, wc, fr, fq);
            PG8_SCHED;
            if (has_next) { LAS unsigned* dump_ = (LAS unsigned*)(lds + STAGE_BYTES + 8192 + ldsw / 4);
                for (int kb = 0; kb < nt * 128; kb += 1024) if (kb > 0 || Cg[0] >= 16) {
#pragma unroll
                    for (int h = 0; h < 2; ++h)
#pragma unroll
                        for (int i = 0; i < 2; ++i) { const char* pa_ = GATHER ? nA + vAn[h][i] : nA + h * hstep + voffA[i];
                            __builtin_amdgcn_global_load_lds((const unsigned*)(pa_ + Cg[i] * 14 + kb), dump_, 4, 0, 0); } } }
            PG8_SCHED;
            E.post(acc, q_, cur, wr, wc, fr, fq);
        } else E(acc, cur, wr, wc, fr, fq);
        if (!has_next) break;
#pragma unroll
        for (int a = 0; a < 2; ++a)
#pragma unroll
            for (int b = 0; b < 2; ++b)
#pragma unroll
                for (int m = 0; m < 4; ++m)
#pragma unroll
                    for (int n = 0; n < 2; ++n) acc[a][b][m][n] = (f32x4){0.f, 0.f, 0.f, 0.f};
        cur = nxt; cA = nA; cB = nB; ++ui;
        if constexpr (GATHER) {
#pragma unroll
            for (int h = 0; h < 2; ++h) { vAc[h][0] = vAn[h][0]; vAc[h][1] = vAn[h][1]; } }
        if constexpr (ALIGN_EPI) { if (wr == 1) PG8_BAR; }
    }
    PG8_WAIT_V(0);
    if constexpr (!ALIGN_EPI) { if (wr == 0) PG8_BAR; }
    PG8_BAR;
#undef PG8_SA
#undef PG8_SB
#undef PG8_STAGE2
#undef PG8_STA
#undef PG8_STB
#undef PG8_ROWS
#undef PG8_LDA
#undef PG8_LDB
#undef PG8_MMA
#undef PG8_CAT
#undef PG8_WAIT_V
#undef PG8_WAIT_L
#undef PG8_BAR
#undef PG8_SCHED
}
}
namespace attn_body {
using bf16x8 = __attribute__((ext_vector_type(8))) short;
using s16x4 = __attribute__((ext_vector_type(4))) short;
using f32x16 = __attribute__((ext_vector_type(16))) float;
constexpr int NW = 8, QBLK = 32, QB = QBLK * NW, KVBLK = 64;
__device__ __forceinline__ int crow(int r, int hi) { return (r & 3) + 8 * (r >> 2) + 4 * hi; }
#define SBAR() __builtin_amdgcn_sched_barrier(0)
constexpr int NSLOT = 4, SLOTK = 8192, SLOTV = 16384;
constexpr int LDS_K = 0, LDS_V = NSLOT * SLOTK, LDS_WS = LDS_V + NSLOT * SLOTV, LDS_TAB = LDS_WS + NW * 64 * 4, TAB_N = 640, LDS_BYTES = LDS_TAB + TAB_N * 4;
__device__ __forceinline__ void glds16(const void* gsrc, unsigned lds_dst) { unsigned keep;
  asm volatile("s_mov_b32 %0, m0\n\ts_mov_b32 m0, %2\n\ts_nop 0\n\tglobal_load_lds_dwordx4 %1, off\n\ts_mov_b32 m0, %0" : "=&s"(keep) : "v"(gsrc), "s"(lds_dst) : "memory"); }
typedef float f32x2_t __attribute__((ext_vector_type(2))); typedef __bf16 bf16x2_t __attribute__((ext_vector_type(2)));
__device__ __forceinline__ unsigned cvtpk_s(float lo, float hi) { f32x2_t v = {lo, hi}; bf16x2_t b = __builtin_convertvector(v, bf16x2_t); return __builtin_bit_cast(unsigned, b); }
#define WAIT_BAR(N) asm volatile("s_waitcnt vmcnt(" #N ") lgkmcnt(0)\n\ts_barrier" ::: "memory")

__device__ __forceinline__ void kload8(bf16x8* kf, const LAS char* Kslot, int r32, int hi);
__device__ __forceinline__ void qkt_r(f32x16& p0, f32x16& p1, const bf16x8* kf, const bf16x8* qr, const f32x16& negm);
__device__ __forceinline__ void qkt(f32x16& p0, f32x16& p1, const LAS char* Kslot, const bf16x8* qr, const f32x16& negm, int r32, int hi) { bf16x8 kf[8]; kload8(kf, Kslot, r32, hi); qkt_r(p0, p1, kf, qr, negm); }
__device__ __forceinline__ float fadd_s(float a, float b) { float r; asm("v_add_f32_e32 %0, %1, %2" : "=v"(r) : "v"(a), "v"(b)); return r; }
__device__ __forceinline__ void kload8(bf16x8* kf, const LAS char* Kslot, int r32, int hi) {
  const unsigned a0 = (unsigned)(uintptr_t)Kslot + r32 * 128 + ((hi ^ ((r32 >> 1) & 7)) << 4);
  #pragma unroll
  for (int d0 = 0; d0 < 4; ++d0) { const LAS char* kb = (const LAS char*)(uintptr_t)(a0 ^ (d0 << 5)); kf[2 * d0] = *(const LAS bf16x8*)(kb); kf[2 * d0 + 1] = *(const LAS bf16x8*)(kb + 4096); }
}
__device__ __forceinline__ void qkt_r(f32x16& p0, f32x16& p1, const bf16x8* kf, const bf16x8* qr, const f32x16& negm) {
  asm volatile("v_mfma_f32_32x32x16_bf16 %0, %1, %2, %3" : "=&v"(p0) : "v"(kf[0]), "v"(qr[0]), "v"(negm));
  asm volatile("v_mfma_f32_32x32x16_bf16 %0, %1, %2, %3" : "=&v"(p1) : "v"(kf[1]), "v"(qr[0]), "v"(negm));
  #pragma unroll
  for (int d0 = 1; d0 < 4; ++d0) {
    asm volatile("v_mfma_f32_32x32x16_bf16 %0, %1, %2, %0" : "+v"(p0) : "v"(kf[2 * d0]), "v"(qr[d0]));
    asm volatile("v_mfma_f32_32x32x16_bf16 %0, %1, %2, %0" : "+v"(p1) : "v"(kf[2 * d0 + 1]), "v"(qr[d0])); }
}
#define MX3(a, b, c) __builtin_fmaxf(__builtin_fmaxf((a), (b)), (c))
__device__ __forceinline__ float rowmax(const f32x16& p0, const f32x16& p1) {
  float a = MX3(p0[0], p0[1], p1[0]), b = MX3(p0[2], p0[3], p1[1]); a = MX3(a, p1[2], p1[3]);
  #pragma unroll
  for (int r = 4; r < 16; r += 4) { a = MX3(a, p0[r], p0[r + 1]); b = MX3(b, p0[r + 2], p0[r + 3]); a = MX3(a, p1[r], p1[r + 1]); b = MX3(b, p1[r + 2], p1[r + 3]); }
  float rm = __builtin_fmaxf(a, b);
  auto rr = __builtin_amdgcn_permlane32_swap(__float_as_uint(rm), __float_as_uint(rm), false, false);
  return __builtin_fmaxf(__uint_as_float(rr[0]), __uint_as_float(rr[1]));
}
__device__ __forceinline__ void bmask(f32x16& p0, f32x16& p1, int jb, int qrel, int hi, const LAS float* tab) {
  const unsigned ta = (unsigned)(uintptr_t)(tab + (255 + qrel - 64 * jb - 4 * hi - 59));
  #pragma unroll
  for (int g = 0; g < 4; ++g) {
    float a0, a1, a2, a3, b0, b1, b2, b3;
    asm volatile("ds_read_b32 %0, %8 offset:%c9\n\tds_read_b32 %1, %8 offset:%c10\n\tds_read_b32 %2, %8 offset:%c11\n\tds_read_b32 %3, %8 offset:%c12\n\t"
                 "ds_read_b32 %4, %8 offset:%c13\n\tds_read_b32 %5, %8 offset:%c14\n\tds_read_b32 %6, %8 offset:%c15\n\tds_read_b32 %7, %8 offset:%c16\n\ts_waitcnt lgkmcnt(0)"
                 : "=&v"(a0), "=&v"(a1), "=&v"(a2), "=&v"(a3), "=&v"(b0), "=&v"(b1), "=&v"(b2), "=&v"(b3)
                 : "v"(ta), "i"(4 * (59 - 8 * g)), "i"(4 * (59 - 8 * g - 1)), "i"(4 * (59 - 8 * g - 2)), "i"(4 * (59 - 8 * g - 3)),
                   "i"(4 * (59 - 8 * g - 32)), "i"(4 * (59 - 8 * g - 33)), "i"(4 * (59 - 8 * g - 34)), "i"(4 * (59 - 8 * g - 35)) : "memory");
    p0[4 * g] += a0; p0[4 * g + 1] += a1; p0[4 * g + 2] += a2; p0[4 * g + 3] += a3;
    p1[4 * g] += b0; p1[4 * g + 1] += b1; p1[4 * g + 2] += b2; p1[4 * g + 3] += b3;
  }
}
template <int ND>
__device__ __forceinline__ void pv(f32x16* o, int vb, bf16x8 pa0, bf16x8 pa1, bf16x8 pa2, bf16x8 pa3) {
  #pragma unroll
  for (int d0 = 0; d0 < ND; d0 += 2) { s16x4 lo[2][4], hi[2][4];
    #pragma unroll
    for (int e = 0; e < 2; ++e)
      #pragma unroll
      for (int ks = 0; ks < 4; ++ks) {
        asm volatile("ds_read_b64_tr_b16 %0,%1 offset:%c2" : "=&v"(lo[e][ks]) : "v"(vb), "i"((d0 + e) * 4096 + ks * 1024) : "memory");
        asm volatile("ds_read_b64_tr_b16 %0,%1 offset:%c2" : "=&v"(hi[e][ks]) : "v"(vb), "i"((d0 + e) * 4096 + ks * 1024 + 512) : "memory"); }
    asm volatile("s_waitcnt lgkmcnt(0)" ::: "memory"); SBAR();
    #define PK(e, k) (bf16x8){lo[e][k][0], lo[e][k][1], lo[e][k][2], lo[e][k][3], hi[e][k][0], hi[e][k][1], hi[e][k][2], hi[e][k][3]}
    o[d0]     = __builtin_amdgcn_mfma_f32_32x32x16_bf16(pa0, PK(0, 0), o[d0], 0, 0, 0);
    o[d0 + 1] = __builtin_amdgcn_mfma_f32_32x32x16_bf16(pa0, PK(1, 0), o[d0 + 1], 0, 0, 0);
    o[d0]     = __builtin_amdgcn_mfma_f32_32x32x16_bf16(pa1, PK(0, 1), o[d0], 0, 0, 0);
    o[d0 + 1] = __builtin_amdgcn_mfma_f32_32x32x16_bf16(pa1, PK(1, 1), o[d0 + 1], 0, 0, 0);
    o[d0]     = __builtin_amdgcn_mfma_f32_32x32x16_bf16(pa2, PK(0, 2), o[d0], 0, 0, 0);
    o[d0 + 1] = __builtin_amdgcn_mfma_f32_32x32x16_bf16(pa2, PK(1, 2), o[d0 + 1], 0, 0, 0);
    o[d0]     = __builtin_amdgcn_mfma_f32_32x32x16_bf16(pa3, PK(0, 3), o[d0], 0, 0, 0);
    o[d0 + 1] = __builtin_amdgcn_mfma_f32_32x32x16_bf16(pa3, PK(1, 3), o[d0 + 1], 0, 0, 0);
    #undef PK
    SBAR();
  }
}

#ifndef MK_TIM
#define MK_TIM 0
#endif
#if MK_TIM
__device__ unsigned long long g_tim[2];
#endif
template <int THRL, int PQ, int PO, int NV>
__device__ __forceinline__ void attn_unit(const bf16_t* Qp, const bf16_t* __restrict__ Kp, const bf16_t* __restrict__ Vp, bf16_t* Op, const int NT, const float mfloor, const float sink2, char* shm, const int dbg = 0,
                                          const bf16_t* O1p = nullptr, const float lam = 0.f, const float* gsub = nullptr, const float post = 0.f) {
  constexpr int ND = 2 * NV;
  int tid = threadIdx.x; asm volatile("" : "+v"(tid));
  const int lane = tid & 63, r32 = lane & 31, hi = lane >> 5; const int wid = __builtin_amdgcn_readfirstlane(tid >> 6);
  const unsigned lds0 = (unsigned)(uintptr_t)shm;
  const LAS char* shm3 = (const LAS char*)shm;
  LAS float* wsf = (LAS float*)((LAS char*)shm + LDS_WS) + wid * 64;
  const LAS float* tab = (const LAS float*)((LAS char*)shm + LDS_TAB);
  const bf16_t* Qw = Qp + (long)(wid * QBLK) * PQ;
  bf16x8 qr[4];
  #pragma unroll
  for (int d0 = 0; d0 < 4; ++d0) qr[d0] = *reinterpret_cast<const bf16x8*>(&Qw[(long)r32 * PQ + d0 * 16 + hi * 8]);
  const bf16_t* ksrc = Kp + (long)(8 * wid + (lane >> 3)) * PQ + (((lane & 7) ^ ((4 * wid + (lane >> 4)) & 7)) * 8);
  const bf16_t* vsrc = Vp + (long)(8 * wid + (lane >> 3)) * PQ + ((((lane >> 2) ^ (lane >> 4)) & 1) * 32) + (lane & 3) * 8;
  const unsigned kdst = lds0 + LDS_K + wid * 1024, vdst = lds0 + LDS_V + wid * 1024;
  #define DMA_K(t, sl) glds16(ksrc + (long)(t) * KVBLK * PQ, (unsigned)__builtin_amdgcn_readfirstlane(kdst + (sl) * SLOTK))
#ifndef MK_DMAX
#define MK_DMAX 0
#endif
  #define DMA_V(t, sl) do { if (MK_DMAX == 1) break; if (MK_DMAX == 2) { const long go_ = (long)(t) * KVBLK * PQ; asm volatile("global_load_lds_dwordx4 %0, off\n\tglobal_load_lds_dwordx4 %1, off" :: "v"(vsrc + go_), "v"(vsrc + go_ + 64) : "memory"); break; } \
      if (MK_DMAX == 3) { const long go_ = (long)(t) * KVBLK * PQ; asm volatile("s_mov_b32 m0, %1\n\ts_nop 0\n\tglobal_load_lds_dwordx4 %0, off" :: "v"(vsrc + go_), "s"((unsigned)__builtin_amdgcn_readfirstlane(vdst + (sl) * SLOTV)) : "memory"); \
        asm volatile("s_mov_b32 m0, %1\n\ts_nop 0\n\tglobal_load_lds_dwordx4 %0, off" :: "v"(vsrc + go_ + 64), "s"((unsigned)__builtin_amdgcn_readfirstlane(vdst + (sl) * SLOTV + 8192)) : "memory"); break; } \
      DMA_V_(t, sl); } while (0)
  #define DMA_V_(t, sl) do { const long go_ = (long)(t) * KVBLK * PQ; glds16(vsrc + go_, (unsigned)__builtin_amdgcn_readfirstlane(vdst + (sl) * SLOTV)); \
      if (NV == 2) glds16(vsrc + go_ + 64, (unsigned)__builtin_amdgcn_readfirstlane(vdst + (sl) * SLOTV + 8192)); } while (0)
  const int vb0 = (int)(lds0 + LDS_V) + (4 * hi + ((lane & 15) >> 2)) * 128 + ((lane >> 3) & 1) * 64 + ((lane >> 4) & 1) * 32 + (lane & 3) * 8;
  float mhat = mfloor, l_reg = 0.f; f32x16 o[ND], negm;
  { float zf = 0.f; asm volatile("" : "+v"(zf));
    _Pragma("unroll") for (int r = 0; r < 16; ++r) { _Pragma("unroll") for (int d = 0; d < ND; ++d) o[d][r] = zf; negm[r] = -mhat; } }
  const int qrel = wid * QBLK + r32;
  DMA_K(0, 0); DMA_V(0, 3); DMA_K(1, 1); DMA_V(0, 0); DMA_K(2, 2); DMA_V(1, 1);
  asm volatile("" :: "v"(qr[0]), "v"(qr[1]), "v"(qr[2]), "v"(qr[3]));
  const int grp = wid >> 2;
  u32x4 pw0, pw1, pw2, pw3; pw0 = pw1 = pw2 = pw3 = (u32x4){0u, 0u, 0u, 0u};
  bool resc = false;
  f32x16 c0, c1;
#ifndef ATT_STAGGER
#define ATT_STAGGER 0
#endif
  if (ATT_STAGGER && grp == 1) { if (NV == 2) WAIT_BAR(6); else WAIT_BAR(4); }
  bf16x8 kf[8];
#ifndef ATT_QKAHEAD
#define ATT_QKAHEAD 0
#endif
  if (!ATT_STAGGER) { if (NV == 2) WAIT_BAR(8); else WAIT_BAR(5); kload8(kf, shm3 + LDS_K, r32, hi); if (ATT_QKAHEAD) { qkt_r(c0, c1, kf, qr, negm); SBAR(); } }
#if MK_TIM
  unsigned long long tim_a = 0ull; unsigned tim_sum = 0u, tim_cnt = 0u; bool tim_have = false;
  #define TIM_AT(k) do { if (NV == 2 && ((k) == MK_TIM_A || (k) == MK_TIM_B)) { unsigned long long tn_; asm volatile("s_memtime %0\n\ts_waitcnt lgkmcnt(0)" : "=s"(tn_) :: "memory"); \
      if ((k) == MK_TIM_B && tim_have) { tim_sum += (unsigned)(tn_ - tim_a); ++tim_cnt; } \
      if ((k) == MK_TIM_A) { tim_a = tn_; tim_have = true; } } } while (0)
#else
  #define TIM_AT(k) do { } while (0)
#endif
#ifndef ATT_SPREAD
#define ATT_SPREAD 0
#endif
#ifndef ATT_DMAPT
#define ATT_DMAPT 1
#endif
  #define DMA_PT(k) do { if ((NV == 2 && ATT_SPREAD) ? (wid == (k)) : ((k) == ATT_DMAPT)) { const int tk_ = t + 3 < NT ? t + 3 : NT - 1, tv_ = t + 2 < NT ? t + 2 : NT - 1; DMA_K(tk_, (t + 3) & 3); DMA_V(tv_, (t + 2) & 3); } } while (0)
  #pragma unroll 1
  for (int t = 0; t <= NT; ++t) {
    TIM_AT(0);
    if (dbg & 32) { } else if (ATT_STAGGER) { if (NV == 2) WAIT_BAR(6); else WAIT_BAR(4); } else { if (NV == 2) WAIT_BAR(5); else WAIT_BAR(3); }
    TIM_AT(1);
    DMA_PT(0);
    TIM_AT(2);
    if (ATT_QKAHEAD) { kload8(kf, shm3 + LDS_K + ((t + 1) & 3) * SLOTK, r32, hi); SBAR(); TIM_AT(3); DMA_PT(1); }
    else { qkt_r(c0, c1, kf, qr, negm); SBAR(); TIM_AT(3); kload8(kf, shm3 + LDS_K + ((t + 1) & 3) * SLOTK, r32, hi); SBAR(); DMA_PT(1); }
    SBAR();
    const int jb = t - (NT - 4);
    if (jb >= -2 && jb <= 3) bmask(c0, c1, jb, qrel, hi, tab);
    const float rm = rowmax(c0, c1);
    if (t < NT && __any(rm > (float)THRL)) {
      const float dl = __builtin_fmaxf(rm, 0.f);
      mhat += dl;
      #pragma unroll
      for (int r = 0; r < 16; ++r) { c0[r] -= dl; c1[r] -= dl; negm[r] = -mhat; }
      const float f = __builtin_amdgcn_exp2f(-dl); l_reg *= f;
      if (hi == 0) wsf[r32] = f;
      resc = true;
    }
    if ((dbg & 32) || !ATT_STAGGER) { } else if (NV == 2) WAIT_BAR(5); else WAIT_BAR(3);
    if (ATT_STAGGER) { const int tk = t + 3 < NT ? t + 3 : NT - 1, tv = t + 2 < NT ? t + 2 : NT - 1;
      if (!(dbg & 4)) { DMA_K(tk, (t + 3) & 3); DMA_V(tv, (t + 2) & 3); } }
    { const int vb = vb0 + ((t + 3) & 3) * SLOTV, vbo = vb ^ 64;
      s16x4 lo[2][4], hi_[2][4];
      #define RD(b, d0) do { _Pragma("unroll") for (int ks = 0; ks < 4; ++ks) { \
          asm volatile("ds_read_b64_tr_b16 %0,%1 offset:%c2" : "=v"(lo[b][ks]) : "v"(((d0) & 1) ? vbo : vb), "i"(((d0) >> 1) * 8192 + ks * 2048) : "memory"); \
          asm volatile("ds_read_b64_tr_b16 %0,%1 offset:%c2" : "=v"(hi_[b][ks]) : "v"(((d0) & 1) ? vbo : vb), "i"(((d0) >> 1) * 8192 + ks * 2048 + 1024) : "memory"); } } while (0)
      #define WT(b) asm volatile("s_waitcnt lgkmcnt(0)" : "+v"(lo[b][0]), "+v"(lo[b][1]), "+v"(lo[b][2]), "+v"(lo[b][3]), "+v"(hi_[b][0]), "+v"(hi_[b][1]), "+v"(hi_[b][2]), "+v"(hi_[b][3]) :: "memory")
      #define PK(b, k) (bf16x8){lo[b][k][0], lo[b][k][1], lo[b][k][2], lo[b][k][3], hi_[b][k][0], hi_[b][k][1], hi_[b][k][2], hi_[b][k][3]}
      #define EXQ(e) do { if (dbg & 1) { if ((e) < 16) c0[(e)] = 0.25f; else c1[(e) - 16] = 0.25f; } else if ((e) < 16) { c0[(e)] = __builtin_amdgcn_exp2f(c0[(e)]); } else { c1[(e) - 16] = __builtin_amdgcn_exp2f(c1[(e) - 16]); } } while (0)
      #define CE(e) ((e) < 16 ? c0[(e) & 15] : c1[(e) & 15])
      #define SUMQ(e) do { if ((e) >= 0) { if ((e) & 1) so_ = fadd_s(so_, CE(e)); else se_ = fadd_s(se_, CE(e)); } } while (0)
      constexpr int EPM = 32 / (4 * ND);
      #define MM(b, d0) do { _Pragma("unroll") for (int k = 0; k < 4; ++k) { \
          const bf16x8 pa_ = __builtin_bit_cast(bf16x8, k == 0 ? pw0 : k == 1 ? pw1 : k == 2 ? pw2 : pw3); \
          if (!(dbg & 2)) o[d0] = __builtin_amdgcn_mfma_f32_32x32x16_bf16(pa_, PK(b, k), o[d0], 0, 0, 0); \
          _Pragma("unroll") for (int x = 0; x < EPM; ++x) EXQ(((d0) * 4 + k) * EPM + x); \
          _Pragma("unroll") for (int x = 0; x < EPM; ++x) SUMQ(((d0) * 4 + k) * EPM + x - EPM); \
          asm volatile("" : "+v"(c0), "+v"(c1)); SBAR(); } } while (0)
      DMA_PT(2);
      float se_ = 0.f, so_ = 0.f;
      if (!(dbg & 16)) { RD(0, 0); WT(0); } else { _Pragma("unroll") for (int b_ = 0; b_ < 2; ++b_) _Pragma("unroll") for (int k_ = 0; k_ < 4; ++k_) { lo[b_][k_] = (s16x4){0, 0, 0, 0}; hi_[b_][k_] = (s16x4){0, 0, 0, 0}; } }
      #pragma unroll
      for (int d0 = 0; d0 < ND; ++d0) {
        if (d0 + 1 < ND && !(dbg & 16)) { if ((d0 & 1) == 0) RD(1, d0 + 1); else RD(0, d0 + 1); }
        SBAR();
        if (ND == 4) DMA_PT(3 + d0);
        if ((d0 & 1) == 0) MM(0, d0); else MM(1, d0);
        if (d0 + 1 < ND && !(dbg & 16)) { if ((d0 & 1) == 0) WT(1); else WT(0); }
      }
      _Pragma("unroll") for (int x = 0; x < EPM; ++x) SUMQ(32 - EPM + x);
      if (t < NT) l_reg += se_ + so_;
      DMA_PT(7);
      #undef RD
      #undef WT
      #undef PK
      #undef EXQ
      #undef MM
      #undef SUMQ
      #undef CE
    }
    TIM_AT(5);
    if (resc) { resc = false;
      asm volatile("s_waitcnt lgkmcnt(0)" ::: "memory");
      #pragma unroll
      for (int c8 = 0; c8 < 2; ++c8) { float fr_[8];
        #pragma unroll
        for (int r = 0; r < 8; ++r) fr_[r] = wsf[crow(8 * c8 + r, hi)];
        asm volatile("s_waitcnt lgkmcnt(0)" ::: "memory");
        #pragma unroll
        for (int r = 0; r < 8; ++r)
          #pragma unroll
          for (int d = 0; d < ND; ++d) o[d][8 * c8 + r] *= fr_[r]; } }
    if (t < NT) {
      #define PKW(P, B) cvtpk_s(P[B], P[B + 1])
      pw0 = (u32x4){PKW(c0, 0), PKW(c0, 2), PKW(c0, 4), PKW(c0, 6)}; pw1 = (u32x4){PKW(c0, 8), PKW(c0, 10), PKW(c0, 12), PKW(c0, 14)};
      pw2 = (u32x4){PKW(c1, 0), PKW(c1, 2), PKW(c1, 4), PKW(c1, 6)}; pw3 = (u32x4){PKW(c1, 8), PKW(c1, 10), PKW(c1, 12), PKW(c1, 14)};
      #undef PKW
      if (ATT_QKAHEAD) { SBAR(); qkt_r(c0, c1, kf, qr, negm); SBAR(); }
    }
  }
  if (ATT_STAGGER && grp == 0) asm volatile("s_barrier" ::: "memory");
#if MK_TIM
  if (NV == 2 && lane == 0 && tim_cnt) { atomicAdd(&g_tim[0], (unsigned long long)tim_sum); atomicAdd(&g_tim[1], (unsigned long long)tim_cnt); }
#endif
  { auto rr = __builtin_amdgcn_permlane32_swap(__float_as_uint(l_reg), __float_as_uint(l_reg), false, false); l_reg = __uint_as_float(rr[0]) + __uint_as_float(rr[1]); }
  l_reg += __builtin_amdgcn_exp2f(sink2 - mhat);
  if (hi == 0) wsf[32 + r32] = l_reg;
  asm volatile("s_waitcnt vmcnt(0) lgkmcnt(0)\n\ts_barrier" ::: "memory");
  float rli[16];
  #pragma unroll
  for (int c8 = 0; c8 < 2; ++c8) {
    #pragma unroll
    for (int r = 0; r < 8; ++r) rli[8 * c8 + r] = wsf[32 + crow(8 * c8 + r, hi)];
    asm volatile("s_waitcnt lgkmcnt(0)" ::: "memory"); }
  #pragma unroll
  for (int r = 0; r < 16; ++r) rli[r] = __builtin_amdgcn_rcpf(rli[r]);
  bf16_t* Ow = Op + (long)(wid * QBLK) * PO;
  { LAS bf16_t* stg = (LAS bf16_t*)((LAS char*)shm) + wid * (32 * 64 * NV);
    #pragma unroll
    for (int r = 0; r < 16; ++r) { const int orow = crow(r, hi);
      #pragma unroll
      for (int d0 = 0; d0 < ND; ++d0) stg[orow * (64 * NV) + d0 * 32 + r32] = (bf16_t)(cvtpk_s(o[d0][r] * rli[r], 0.f) & 0xffffu); }
    asm volatile("s_waitcnt lgkmcnt(0)" ::: "memory");
    constexpr int CPR = 8 * NV, RPI = 64 / CPR;
    if (NV == 2 && O1p != nullptr) {
      const bf16_t* O1w = O1p + (long)(wid * QBLK) * PO; const int ch = lane % CPR;
      float gv[8];
      { const f32x4 ga = *(const f32x4*)(gsub + ch * 8), gb = *(const f32x4*)(gsub + ch * 8 + 4);
        gv[0] = ga[0] * post; gv[1] = ga[1] * post; gv[2] = ga[2] * post; gv[3] = ga[3] * post; gv[4] = gb[0] * post; gv[5] = gb[1] * post; gv[6] = gb[2] * post; gv[7] = gb[3] * post; }
      #pragma unroll
      for (int i = 0; i < 32 / RPI; ++i) { const int row = i * RPI + lane / CPR;
        const u32x4 q = *(const LAS u32x4*)(stg + row * (64 * NV) + ch * 8); const u32x4 p = *(const u32x4*)(O1w + (long)row * PO + ch * 8);
        float x[8];
        x[0] = bf_lo(p.x) - lam * bf_lo(q.x); x[1] = bf_hi(p.x) - lam * bf_hi(q.x); x[2] = bf_lo(p.y) - lam * bf_lo(q.y); x[3] = bf_hi(p.y) - lam * bf_hi(q.y);
        x[4] = bf_lo(p.z) - lam * bf_lo(q.z); x[5] = bf_hi(p.z) - lam * bf_hi(q.z); x[6] = bf_lo(p.w) - lam * bf_lo(q.w); x[7] = bf_hi(p.w) - lam * bf_hi(q.w);
        float ss = 0.f;
        #pragma unroll
        for (int k = 0; k < 8; ++k) ss += x[k] * x[k];
        #pragma unroll
        for (int sh = 1; sh < 16; sh <<= 1) ss += __int_as_float(__builtin_amdgcn_ds_bpermute((lane ^ sh) << 2, __float_as_int(ss)));
        const float rn = 1.0f / sqrtf(ss * (1.0f / 128.0f) + SUBLN_EPS);
        u32x4 w; w.x = cvtpk_s(x[0] * rn * gv[0], x[1] * rn * gv[1]); w.y = cvtpk_s(x[2] * rn * gv[2], x[3] * rn * gv[3]);
        w.z = cvtpk_s(x[4] * rn * gv[4], x[5] * rn * gv[5]); w.w = cvtpk_s(x[6] * rn * gv[6], x[7] * rn * gv[7]);
        *(u32x4*)(Ow + (long)row * PO + ch * 8) = w; }
    } else {
    #pragma unroll
    for (int i = 0; i < 32 / RPI; ++i) { const int row = i * RPI + lane / CPR, ch = lane % CPR; const u32x4 v = *(const LAS u32x4*)(stg + row * (64 * NV) + ch * 8); *(u32x4*)(Ow + (long)row * PO + ch * 8) = v; } } }
  asm volatile("s_waitcnt lgkmcnt(0)\n\ts_barrier" ::: "memory");
  #undef DMA_K
  #undef DMA_V
}
#undef SBAR
#undef WAIT_BAR
#undef MX3
}
constexpr size_t MiB = 1u << 20;
constexpr size_t WS_CTL = 0, CTL_ZERO_BYTES = 1 * MiB;
constexpr size_t WS_MOD = 1 * MiB;
constexpr size_t WS_LAM = WS_MOD + 512 * 1024;
constexpr size_t WS_WIN = 2 * MiB;
constexpr size_t WS_WOA = 20 * MiB, WS_WOB = 22 * MiB;
constexpr size_t WS_WR = 24 * MiB;
constexpr size_t WS_WGU = 32 * MiB;
constexpr size_t WS_WD = 288 * MiB;
constexpr size_t WS_H = 416 * MiB;
constexpr size_t WS_P = 480 * MiB;
constexpr size_t WS_OA = 752 * MiB, WS_OD = 784 * MiB, WS_OB = 848 * MiB;
constexpr size_t WS_YA = 880 * MiB, WS_Y = 944 * MiB;
constexpr size_t WS_LOG = 1008 * MiB;
constexpr size_t WS_LIST = 1012 * MiB;
constexpr size_t WS_WSLOT = 1016 * MiB;
constexpr size_t WS_LISTW = 1017 * MiB;
constexpr size_t WS_ACT = 1024 * MiB;
constexpr size_t WS_YS = 1296 * MiB;
constexpr size_t WS_SPOS = 1021 * MiB;
constexpr size_t WS_H8 = 1568 * MiB;
constexpr size_t WS_H8M = 1600 * MiB;
constexpr size_t WS_WIN8 = 14 * MiB;
constexpr size_t WS_END = 1632 * MiB;
static_assert((size_t)ACT_ROWS * D * 2 <= WS_H8 - WS_YS && (size_t)ACT_ROWS * FF * 2 <= WS_YS - WS_ACT && (size_t)M * INW * 2 <= WS_OA - WS_P, "ws map");
constexpr int CW_BAR = 4096;
constexpr int CW_CNT = 8192;
constexpr int CW_Q = 16384;

constexpr int RING_OFF = 0, RING_BYTES = 131072;
constexpr int LDSCTL_OFF = RING_BYTES;
constexpr int LW_TOFF = 64, LW_CL = 128, LW_LCNT = 192, LW_LBASE = 256, LW_QK = 320;
constexpr int LDS_BYTES = 147456;
static_assert(attn_body::LDS_BYTES <= RING_BYTES && pg8::STAGE_BYTES <= RING_BYTES, "ring");

#define RLX_AGENT __ATOMIC_RELAXED, __HIP_MEMORY_SCOPE_AGENT
#define LDS_WAIT() asm volatile("s_waitcnt lgkmcnt(0)" ::: "memory")
__device__ __forceinline__ unsigned f2bf(float f) { unsigned u = __builtin_bit_cast(unsigned, f); return (u + 0x7fffu + ((u >> 16) & 1u)) >> 16; }
__device__ __forceinline__ unsigned pk2(float lo, float hi) { return f2bf(lo) | (f2bf(hi) << 16); }

#define XB_TMO      128
#define XB_XCNT(j)  (256  + 64 * (j))
#define XB_XSUB(j)  (1280 + 64 * (j))
#define XB_XGEN(j)  (2304 + 64 * (j))
#define XB_TOP      3328
#define XB_TOPGEN   3392
#define XCD_BAR_WORDS 3456
#define XB_SPIN_CAP (1u << 18)
__device__ __forceinline__ unsigned xb_ld(unsigned* p)              { return __hip_atomic_load(p, __ATOMIC_RELAXED, __HIP_MEMORY_SCOPE_AGENT); }
__device__ __forceinline__ unsigned xb_add(unsigned* p, unsigned v) { return __hip_atomic_fetch_add(p, v, __ATOMIC_RELAXED, __HIP_MEMORY_SCOPE_AGENT); }
__device__ __forceinline__ unsigned xb_xcc_id() { return (unsigned)__builtin_amdgcn_s_getreg((3 << 11) | 20) & 0xFu; }
#define XB_SPIN(cond, bar) do { unsigned _sp = 0; while (cond) { __builtin_amdgcn_s_sleep(1); \
    if ((++_sp & 255u) == 0u) { if (xb_ld(&(bar)[XB_TMO])) break; if (_sp > XB_SPIN_CAP) { atomicAdd(&(bar)[XB_TMO], 1u); break; } } } } while (0)
struct XcdBarrier { unsigned* bar; unsigned x; volatile LAS unsigned* st; };
__device__ __forceinline__ XcdBarrier xcd_barrier_post(unsigned* bar, volatile LAS unsigned* st) {
    XcdBarrier b; b.bar = bar; b.x = xb_xcc_id(); b.st = st;
    if (threadIdx.x == 0) (void)xb_add(&bar[XB_XCNT(b.x)], 1u);
    return b;
}
__device__ __forceinline__ void xcd_barrier_complete(unsigned* bar, unsigned x, unsigned& nloc, unsigned& nx) {
    const unsigned G = gridDim.x * gridDim.y * gridDim.z;
    unsigned sum, cnt, mine, sp = 0u;
    for (;;) {
        sum = 0u; cnt = 0u; mine = 0u;
#pragma unroll
        for (unsigned j = 0; j < 16; ++j) { const unsigned c = xb_ld(&bar[XB_XCNT(j)]); sum += c; cnt += (c > 0u) ? 1u : 0u; mine = (j == x) ? c : mine; }
        if (sum == G) break;
        __builtin_amdgcn_s_sleep(1);
        if ((++sp & 255u) == 0u) { if (xb_ld(&bar[XB_TMO])) break; if (sp > XB_SPIN_CAP) { atomicAdd(&bar[XB_TMO], 1u); break; } }
    }
    nloc = mine > 0u ? mine : 1u; nx = cnt > 0u ? cnt : 1u;
}
__device__ __forceinline__ void xcd_barrier(const XcdBarrier& b) {
    asm volatile("s_waitcnt vmcnt(0)" ::: "memory");
    __syncthreads();
    if (threadIdx.x == 0) {
        unsigned* bar = b.bar; unsigned bx_ = b.x;
        asm volatile("" : "+s"(bar), "+s"(bx_));
        __builtin_amdgcn_s_waitcnt(0);
        unsigned nloc = b.st[0], nx = b.st[1];
        if (nloc == 0u) { xcd_barrier_complete(bar, bx_, nloc, nx); b.st[0] = nloc; b.st[1] = nx; }
        const unsigned old = xb_add(&bar[XB_XSUB(bx_)], 1u);
        const unsigned gen = old / nloc;
        if (old + 1u == (gen + 1u) * nloc) {
            __builtin_amdgcn_fence(__ATOMIC_RELEASE, "agent");
            asm volatile("s_waitcnt vmcnt(0)" ::: "memory");
            const unsigned og = xb_add(&bar[XB_TOP], 1u);
            const unsigned tg = og / nx;
            if (og + 1u == (tg + 1u) * nx) xb_add(&bar[XB_TOPGEN], 1u);
            else XB_SPIN(xb_ld(&bar[XB_TOPGEN]) == tg, bar);
            __builtin_amdgcn_fence(__ATOMIC_ACQUIRE, "agent");
            xb_add(&bar[XB_XGEN(bx_)], 1u);
            asm volatile("s_waitcnt vmcnt(0)" ::: "memory");
        } else {
            XB_SPIN(xb_ld(&bar[XB_XGEN(bx_)]) == gen, bar);
            __builtin_amdgcn_fence(__ATOMIC_ACQUIRE, "agent");
            asm volatile("s_waitcnt vmcnt(0)" ::: "memory");
        }
    }
    __syncthreads();
}

struct Args { const float* in[20]; float* out; unsigned char* ws; };
typedef const __attribute__((address_space(4))) Args* CArgs;
__device__ __forceinline__ CArgs launder(CArgs p) { asm volatile("" : "+s"(p)); return p; }
__device__ __forceinline__ Args load_args(CArgs p) { Args a;
#pragma unroll
    for (int i = 0; i < 20; ++i) a.in[i] = p->in[i];
    a.out = p->out; a.ws = p->ws; return a; }
constexpr int NWAVES = 8;
__device__ __forceinline__ int tid_now() { int t = threadIdx.x; asm volatile("" : "+v"(t)); return t; }
__device__ __forceinline__ float shfl_xor_l(float v, int o, int lane) { return __int_as_float(__builtin_amdgcn_ds_bpermute((lane ^ o) << 2, __float_as_int(v))); }
__device__ __forceinline__ float wave_sum(float v, int lane) {
#pragma unroll
    for (int o = 1; o < 64; o <<= 1) v += shfl_xor_l(v, o, lane);
    return v;
}
__device__ __forceinline__ float lam_init_of(int l) { return 0.8f - 0.6f * expf(-0.3f * (float)l); }
__device__ __forceinline__ int t5_bucket(int n) {
    if (n < 16) return n;
    const float v = logf((float)n / 16.0f) / 2.0794415416798357f * 16.0f;
    const int lg = 16 + (int)v; return lg < 31 ? lg : 31;
}
__device__ __forceinline__ void p0_transpose_item(const float* W, int K, int N, bf16_t* WT, int drow0, float scale, LAS float* scr, int kb, int nb, int lane) {
    const int k0 = 64 * kb, n0 = 32 * nb;
#pragma unroll 8
    for (int i = 0; i < 32; ++i) { const int kk = 2 * i + (lane >> 5); scr[kk * 33 + (lane & 31)] = W[(size_t)(k0 + kk) * N + n0 + (lane & 31)] * scale; }
    LDS_WAIT(); asm volatile("" ::: "memory");
    const int c = lane & 7;
#pragma unroll
    for (int j = 0; j < 4; ++j) { const int n = (lane >> 3) + 8 * j; const LAS float* s = scr + (8 * c) * 33 + n;
        u32x4 o; o.x = pk2(s[0 * 33], s[1 * 33]); o.y = pk2(s[2 * 33], s[3 * 33]); o.z = pk2(s[4 * 33], s[5 * 33]); o.w = pk2(s[6 * 33], s[7 * 33]);
        *(u32x4*)(WT + (size_t)(drow0 + n) * K + k0 + 8 * c) = o; }
    LDS_WAIT(); asm volatile("" ::: "memory");
}

__device__ __forceinline__ void p0_transpose64(const float* W, int K, int N, bf16_t* WT, int drow0, float scale, LAS unsigned* scr, int kb, int nb, int lane) {
    const int k0 = 64 * kb, n0 = 64 * nb, q = lane & 15, kk = lane >> 4;
    f32x4 v[16];
#pragma unroll
    for (int t = 0; t < 16; ++t) { const int k = 8 * (t >> 1) + 2 * kk + (t & 1); v[t] = *(const f32x4*)(W + (size_t)(k0 + k) * N + n0 + 4 * q); }
#pragma unroll
    for (int u = 0; u < 8; ++u)
#pragma unroll
        for (int i = 0; i < 4; ++i) scr[(4 * q + i) * 33 + 4 * u + kk] = cvt_pk_bf16(v[2 * u][i] * scale, v[2 * u + 1][i] * scale);
    LDS_WAIT(); asm volatile("" ::: "memory");
    const int nr = lane >> 3, c = lane & 7;
#pragma unroll
    for (int p = 0; p < 8; ++p) { const int n = 8 * p + nr; const LAS unsigned* s_ = scr + n * 33 + 4 * c;
        u32x4 o; o.x = s_[0]; o.y = s_[1]; o.z = s_[2]; o.w = s_[3];
        *(u32x4*)(WT + (size_t)(drow0 + n) * K + k0 + 8 * c) = o; }
    LDS_WAIT(); asm volatile("" ::: "memory");
}

template <bool NTL = false>
__device__ __forceinline__ void p0_transpose64_f8(const float* W, int K, int N, unsigned char* WT, int drow0, float scale, LAS unsigned* scr, int kb, int nb, int lane) {
    const int k0 = 64 * kb, n0 = 64 * nb, q = lane & 15, kk = lane >> 4;
    f32x4 v[16];
#pragma unroll
    for (int t = 0; t < 16; ++t) { const int k = 16 * (t >> 2) + 4 * kk + (t & 3); const f32x4* p_ = (const f32x4*)(W + (size_t)(k0 + k) * N + n0 + 4 * q); v[t] = NTL ? __builtin_nontemporal_load(p_) : *p_; }
#pragma unroll
    for (int u = 0; u < 4; ++u)
#pragma unroll
        for (int i = 0; i < 4; ++i) scr[(4 * q + i) * 17 + 4 * u + kk] = pk4_fp8(v[4 * u][i] * scale, v[4 * u + 1][i] * scale, v[4 * u + 2][i] * scale, v[4 * u + 3][i] * scale);
    LDS_WAIT(); asm volatile("" ::: "memory");
    const int nr = lane >> 2, c = lane & 3;
#pragma unroll
    for (int p = 0; p < 4; ++p) { const int n = 16 * p + nr; const LAS unsigned* s_ = scr + n * 17 + 4 * c;
        u32x4 o; o.x = s_[0]; o.y = s_[1]; o.z = s_[2]; o.w = s_[3];
        if (NTL) __builtin_nontemporal_store(o, (u32x4*)(WT + (size_t)(drow0 + n) * K + k0 + 16 * c)); else *(u32x4*)(WT + (size_t)(drow0 + n) * K + k0 + 16 * c) = o; }
    LDS_WAIT(); asm volatile("" ::: "memory");
}

template <int MODE>
__device__ __forceinline__ void row_pass(CArgs ap, int l, int vcu, int G, const LAS int* toffl = nullptr) {
    ap = launder(ap); const int tid_ = tid_now(), lane = tid_ & 63, wave = __builtin_amdgcn_readfirstlane(tid_ >> 6); const Args a = load_args(ap);
    unsigned char* ws = a.ws;
    const float* mod = (const float*)(ws + WS_MOD);
    const bf16_t* Y = (const bf16_t*)(ws + WS_Y); const bf16_t* YS = (const bf16_t*)(ws + WS_YS); bf16_t* H = (bf16_t*)(ws + WS_H);
    const float* xin = (MODE == 0 || (MODE == 1 && l == 0)) ? a.in[0] : a.out;
    const bool need_h = (MODE != 2) || (l + 1 < DEPTH);
    const int lh = (MODE == 2) ? l + 1 : l;
    const float* gpre = (MODE == 1) ? a.in[7] + (size_t)l * D : a.in[5] + (size_t)(lh < DEPTH ? lh : 0) * D;
    const float* gpost = (MODE == 1) ? a.in[6] + (size_t)l * D : a.in[8] + (size_t)l * D;
    const int gw = vcu * NWAVES + wave, NGW = G * NWAVES, RPW = (M + NGW - 1) / NGW;
    int m0 = gw * RPW, m1 = m0 + RPW; if (m1 > M) m1 = M;
    f32x4 a_r[4], a_h[4], s_h[4]; int curb = -1;
#ifndef ROWS_PER_STEP
#define ROWS_PER_STEP 2
#endif
    constexpr int RR = ROWS_PER_STEP;
    for (int mb_ = m0; mb_ < m1; mb_ += RR) {
        const int b = mb_ / SEQ;
        if (b != curb) { curb = b;
            const float* mb = mod + (size_t)((l * BATCH + b) * 6) * D; const float* mh = mod + (size_t)(((lh < DEPTH ? lh : 0) * BATCH + b) * 6) * D;
#pragma unroll
            for (int j = 0; j < 4; ++j) { const int c = 4 * lane + 256 * j;
                if (MODE == 1) { a_r[j] = *(const f32x4*)(mb + 2 * D + c) * *(const f32x4*)(gpost + c); a_h[j] = *(const f32x4*)(gpre + c) * (*(const f32x4*)(mb + 4 * D + c) + 1.0f); s_h[j] = *(const f32x4*)(mb + 3 * D + c); }
                else { if (MODE == 2) a_r[j] = *(const f32x4*)(mb + 5 * D + c) * *(const f32x4*)(gpost + c);
                       a_h[j] = *(const f32x4*)(gpre + c) * (*(const f32x4*)(mh + 1 * D + c) + 1.0f); s_h[j] = *(const f32x4*)(mh + 0 * D + c); } } }
        f32x4 xv[RR][4], yv[RR][4]; int mrow[RR];
#pragma unroll
        for (int r = 0; r < RR; ++r) { mrow[r] = (mb_ + r < m1) ? mb_ + r : m1 - 1;
#pragma unroll
            for (int j = 0; j < 4; ++j) xv[r][j] = *(const f32x4*)(xin + (size_t)mrow[r] * D + 4 * lane + 256 * j); }
        if (MODE != 0) {
            if (MODE == 1) {
#pragma unroll
                for (int r = 0; r < RR; ++r)
#pragma unroll
                    for (int j = 0; j < 4; ++j) { const u32x2 w = *(const u32x2*)(Y + (size_t)mrow[r] * D + 4 * lane + 256 * j); yv[r][j] = (f32x4){bf_lo(w.x), bf_hi(w.x), bf_lo(w.y), bf_hi(w.y)}; }
            } else {
                u32x4 sp[RR];
#pragma unroll
                for (int r = 0; r < RR; ++r) sp[r] = *(const u32x4*)(ws + WS_SPOS + (size_t)mrow[r] * TOPK * 4);
                unsigned w8[RR][TOPK][4];
#pragma unroll
                for (int r = 0; r < RR; ++r) { int srow[TOPK];
                    srow[0] = toffl[sp[r].x >> 16] * 256 + (int)(sp[r].x & 0xffffu); srow[1] = toffl[sp[r].y >> 16] * 256 + (int)(sp[r].y & 0xffffu);
                    srow[2] = toffl[sp[r].z >> 16] * 256 + (int)(sp[r].z & 0xffffu); srow[3] = toffl[sp[r].w >> 16] * 256 + (int)(sp[r].w & 0xffffu);
#pragma unroll
                    for (int k = 0; k < TOPK; ++k)
#pragma unroll
                        for (int j = 0; j < 4; ++j) w8[r][k][j] = *(const unsigned*)((const unsigned char*)YS + (size_t)srow[k] * D + 4 * lane + 256 * j); }
#pragma unroll
                for (int r = 0; r < RR; ++r)
#pragma unroll
                    for (int j = 0; j < 4; ++j) { yv[r][j] = (f32x4){0.f, 0.f, 0.f, 0.f};
#pragma unroll
                        for (int k = 0; k < TOPK; ++k) { const auto lo2 = __builtin_amdgcn_cvt_pk_f32_fp8(w8[r][k][j], false), hi2 = __builtin_amdgcn_cvt_pk_f32_fp8(w8[r][k][j], true); yv[r][j] += (f32x4){lo2[0], lo2[1], hi2[0], hi2[1]}; }
                        yv[r][j] = yv[r][j] * (1.0f / F8_SY); }
            }
            float ss[RR];
#pragma unroll
            for (int r = 0; r < RR; ++r) { ss[r] = 0.f;
#pragma unroll
                for (int j = 0; j < 4; ++j) ss[r] += (yv[r][j].x * yv[r][j].x + yv[r][j].y * yv[r][j].y) + (yv[r][j].z * yv[r][j].z + yv[r][j].w * yv[r][j].w); }
#pragma unroll
            for (int r = 0; r < RR; ++r) { const float rn = 1.0f / sqrtf(wave_sum(ss[r], lane) * (1.0f / D) + NORM_EPS);
#pragma unroll
                for (int j = 0; j < 4; ++j) { xv[r][j] = xv[r][j] + a_r[j] * (yv[r][j] * rn); *(f32x4*)(a.out + (size_t)mrow[r] * D + 4 * lane + 256 * j) = xv[r][j]; } }
        }
        if (need_h) {
            float ss[RR];
#pragma unroll
            for (int r = 0; r < RR; ++r) { ss[r] = 0.f;
#pragma unroll
                for (int j = 0; j < 4; ++j) ss[r] += (xv[r][j].x * xv[r][j].x + xv[r][j].y * xv[r][j].y) + (xv[r][j].z * xv[r][j].z + xv[r][j].w * xv[r][j].w); }
#pragma unroll
            for (int r = 0; r < RR; ++r) { const float rn = 1.0f / sqrtf(wave_sum(ss[r], lane) * (1.0f / D) + NORM_EPS);
#pragma unroll
                for (int j = 0; j < 4; ++j) { const f32x4 h = (xv[r][j] * rn) * a_h[j] + s_h[j]; u32x2 w; w.x = cvt_pk_bf16(h.x, h.y); w.y = cvt_pk_bf16(h.z, h.w);
                    *(u32x2*)(H + (size_t)mrow[r] * D + 4 * lane + 256 * j) = w;
                    *(unsigned*)(ws + (MODE == 1 ? WS_H8 : WS_H8M) + (size_t)mrow[r] * D + 4 * lane + 256 * j) = pk4_fp8(h.x * F8_SH, h.y * F8_SH, h.z * F8_SH, h.w * F8_SH); } }
        }
    }
}

__device__ __forceinline__ void diff_combine(CArgs ap, int l, int vcu, int G) {
    ap = launder(ap); const int tid_ = tid_now(), lane = tid_ & 63, wave = __builtin_amdgcn_readfirstlane(tid_ >> 6);
    unsigned char* ws = ap->ws; struct { const float* in[14]; } a; a.in[13] = ap->in[13];
    const bf16_t* O1 = (const bf16_t*)(ws + WS_OD); const bf16_t* O2 = O1 + (size_t)M * 512; bf16_t* OB = (bf16_t*)(ws + WS_OB);
    const float lam = ((const float*)(ws + WS_LAM))[l]; const float post = 1.0f - lam_init_of(l);
    const float* g = a.in[13] + (size_t)l * 128 + (8 * lane) % 128;
    float gv[8];
#pragma unroll
    for (int i = 0; i < 8; ++i) gv[i] = g[i] * post;
    const int gw = vcu * NWAVES + wave, NGW = G * NWAVES;
    for (int m = gw; m < M; m += NGW) {
        const u32x4 p = *(const u32x4*)(O1 + (size_t)m * 512 + 8 * lane), q = *(const u32x4*)(O2 + (size_t)m * 512 + 8 * lane);
        float o[8];
        o[0] = bf_lo(p.x) - lam * bf_lo(q.x); o[1] = bf_hi(p.x) - lam * bf_hi(q.x); o[2] = bf_lo(p.y) - lam * bf_lo(q.y); o[3] = bf_hi(p.y) - lam * bf_hi(q.y);
        o[4] = bf_lo(p.z) - lam * bf_lo(q.z); o[5] = bf_hi(p.z) - lam * bf_hi(q.z); o[6] = bf_lo(p.w) - lam * bf_lo(q.w); o[7] = bf_hi(p.w) - lam * bf_hi(q.w);
        float ss = 0.f;
#pragma unroll
        for (int i = 0; i < 8; ++i) ss += o[i] * o[i];
        ss += shfl_xor_l(ss, 1, lane); ss += shfl_xor_l(ss, 2, lane); ss += shfl_xor_l(ss, 4, lane); ss += shfl_xor_l(ss, 8, lane);
        const float r = 1.0f / sqrtf(ss * (1.0f / 128.0f) + SUBLN_EPS);
        u32x4 w; w.x = cvt_pk_bf16(o[0] * r * gv[0], o[1] * r * gv[1]); w.y = cvt_pk_bf16(o[2] * r * gv[2], o[3] * r * gv[3]);
        w.z = cvt_pk_bf16(o[4] * r * gv[4], o[5] * r * gv[5]); w.w = cvt_pk_bf16(o[6] * r * gv[6], o[7] * r * gv[7]);
        *(u32x4*)(OB + (size_t)m * 512 + 8 * lane) = w;
    }
}

__device__ __forceinline__ void topk_lists(CArgs ap, int l, int G, volatile LAS unsigned* LW) {
    ap = launder(ap);
    unsigned char* ws = ap->ws;
    const float* LOG = (const float*)(ws + WS_LOG); int* LIST = (int*)(ws + WS_LIST); float* WSLOT = (float*)(ws + WS_WSLOT);
    unsigned* CNT = (unsigned*)(ws + WS_CTL) + CW_CNT + l * NE;
    int tid = threadIdx.x; asm volatile("" : "+v"(tid)); const int TPW = (M + G - 1) / G;
    for (int base = blockIdx.x * TPW, done = 0; done < TPW; done += 512) {
        if (tid < NE) LW[LW_LCNT + tid] = 0u;
        __syncthreads();
        const int m = base + done + tid; const bool act = (done + tid < TPW) && (m < M);
        int ek[TOPK]; float wk[TOPK]; unsigned lp[TOPK];
        if (act) {
            float v[NE];
#pragma unroll
            for (int q = 0; q < NE / 4; ++q) { const f32x4 t = *(const f32x4*)(LOG + (size_t)m * NE + 4 * q); v[4 * q] = t.x; v[4 * q + 1] = t.y; v[4 * q + 2] = t.z; v[4 * q + 3] = t.w; }
            unsigned taken = 0u;
#pragma unroll
            for (int k = 0; k < TOPK; ++k) { float best = -INFINITY; int bi = 0;
#pragma unroll
                for (int e = 0; e < NE; ++e) { const bool ok = !((taken >> e) & 1u) && (v[e] > best); best = ok ? v[e] : best; bi = ok ? e : bi; }
                taken |= 1u << bi; ek[k] = bi; wk[k] = best; }
            float s = 0.f; const float mx = wk[0];
#pragma unroll
            for (int k = 0; k < TOPK; ++k) { wk[k] = expf(wk[k] - mx > -80.f ? wk[k] - mx : -80.f); s += wk[k]; }
#pragma unroll
            for (int k = 0; k < TOPK; ++k) { wk[k] = wk[k] / s; lp[k] = __hip_atomic_fetch_add((LAS unsigned*)&LW[LW_LCNT + ek[k]], 1u, __ATOMIC_RELAXED, __HIP_MEMORY_SCOPE_WORKGROUP); }
        }
        __syncthreads();
        if (tid < NE) { const unsigned c = LW[LW_LCNT + tid]; LW[LW_LBASE + tid] = c ? __hip_atomic_fetch_add(CNT + tid, c, RLX_AGENT) : 0u; }
        __syncthreads();
        if (act) {
#pragma unroll
            for (int k = 0; k < TOPK; ++k) { const unsigned pos = LW[LW_LBASE + ek[k]] + lp[k]; __hip_atomic_store(LIST + (size_t)ek[k] * CAP + pos, m * TOPK + k, RLX_AGENT);
                __hip_atomic_store((float*)(ws + WS_LISTW) + (size_t)ek[k] * CAP + pos, wk[k], RLX_AGENT);
                ((unsigned*)(ws + WS_SPOS))[(size_t)m * TOPK + k] = ((unsigned)ek[k] << 16) | pos; }
        }
        __syncthreads();
    }
}

__device__ __forceinline__ void p0_prologue(CArgs ap, LAS unsigned char* lds, int vcu, int G) {
    ap = launder(ap); const Args a = load_args(ap);
    unsigned char* ws = a.ws; const int tid = tid_now(), lane = tid & 63, wave = __builtin_amdgcn_readfirstlane(tid >> 6);
    LAS float* ca = (LAS float*)(lds + RING_OFF); LAS float* red = (LAS float*)(lds + RING_OFF + 8192);
    for (int i = tid; i < BATCH * D; i += NWAVES * 64) { const float v = a.in[1][i]; ca[i] = v / (1.0f + expf(-v)); }
    __syncthreads();
    float* mod = (float*)(ws + WS_MOD);
    for (int it = blockIdx.x; it < DEPTH * (6 * D / 32); it += G) {
        const int l = it / (6 * D / 32), cg = it % (6 * D / 32), c = tid & 31, kc = tid >> 5;
        const float* w = a.in[3] + (size_t)l * D * 6 * D + cg * 32 + c;
        float s0 = 0.f, s1 = 0.f;
#pragma unroll 8
        for (int k = kc * 64; k < kc * 64 + 64; ++k) { const float wv = w[(size_t)k * 6 * D]; s0 += ca[k] * wv; s1 += ca[D + k] * wv; }
        red[(kc * 32 + c) * 2] = s0; red[(kc * 32 + c) * 2 + 1] = s1;
        __syncthreads();
        if (tid < 64) { const int cc = tid & 31, b = tid >> 5; float s = 0.f;
#pragma unroll
            for (int k = 0; k < 16; ++k) s += red[(k * 32 + cc) * 2 + b];
            mod[(size_t)(l * BATCH + b) * 6 * D + cg * 32 + cc] = s + a.in[4][(size_t)l * 6 * D + cg * 32 + cc]; }
        __syncthreads();
    }
    if (blockIdx.x == 0 && wave == 0) {
        for (int l = 0; l < DEPTH; ++l) { const float* lp = a.in[12] + (size_t)l * 256;
            const float s01 = wave_sum(lp[lane] * lp[64 + lane], lane), s23 = wave_sum(lp[128 + lane] * lp[192 + lane], lane);
            if (lane == 0) ((float*)(ws + WS_LAM))[l] = expf(s01) - expf(s23) + lam_init_of(l); }
    }
    { u32x4* z = (u32x4*)(ws + WS_WR); const u32x4 zero = {0u, 0u, 0u, 0u};
      for (int l = 0; l < DEPTH; ++l) for (int i = blockIdx.x * NWAVES * 64 + tid; i < 224 * D * 2 / 16; i += G * NWAVES * 64) z[(size_t)l * (256 * D * 2 / 16) + 32 * D * 2 / 16 + i] = zero; }
    LAS float* scr = (LAS float*)(lds + RING_OFF + wave * 16384); LAS unsigned* scru = (LAS unsigned*)scr;
    const int gw = vcu * NWAVES + wave, NGW = G * NWAVES;
    constexpr int I_IN = 16 * (INW / 64), I_O = 8 * (D / 64), I_R = 16, I_GU1 = 16 * (2 * FF / 64), I_GU = NE * I_GU1, I_D1 = 16 * (D / 64), I_DN = NE * I_D1;
    constexpr int I_LAYER = I_IN + 2 * I_O + I_R + I_GU + I_DN;
    for (int it = gw; it < DEPTH * I_LAYER; it += NGW) {
        const int l = it / I_LAYER; int r = it - l * I_LAYER;
        if (r < I_IN) { const int nblk = INW / 64, kb = r / nblk, nb = r % nblk, n0 = 64 * nb;
            const float sc = (n0 < C_KA || (n0 >= C_QB && n0 < C_KB)) ? QSCALE : 1.0f;
            if (n0 < C_GZA) p0_transpose64(a.in[9] + (size_t)l * D * INW, D, INW, (bf16_t*)(ws + WS_WIN) + (size_t)l * C_GZA * D, n0, sc, scru, kb, nb, lane);
            else p0_transpose64_f8(a.in[9] + (size_t)l * D * INW, D, INW, ws + WS_WIN8 + (size_t)l * (INW - C_GZA) * D, n0 - C_GZA, F8_SW, scru, kb, nb, lane);
            continue; }
        r -= I_IN;
        if (r < 2 * I_O) { const int half = r / I_O; r -= half * I_O; const int nblk = D / 64, kb = r / nblk, nb = r % nblk;
            p0_transpose64(a.in[10] + (size_t)l * D * D + (size_t)half * 512 * D, 512, D, (bf16_t*)(ws + (half ? WS_WOB : WS_WOA)) + (size_t)l * D * 512, 64 * nb, 1.0f, scru, kb, nb, lane); continue; }
        r -= 2 * I_O;
        if (r < I_R) { p0_transpose_item(a.in[14] + (size_t)l * D * NE, D, NE, (bf16_t*)(ws + WS_WR) + (size_t)l * 256 * D, 0, 1.0f, scr, r, 0, lane); continue; }
    }
}

__device__ __forceinline__ void expert_convert(CArgs ap, int l, LAS unsigned char* lds, int c, int G) {
    ap = launder(ap); const Args a = load_args(ap);
    unsigned char* ws = a.ws; const int tid = tid_now(), lane = tid & 63, wave = __builtin_amdgcn_readfirstlane(tid >> 6);
    LAS unsigned* scru = (LAS unsigned*)(lds + RING_OFF + wave * 4608);
    constexpr int I_GU1 = 16 * (2 * FF / 64), I_GU = NE * I_GU1, I_D1 = 16 * (D / 64), I_DN = NE * I_D1;
    const int gw = c * NWAVES + wave, NGW = G * NWAVES;
#pragma unroll 1
    for (int it = gw; it < I_GU + I_DN; it += NGW) { int r = it;
        if (r < I_GU) { const int e = r / I_GU1; r -= e * I_GU1; const int nblk = 2 * FF / 64, kb = r / nblk, nb = r % nblk, n0 = 64 * nb;
            const int j = n0 % FF, drow = (j / 128) * 256 + (n0 >= FF ? 128 : 0) + (j % 128);
            p0_transpose64_f8<true>(a.in[16] + ((size_t)l * NE + e) * D * 2 * FF, D, 2 * FF, ws + WS_WGU + ((size_t)l * NE + e) * 2 * FF * D, drow, F8_SW, scru, kb, nb, lane); continue; }
        r -= I_GU;
        { const int e = r / I_D1; r -= e * I_D1; const int nblk = D / 64, kb = r / nblk, nb = r % nblk;
            p0_transpose64_f8<true>(a.in[18] + ((size_t)l * NE + e) * FF * D, FF, D, ws + WS_WD + ((size_t)l * NE + e) * D * FF, 64 * nb, F8_SW, scru, kb, nb, lane); }
    }
    __syncthreads();
}

__device__ __forceinline__ void attn_fill_tab(const float* rel, int col, bool swa, LAS float* tab) {
    for (int j = tid_now(); j < attn_body::TAB_N; j += NWAVES * 64) {
        const int dist = j - 255; float v;
        if (dist < 0) v = -INFINITY;
        else if (swa) v = dist >= 128 ? -INFINITY : rel[t5_bucket(dist) * NBH + col] * LOG2E;
        else v = (rel[t5_bucket(dist < 127 ? dist : 127) * NBH + col] - rel[31 * NBH + col]) * LOG2E;
        tab[j] = v;
    }
}
#ifndef MK_ADBG
#define MK_ADBG 0
#endif
__device__ __forceinline__ void attn_phase(CArgs ap, int l, char* lds, int vcu, int G, int rep = 0) {
    ap = launder(ap);
    unsigned char* ws = ap->ws; struct { const float* in[14]; } a; a.in[2] = ap->in[2]; a.in[11] = ap->in[11]; a.in[13] = ap->in[13];
    const int dbg = rep ? MK_ADBG : 0;
    const bf16_t* P = (const bf16_t*)(ws + WS_P); bf16_t* OA = (bf16_t*)(ws + (rep ? WS_YA : WS_OA)); bf16_t* OD = (bf16_t*)(ws + (rep ? WS_YA + 32 * MiB : WS_OD)); bf16_t* OBo = (bf16_t*)(ws + (rep ? WS_Y : WS_OB));
    LAS float* tab = (LAS float*)((LAS char*)lds + attn_body::LDS_TAB);
    const float* rel = a.in[2];
    for (int v = vcu; v < 256; v += G) {
        const int u = v & 31, h = (v >> 5) & 3, b = v >> 7;
        attn_fill_tab(rel, HA + h, false, tab);
        const float lam = ((const float*)(ws + WS_LAM))[l], post = 1.0f - lam_init_of(l);
        const float* gsub = a.in[13] + (size_t)l * 128;
#pragma unroll 1
        for (int i = 0; i < 4; ++i) {
            const int mp = i & 1, qb = (i >> 1) ? u : 63 - u;
            const size_t row0 = (size_t)b * SEQ + (size_t)qb * 256;
            const bf16_t* Kp = P + (size_t)b * SEQ * PITCH + C_KB + h * 128 + mp * 64;
            const bf16_t* Vp = P + (size_t)b * SEQ * PITCH + C_VB + h * 128;
            bf16_t* O1 = OD + row0 * 512 + h * 128;
            attn_body::attn_unit<8, PITCH, 512, 2>(P + row0 * PITCH + C_QB + h * 128 + mp * 64, Kp, Vp, mp ? OBo + row0 * 512 + h * 128 : O1,
                                                   (dbg & 64) ? 4 : 4 * (qb + 1), -30.0f, -INFINITY, lds, dbg, mp ? O1 : nullptr, lam, gsub, post);
            if (!rep && i == ((blockIdx.x >> 3) & 3)) expert_convert(ap, l, (LAS unsigned char*)((LAS char*)lds - RING_OFF), blockIdx.x, G);
        }
        if (G == 256) {
            unsigned* Q = (unsigned*)(ws + WS_CTL) + CW_Q + (l * 2 + (rep ? 1 : 0)) * 8;
            volatile LAS unsigned* LWq = (volatile LAS unsigned*)((LAS char*)lds + LDSCTL_OFF - RING_OFF) + LW_QK;
            int qx = blockIdx.x & 7, tries = 0, cur_ha = -1, k0 = 0, kn = 0;
#pragma unroll 1
            for (;;) {
                if (k0 >= kn) {
                    if (tries >= 8) break;
                    const unsigned take = tries == 0 ? 2u : 1u;
                    if (tid_now() == 0) LWq[0] = __hip_atomic_fetch_add(Q + qx, take, RLX_AGENT);
                    __syncthreads(); k0 = (int)LWq[0]; __syncthreads();
                    kn = k0 + (int)take; kn = kn > 128 ? 128 : kn;
                    if (k0 >= 128) { qx = (qx + 1) & 7; ++tries; k0 = kn = 0; continue; }
                }
                const int id = qx * 128 + k0; ++k0;
                const int qb = id & 63, ha = (id >> 6) & 7, bb = id >> 9;
                if (ha != cur_ha) { attn_fill_tab(rel, ha, true, tab); cur_ha = ha; }
                const size_t row0 = (size_t)bb * SEQ + (size_t)qb * 256, krow = row0 - (qb ? 128 : 0);
                const float sink2 = a.in[11][l * HA + ha] * LOG2E;
                attn_body::attn_unit<8, PITCH, 512, 1>(P + row0 * PITCH + C_QA + ha * 64, P + krow * PITCH + C_KA + (ha >> 2) * 64, P + krow * PITCH + C_VA + (ha >> 2) * 64,
                                                       OA + row0 * 512 + ha * 64, qb ? 6 : 4, sink2, sink2, lds, dbg);
            }
        } else {
#pragma unroll 1
        for (int i = 0; i < 4; ++i) {
            const int id = v * 4 + i, qb = id & 63, ha = (id >> 6) & 7, bb = id >> 9;
            if (i == 0) attn_fill_tab(rel, ha, true, tab);
            const size_t row0 = (size_t)bb * SEQ + (size_t)qb * 256, krow = row0 - (qb ? 128 : 0);
            const float sink2 = a.in[11][l * HA + ha] * LOG2E;
            attn_body::attn_unit<8, PITCH, 512, 1>(P + row0 * PITCH + C_QA + ha * 64, P + krow * PITCH + C_KA + (ha >> 2) * 64, P + krow * PITCH + C_VA + (ha >> 2) * 64,
                                                   OA + row0 * 512 + ha * 64, qb ? 6 : 4, sink2, sink2, lds, dbg);
        } }
    }
}

#ifndef MK_PROBE
#define MK_PROBE 0
#endif
#ifndef MK_PFA
#define MK_PFA 0
#endif
constexpr bool PFA_ON = MK_PFA != 0;
#ifndef MK_DUP
#define MK_DUP 0
#endif
constexpr int CW_DIG = 12288;
__device__ __forceinline__ void probe_rows(CArgs ap, const bf16_t* base, int nrows_total, bool by_tile, const LAS int* toff, const LAS int* cl, int vcu, int G) {
    unsigned* DIG = (unsigned*)(launder(ap)->ws + WS_CTL) + CW_DIG;
    const int tid = tid_now(), lane = tid & 63, wave = tid >> 6;
    if (by_tile) {
        const int ntile = toff[NE];
        for (int gt = vcu; gt < ntile; gt += G) {
            int e = 0;
            for (int k = 16; k >= 1; k >>= 1) if (toff[e + k] <= gt) e += k;
            const int rt = gt - toff[e]; int nv = cl[e] - rt * 256; nv = nv > 256 ? 256 : nv;
            unsigned s = 0u;
            for (int r = wave; r < nv; r += NWAVES) { const u32x4* p = (const u32x4*)(base + ((size_t)gt * 256 + r) * 1024 + lane * 16); const u32x4 a = p[0], b = p[1];
                s += (a.x & 0xffffu) + (a.x >> 16) + (a.y & 0xffffu) + (a.y >> 16) + (a.z & 0xffffu) + (a.z >> 16) + (a.w & 0xffffu) + (a.w >> 16);
                s += (b.x & 0xffffu) + (b.x >> 16) + (b.y & 0xffffu) + (b.y >> 16) + (b.z & 0xffffu) + (b.z >> 16) + (b.w & 0xffffu) + (b.w >> 16); }
            __hip_atomic_fetch_add(DIG + e, s, RLX_AGENT);
        }
    } else {
        for (int r = vcu * NWAVES + wave; r < nrows_total; r += G * NWAVES) { const u32x4* p = (const u32x4*)(base + (size_t)r * 1024 + lane * 16); const u32x4 a = p[0], b = p[1];
            unsigned s = (a.x & 0xffffu) + (a.x >> 16) + (a.y & 0xffffu) + (a.y >> 16) + (a.z & 0xffffu) + (a.z >> 16) + (a.w & 0xffffu) + (a.w >> 16);
            s += (b.x & 0xffffu) + (b.x >> 16) + (b.y & 0xffffu) + (b.y >> 16) + (b.z & 0xffffu) + (b.z >> 16) + (b.w & 0xffffu) + (b.w >> 16);
            __hip_atomic_fetch_add(DIG + (r & 31), s, RLX_AGENT); }
    }
}
__device__ __forceinline__ void probe_lists(CArgs ap, int l, int vcu, int G) {
    unsigned char* ws = launder(ap)->ws; unsigned* DIG = (unsigned*)(ws + WS_CTL) + CW_DIG; const int* LIST = (const int*)(ws + WS_LIST);
    const int tid = tid_now();
    for (int e = vcu; e < NE; e += G) { const int cnt = (int)__hip_atomic_load((unsigned*)(ws + WS_CTL) + CW_CNT + l * NE + e, RLX_AGENT);
        unsigned s1 = 0u, s2 = 0u;
        for (int i = tid; i < cnt; i += NWAVES * 64) { const unsigned v = (unsigned)LIST[(size_t)e * CAP + i]; s1 += v; s2 += (v * 2654435761u) >> 9; }
        __hip_atomic_fetch_add(DIG + e, s1, RLX_AGENT); __hip_atomic_fetch_add(DIG + 32 + e, s2 + (unsigned)cnt * 7919u, RLX_AGENT); }
}
__device__ __forceinline__ void probe_dump(CArgs ap) {
    const CArgs aq = launder(ap); const unsigned* DIG = (const unsigned*)(aq->ws + WS_CTL) + CW_DIG; float* out = aq->out; const int tid = tid_now();
    if (blockIdx.x == 0 && tid < 64) out[tid] = (float)(__hip_atomic_load((unsigned*)DIG + tid, RLX_AGENT) & 0x7fffffu) * (1.0f / 65536.0f);
}

__device__ __forceinline__ void probe_region(CArgs ap, size_t off, size_t nwords, int G) {
    unsigned char* ws = launder(ap)->ws; unsigned* DIG = (unsigned*)(ws + WS_CTL) + CW_DIG; const unsigned* src = (const unsigned*)(ws + off);
    const int t = tid_now(); unsigned sacc = 0u;
    for (size_t i = (size_t)blockIdx.x * NWAVES * 64 + t; i < nwords; i += (size_t)G * NWAVES * 64) { const unsigned v = src[i]; sacc += (v & 0xffffu) + (v >> 16); }
    __hip_atomic_fetch_add(DIG + (t & 63), sacc, RLX_AGENT);
}
#define PROBE_AT(id, off, nwords) do { if (MK_PROBE == (id)) { probe_region(ap, off, nwords, G); GRID_BAR(); probe_dump(ap); return; } } while (0)

__global__ void __launch_bounds__(NWAVES * 64, 2) mk_fwd(Args a) {
    extern __shared__ __attribute__((aligned(16))) unsigned char lds_raw[];
    LAS unsigned char* lds = (LAS unsigned char*)lds_raw;
    volatile LAS unsigned* LW = (volatile LAS unsigned*)(lds + LDSCTL_OFF);
    const int tid = tid_now();
    const int G = gridDim.x; const int bx = blockIdx.x; const int vcu = (G % 8 == 0) ? (bx % 8) * (G / 8) + bx / 8 : bx;
    const CArgs ap = (CArgs)__builtin_amdgcn_kernarg_segment_ptr();
    for (int u = tid; u < (LDS_BYTES - LDSCTL_OFF) / 4; u += NWAVES * 64) ((LAS unsigned*)(lds + LDSCTL_OFF))[u] = 0u;
    __syncthreads();
    XcdBarrier bar = xcd_barrier_post((unsigned*)(ap->ws + WS_CTL) + CW_BAR, LW + 8);
#define GRID_BAR() xcd_barrier(bar)

#ifndef PH_MASK
#define PH_MASK 0xFFFF
#endif
#define PH(k) ((PH_MASK >> (k)) & 1)
#pragma unroll 1
    for (int rep = 0; rep < ((MK_DUP & 1) ? 2 : 1); ++rep) {
    if (PH(0)) p0_prologue(ap, lds, vcu, G);
    GRID_BAR(); }
    PROBE_AT(10, WS_MOD, (size_t)DEPTH * BATCH * 6 * D);
    PROBE_AT(11, WS_WIN, (size_t)DEPTH * INW * D / 2);
    PROBE_AT(12, WS_WOA, (size_t)4 * MiB / 4);
    if (PH(0)) row_pass<0>(ap, 0, vcu, G);
    GRID_BAR();
    PROBE_AT(13, WS_H, (size_t)M * D / 2);

#pragma unroll 1
    for (int l = 0; l < DEPTH; ++l) {
#pragma unroll 1
        for (int rep = 0; rep < ((MK_DUP & 2) ? 2 : 1); ++rep) {
        if (PH(1)) { unsigned char* ws = launder(ap)->ws; bf16_t* H = (bf16_t*)(ws + WS_H); bf16_t* P = (bf16_t*)(ws + WS_P);
          { pg8::Gemm g{H, (const bf16_t*)(ws + WS_WIN) + (size_t)l * C_GZA * D, D, 0, nullptr}; pg8::StaticOrder S; S.init(M, C_GZA, G, bx);
            pg8::EpiBf16 E{P, PITCH, 1.0f};
            pg8::gemm_phase<pg8::EpiBf16, pg8::StaticOrder, false, true>(lds + RING_OFF, g, S, E); }
          { pg8::Gemm g{(const bf16_t*)(ws + WS_H8M), (const bf16_t*)(ws + WS_WIN8 + (size_t)l * (INW - C_GZA) * D), D / 2, 0, nullptr}; pg8::StaticOrder S; S.init(M, INW - C_GZA, G, bx, 1);
            pg8::EpiBf16 E{P + C_GZA, PITCH, 1.0f / (F8_SH * F8_SW)};
            pg8::gemm_phase<pg8::EpiBf16, pg8::StaticOrder, false, true, true>(lds + RING_OFF, g, S, E); } }
        GRID_BAR(); }
        PROBE_AT(14, WS_P, (size_t)M * INW / 2);
#pragma unroll 1
        for (int rep = 0; rep < ((MK_DUP & 4) ? 2 : 1); ++rep) {
        if (PH(2)) attn_phase(ap, l, (char*)lds_raw + RING_OFF, vcu, G, rep);
        GRID_BAR(); }
        PROBE_AT(15, WS_OA, (size_t)M * 512 / 2);
        PROBE_AT(16, WS_OD, (size_t)M * 512);
        PROBE_AT(17, WS_OB, (size_t)M * 512 / 2);
        if (PH(4)) { unsigned char* ws = launder(ap)->ws; bf16_t* P = (bf16_t*)(ws + WS_P); pg8::Gemm g{(const bf16_t*)(ws + WS_OA), (const bf16_t*)(ws + WS_WOA) + (size_t)l * D * 512, 512, 0, nullptr}; pg8::StaticOrder S; S.init(M, D, G, bx);
          pg8::EpiGate<true> E{(bf16_t*)(ws + WS_YA), nullptr, P, C_GZA};
          pg8::gemm_phase<pg8::EpiGate<true>, pg8::StaticOrder, false, true>(lds + RING_OFF, g, S, E); }
        GRID_BAR();
        PROBE_AT(18, WS_YA, (size_t)M * D / 2);
        if (PH(5)) { unsigned char* ws = launder(ap)->ws; bf16_t* P = (bf16_t*)(ws + WS_P); pg8::Gemm g{(const bf16_t*)(ws + WS_OB), (const bf16_t*)(ws + WS_WOB) + (size_t)l * D * 512, 512, 0, nullptr}; pg8::StaticOrder S; S.init(M, D, G, bx);
          pg8::EpiGate<false> E{(bf16_t*)(ws + WS_Y), (const bf16_t*)(ws + WS_YA), P, C_GZB};
          pg8::gemm_phase<pg8::EpiGate<false>, pg8::StaticOrder, false, true>(lds + RING_OFF, g, S, E); }
        GRID_BAR();
        PROBE_AT(19, WS_Y, (size_t)M * D / 2);
        if (PH(6)) row_pass<1>(ap, l, vcu, G);
        if (MK_STOP == 1 || (MK_STOP == 3 && l == 1)) return;
        GRID_BAR();
        if (PH(7)) { const CArgs aq = launder(ap); unsigned char* ws = aq->ws; bf16_t* H = (bf16_t*)(ws + WS_H); pg8::Gemm g{H, (const bf16_t*)(ws + WS_WR) + (size_t)l * 256 * D, D, 0, nullptr}; pg8::StaticOrder S; S.init(M, 256, G, bx);
          pg8::EpiRouter E{(float*)(ws + WS_LOG), aq->in[15] + (size_t)l * NE};
          pg8::gemm_phase<pg8::EpiRouter, pg8::StaticOrder, false, true>(lds + RING_OFF, g, S, E); }
        GRID_BAR();
        if (MK_PROBE == 4 || MK_PROBE == 5) { unsigned char* ws = launder(ap)->ws; unsigned* DIG = (unsigned*)(ws + WS_CTL) + CW_DIG; const unsigned* src = (const unsigned*)(ws + (MK_PROBE == 4 ? WS_LOG : WS_H));
            const int n = MK_PROBE == 4 ? M * NE : M * D / 2; const int t = tid_now(); unsigned sacc = 0u;
            for (int i = blockIdx.x * NWAVES * 64 + t; i < n; i += G * NWAVES * 64) { const unsigned v = src[i]; sacc += (v & 0xffffu) + (v >> 16); }
            __hip_atomic_fetch_add(DIG + (t & 63), sacc, RLX_AGENT); GRID_BAR(); probe_dump(ap); return; }
        if (PH(8)) topk_lists(ap, l, G, LW);
        GRID_BAR();
        if (MK_PROBE == 1) { probe_lists(ap, l, vcu, G); GRID_BAR(); probe_dump(ap); return; }
        { unsigned char* ws = launder(ap)->ws; const int tid = tid_now(); if (tid < NE) LW[LW_CL + tid] = __hip_atomic_load((unsigned*)(ws + WS_CTL) + CW_CNT + l * NE + tid, RLX_AGENT);
          __syncthreads();
          if (tid == 0) { unsigned acc = 0u; for (int e = 0; e < NE; ++e) { LW[LW_TOFF + e] = acc; acc += (LW[LW_CL + e] + 255u) >> 8; } LW[LW_TOFF + NE] = acc; }
          __syncthreads(); }
#pragma unroll 1
        for (int rep = 0; rep < ((MK_DUP & 32) ? 2 : 1); ++rep) {
        if (PH(9)) { const CArgs aq = launder(ap); unsigned char* ws = aq->ws; bf16_t* H = (bf16_t*)(ws + WS_H); pg8::Gemm g{(const bf16_t*)(ws + WS_H8), (const bf16_t*)(ws + WS_WGU + (size_t)l * NE * 2 * FF * D), D / 2, (size_t)2 * FF * D / 2, (const int*)(ws + WS_LIST)};
          pg8::MoeOrder S{(const LAS int*)(lds + LDSCTL_OFF) + LW_TOFF, (const LAS int*)(lds + LDSCTL_OFF) + LW_CL, 2 * FF / 256, G, bx};
          pg8::EpiSwiglu8 E{ws + WS_ACT, aq->in[17] + (size_t)l * NE * 2 * FF};
          pg8::gemm_phase<pg8::EpiSwiglu8, pg8::MoeOrder, true, true, true, PFA_ON>(lds + RING_OFF, g, S, E); }
        GRID_BAR(); }
        if (MK_PROBE == 2) { probe_rows(ap, (const bf16_t*)(launder(ap)->ws + WS_ACT), 0, true, (const LAS int*)(lds + LDSCTL_OFF) + LW_TOFF, (const LAS int*)(lds + LDSCTL_OFF) + LW_CL, vcu, G); GRID_BAR(); probe_dump(ap); return; }
#pragma unroll 1
        for (int rep = 0; rep < ((MK_DUP & 64) ? 2 : 1); ++rep) {
        if (PH(10)) { const CArgs aq = launder(ap); unsigned char* ws = aq->ws; pg8::Gemm g{(const bf16_t*)(ws + WS_ACT), (const bf16_t*)(ws + WS_WD + (size_t)l * NE * D * FF), FF / 2, (size_t)D * FF / 2, nullptr};
          pg8::MoeOrder S{(const LAS int*)(lds + LDSCTL_OFF) + LW_TOFF, (const LAS int*)(lds + LDSCTL_OFF) + LW_CL, D / 256, G, bx};
          pg8::EpiDown8 E{ws + WS_YS, aq->in[19] + (size_t)l * NE * D, (const float*)(ws + WS_LISTW), 1.0f / (F8_SACT * F8_SW)};
#if defined(MK_EPIX)
          if (rep == 0 && (MK_DUP & 64)) { pg8::EpiDownX<MK_EPIX> EX{(bf16_t*)(ws + WS_YS), aq->in[19] + (size_t)l * NE * D, (const float*)(ws + WS_LISTW), 1.0f / (F8_SACT * F8_SW)}; pg8::gemm_phase<pg8::EpiDownX<MK_EPIX>, pg8::MoeOrder, false, true, true>(lds + RING_OFF, g, S, EX); } else
#elif defined(MK_NULLEPI)
          if (rep) { pg8::EpiNull EN; pg8::gemm_phase<pg8::EpiNull, pg8::MoeOrder, false, true, true>(lds + RING_OFF, g, S, EN); } else
#endif
          pg8::gemm_phase<pg8::EpiDown8, pg8::MoeOrder, false, true, true, PFA_ON>(lds + RING_OFF, g, S, E); }
        GRID_BAR(); }
        if (MK_PROBE == 3) { probe_rows(ap, (const bf16_t*)(launder(ap)->ws + WS_YS), M * TOPK, false, nullptr, nullptr, vcu, G); GRID_BAR(); probe_dump(ap); return; }
        if (PH(11)) row_pass<2>(ap, l, vcu, G, (const LAS int*)(lds + LDSCTL_OFF) + LW_TOFF);
        if (MK_STOP == 2) return;
        if (l + 1 < DEPTH) GRID_BAR();
    }
#if MK_TIM
    GRID_BAR();
    { const CArgs aq = launder(ap); const float* x = aq->in[0]; float* out = aq->out; const int t = tid_now();
      const unsigned long long s_ = __hip_atomic_load(&attn_body::g_tim[0], RLX_AGENT), c_ = __hip_atomic_load(&attn_body::g_tim[1], RLX_AGENT);
      float sc = (float)((double)s_ / (double)(c_ ? c_ : 1ull)) * (1.0f / MK_TIM);
#ifdef MK_TIM_Q
      sc = MK_TIM_Q * floorf(sc / MK_TIM_Q + 0.5f);
#endif
      for (size_t i = (size_t)blockIdx.x * NWAVES * 64 + t; i < (size_t)M * D; i += (size_t)G * NWAVES * 64) out[i] = x[i] * sc; }
#endif
}

extern "C" void kernel_launch(void* const* d_in, const int* in_sizes, int n_in, void* d_out, int out_size, void* d_ws, size_t ws_size, hipStream_t stream) {
    static int grid = 0;
    if (grid == 0) {
        if (n_in != 20 || in_sizes[0] != M * D || out_size != M * D || ws_size < WS_END) { fprintf(stderr, "kernel_launch: unexpected shapes (n_in %d, in0 %d, out %d, ws %zu < %zu); nothing launched\n", n_in, n_in > 0 ? in_sizes[0] : -1, out_size, ws_size, (size_t)WS_END); grid = -1; return; }
        int dev = 0, cus = 0, per_cu = 0;
        if (hipGetDevice(&dev) != hipSuccess || hipDeviceGetAttribute(&cus, hipDeviceAttributeMultiprocessorCount, dev) != hipSuccess) { grid = -1; return; }
        if (hipFuncSetAttribute((const void*)mk_fwd, hipFuncAttributeMaxDynamicSharedMemorySize, LDS_BYTES) != hipSuccess) { fprintf(stderr, "kernel_launch: hipFuncSetAttribute failed\n"); grid = -1; return; }
        if (hipOccupancyMaxActiveBlocksPerMultiprocessor(&per_cu, (const void*)mk_fwd, NWAVES * 64, LDS_BYTES) != hipSuccess || per_cu < 1)
            fprintf(stderr, "kernel_launch: note: occupancy query reports %d workgroups per CU\n", per_cu);
        (void)hipGetLastError();
        grid = cus > 256 ? 256 : cus;
    }
    if (grid < 0) return;
    if (hipMemsetAsync((char*)d_ws + WS_CTL, 0, CTL_ZERO_BYTES, stream) != hipSuccess) return;
    Args a{};
    for (int i = 0; i < 20; ++i) a.in[i] = (const float*)d_in[i];
    a.out = (float*)d_out; a.ws = (unsigned char*)d_ws;
    hipLaunchKernelGGL(mk_fwd, dim3(grid), dim3(NWAVES * 64), LDS_BYTES, stream, a);
}
```

```cpp
#define XC_SLOT(b) (2)
#include <hip/hip_runtime.h>
#include <cstdio>
#include <cstdint>
#include <cmath>

#ifndef MK_STOP
#define MK_STOP 0
#endif

constexpr int BATCH = 2, SEQ = 16384, D = 1024, M = BATCH * SEQ, DEPTH = 2;
constexpr int INW = 4352, PITCH = INW;
constexpr int C_QA = 0, C_KA = 512, C_VA = 640, C_QB = 768, C_KB = 1280, C_VB = 1792, C_GZA = 2304, C_GZB = 3328;
constexpr int NE = 32, TOPK = 4, FF = 1024, CAP = M;
constexpr int NBH = 12, HA = 8;
constexpr float LOG2E = 1.4426950408889634f, QSCALE = 0.125f * LOG2E;
constexpr float NORM_EPS = 1e-6f, SUBLN_EPS = 1e-5f;
constexpr int ACT_ROWS = M * TOPK + NE * 256;

#define LAS __attribute__((address_space(3)))
#define GAS __attribute__((address_space(1)))
typedef unsigned short bf16_t;
typedef short bf16x8 __attribute__((ext_vector_type(8)));
typedef float f32x4 __attribute__((ext_vector_type(4)));
typedef float f32x2 __attribute__((ext_vector_type(2)));
typedef unsigned u32x4 __attribute__((ext_vector_type(4)));
typedef unsigned u32x2 __attribute__((ext_vector_type(2)));
typedef int v4i_t __attribute__((ext_vector_type(4)));
typedef int v8i_t __attribute__((ext_vector_type(8)));
constexpr float F8_SW = 128.0f, F8_SH = 16.0f, F8_SACT = 4.0f, F8_SY = 32.0f, F8_MAX = 448.0f;
__device__ __forceinline__ float f8clamp(float v) { return fminf(fmaxf(v, -F8_MAX), F8_MAX); }
__device__ __forceinline__ unsigned pk4_fp8(float a, float b, float c, float d) { unsigned w = 0u; w = __builtin_amdgcn_cvt_pk_fp8_f32(f8clamp(a), f8clamp(b), w, false); w = __builtin_amdgcn_cvt_pk_fp8_f32(f8clamp(c), f8clamp(d), w, true); return w; }

__device__ __forceinline__ unsigned cvt_pk_bf16(float lo, float hi) { unsigned r; asm volatile("v_cvt_pk_bf16_f32 %0, %1, %2" : "=v"(r) : "v"(lo), "v"(hi)); return r; }
__device__ __forceinline__ float bf_lo(unsigned w) { return __uint_as_float(w << 16); }
__device__ __forceinline__ float bf_hi(unsigned w) { return __uint_as_float(w & 0xffff0000u); }
__device__ __forceinline__ float sigmoidf_(float v) { return __builtin_amdgcn_rcpf(1.0f + __builtin_amdgcn_exp2f(-v * LOG2E)); }

namespace pg8 {
constexpr int BM = 256, BK = 64, HALF = 128, HTB = HALF * BK * 2, STAGE_BYTES = 8 * HTB, NXCD = 8, WGM = 8;
__host__ __device__ __forceinline__ int lds_byte(int r, int c) { const int st = (r >> 4) * 2 + (c >> 5), rr = r & 15, cc = c & 31, ob = rr * 64 + cc * 2; return st * 1024 + (ob ^ (((ob >> 9) & 1) << 5)); }
__host__ __device__ __forceinline__ void stage_rc(int b, int& R, int& C) { const int st = b / 1024, sb = b % 1024, swz = sb ^ (((sb >> 9) & 1) << 5); R = (st >> 1) * 16 + swz / 64; C = (st & 1) * 32 + (swz % 64) / 2; }
__host__ __device__ __forceinline__ int perm32(int rho) { const int n = rho >> 4, i = rho & 15; return 8 * (i >> 2) + 4 * n + (i & 3); }

template <class E, class = void> struct Perm16 { static constexpr bool v = false; };
template <class E> struct Perm16<E, decltype((void)E::PERM16)> { static constexpr bool v = E::PERM16; };
__host__ __device__ __forceinline__ int perm16x(int R) { return 64 * (R >> 5) + 16 * ((R >> 2) & 3) + 4 * ((R >> 4) & 1) + (R & 3); }
struct Unit { int pm, pn, e, lrow, nvalid; };
struct Gemm { const bf16_t* A; const bf16_t* Bt; int K; size_t estride; const int* rows; };

struct StaticOrder {
    int nM, nN, nwg, G, c, skew;
    __device__ void init(int Mr, int N, int G_, int c_, int skew_ = 0) { nM = Mr / BM; nN = N / BM; nwg = nM * nN; G = G_; c = c_; skew = (skew_ && G_ == 256 && nwg == 1024) ? 1 : 0; }
    __device__ bool next(int i, Unit& u) const {
        long L = (long)i * G + c;
        if (skew) { if (c >= 128) { if (i >= 5) return false; L = (c - 128) + 128 * i; } else { if (i >= 3) return false; L = 640 + c + 128 * i; } }
        if (L >= nwg) return false;
        int wgid = (int)L; { const int q = nwg / NXCD, r = nwg % NXCD, xcd = wgid % NXCD, off = wgid / NXCD; wgid = (xcd < r ? xcd * (q + 1) : r * (q + 1) + (xcd - r) * q) + off; }
        const int nig = WGM * nN, gid = wgid / nig, fm = gid * WGM, gsz = (nM - fm) < WGM ? (nM - fm) : WGM;
        u.pm = fm + ((wgid % nig) % gsz); u.pn = (wgid % nig) / gsz; u.e = 0; u.lrow = 0; u.nvalid = 256; return true;
    }
};
struct MoeOrder {
    const LAS int* toff; const LAS int* cl; int nN, G, c;
    __device__ bool next(int i, Unit& u) const {
        const int ntile = toff[NE]; int gt, pn;
        if ((G & 7) == 0) { const int x = c & 7, s = c >> 3, per = G >> 3, t0 = (ntile * x) >> 3, t1 = (ntile * (x + 1)) >> 3, Lx = i * per + s;
            if (Lx >= (t1 - t0) * nN) return false;
            const int q = Lx / nN; gt = t0 + q; pn = Lx - q * nN; }
        else { const int L = i * G + c; if (L >= ntile * nN) return false; gt = L / nN; pn = L - gt * nN; }
        int e = 0;
#pragma unroll
        for (int k = 16; k >= 1; k >>= 1) if (toff[e + k] <= gt) e += k;
        const int rt = gt - toff[e]; int nv = cl[e] - rt * 256; nv = nv > 256 ? 256 : nv;
        u.pm = __builtin_amdgcn_readfirstlane(gt); u.pn = __builtin_amdgcn_readfirstlane(pn); u.e = __builtin_amdgcn_readfirstlane(e);
        u.lrow = __builtin_amdgcn_readfirstlane(e * CAP + rt * 256); u.nvalid = __builtin_amdgcn_readfirstlane(nv); return true;
    }
};

#ifndef MK_NT
#define MK_NT 1
#endif
#if MK_NT
#define NT_STORE(v, p) __builtin_nontemporal_store(v, p)
#else
#define NT_STORE(v, p) (*(p) = (v))
#endif
struct EpiBf16 {
    static constexpr bool PERM = true;
    bf16_t* O; int ldc; float sc;
    __device__ __forceinline__ void operator()(const f32x4 (&acc)[2][2][4][2], const Unit& u, int wr, int wc, int fr, int fq) const {
        const int row0 = u.pm * BM + wr * 64 + fr, col0 = u.pn * BM + wc * 32 + 8 * fq;
#pragma unroll
        for (int ai = 0; ai < 2; ++ai)
#pragma unroll
            for (int m = 0; m < 4; ++m) { bf16_t* rowp = O + (size_t)(row0 + ai * HALF + m * 16) * ldc + col0;
#pragma unroll
                for (int bj = 0; bj < 2; ++bj) { const f32x4 v0 = acc[ai][bj][m][0] * sc, v1 = acc[ai][bj][m][1] * sc;
                    u32x4 w; w.x = cvt_pk_bf16(v0[0], v0[1]); w.y = cvt_pk_bf16(v0[2], v0[3]); w.z = cvt_pk_bf16(v1[0], v1[1]); w.w = cvt_pk_bf16(v1[2], v1[3]);
                    NT_STORE(w, (u32x4*)(rowp + bj * HALF)); } }
    }
};
template <bool FIRST> struct EpiGate {
    static constexpr bool PERM = true;
    bf16_t* O; const bf16_t* prev; const bf16_t* P; int gcol;
    __device__ __forceinline__ void operator()(const f32x4 (&acc)[2][2][4][2], const Unit& u, int wr, int wc, int fr, int fq) const {
        const int row0 = u.pm * BM + wr * 64 + fr, col0 = u.pn * BM + wc * 32 + 8 * fq;
#pragma unroll
        for (int ai = 0; ai < 2; ++ai)
#pragma unroll
            for (int m = 0; m < 4; ++m) { const size_t row = (size_t)(row0 + ai * HALF + m * 16);
#pragma unroll
                for (int bj = 0; bj < 2; ++bj) { const int col = col0 + bj * HALF;
                    const u32x4 gz = *(const u32x4*)(P + row * PITCH + gcol + col);
                    const f32x4 v0 = acc[ai][bj][m][0], v1 = acc[ai][bj][m][1];
                    float o[8];
                    o[0] = v0[0] * sigmoidf_(bf_lo(gz.x)); o[1] = v0[1] * sigmoidf_(bf_hi(gz.x)); o[2] = v0[2] * sigmoidf_(bf_lo(gz.y)); o[3] = v0[3] * sigmoidf_(bf_hi(gz.y));
                    o[4] = v1[0] * sigmoidf_(bf_lo(gz.z)); o[5] = v1[1] * sigmoidf_(bf_hi(gz.z)); o[6] = v1[2] * sigmoidf_(bf_lo(gz.w)); o[7] = v1[3] * sigmoidf_(bf_hi(gz.w));
                    if (!FIRST) { const u32x4 pv = *(const u32x4*)(prev + row * D + col);
                        o[0] += bf_lo(pv.x); o[1] += bf_hi(pv.x); o[2] += bf_lo(pv.y); o[3] += bf_hi(pv.y); o[4] += bf_lo(pv.z); o[5] += bf_hi(pv.z); o[6] += bf_lo(pv.w); o[7] += bf_hi(pv.w); }
                    u32x4 w; w.x = cvt_pk_bf16(o[0], o[1]); w.y = cvt_pk_bf16(o[2], o[3]); w.z = cvt_pk_bf16(o[4], o[5]); w.w = cvt_pk_bf16(o[6], o[7]);
                    *(u32x4*)(O + row * D + col) = w; } }
    }
};
struct EpiRouter {
    static constexpr bool PERM = false;
    float* L; const float* bias;
    __device__ __forceinline__ void operator()(const f32x4 (&acc)[2][2][4][2], const Unit& u, int wr, int wc, int fr, int fq) const {
        if (wc != 0) return;
        const int row0 = u.pm * BM + wr * 64 + fr, col0 = 4 * fq;
        const f32x4 b0 = *(const f32x4*)(bias + col0), b1 = *(const f32x4*)(bias + col0 + 16);
#pragma unroll
        for (int ai = 0; ai < 2; ++ai)
#pragma unroll
            for (int m = 0; m < 4; ++m) { float* rowp = L + (size_t)(row0 + ai * HALF + m * 16) * NE + col0;
                *(f32x4*)(rowp) = acc[ai][0][m][0] + b0; *(f32x4*)(rowp + 16) = acc[ai][0][m][1] + b1; }
    }
};
struct EpiSwiglu {
    static constexpr bool PERM = true;
    bf16_t* ACT; const float* bgu;
    __device__ __forceinline__ void operator()(const f32x4 (&acc)[2][2][4][2], const Unit& u, int wr, int wc, int fr, int fq) const {
        const int row0 = u.pm * BM + wr * 64 + fr, j0 = u.pn * HALF + wc * 32 + 8 * fq;
        const float* bg = bgu + (size_t)u.e * 2 * FF + j0;
        float g_b[8], u_b[8];
        { const f32x4 a = *(const f32x4*)bg, b = *(const f32x4*)(bg + 4), c = *(const f32x4*)(bg + FF), d = *(const f32x4*)(bg + FF + 4);
#pragma unroll
          for (int i = 0; i < 4; ++i) { g_b[i] = a[i]; g_b[4 + i] = b[i]; u_b[i] = c[i]; u_b[4 + i] = d[i]; } }
#pragma unroll
        for (int ai = 0; ai < 2; ++ai)
#pragma unroll
            for (int m = 0; m < 4; ++m) { bf16_t* rowp = ACT + (size_t)(row0 + ai * HALF + m * 16) * FF + j0;
                float o[8];
#pragma unroll
                for (int n = 0; n < 2; ++n)
#pragma unroll
                    for (int i = 0; i < 4; ++i) { float gt = acc[ai][0][m][n][i] + g_b[4 * n + i], up = acc[ai][1][m][n][i] + u_b[4 * n + i];
                        gt = fminf(gt, 7.0f); up = fminf(fmaxf(up, -7.0f), 7.0f);
                        o[4 * n + i] = gt * __builtin_amdgcn_rcpf(1.0f + __builtin_amdgcn_exp2f(-1.702f * LOG2E * gt)) * (up + 1.0f); }
                u32x4 w; w.x = cvt_pk_bf16(o[0], o[1]); w.y = cvt_pk_bf16(o[2], o[3]); w.z = cvt_pk_bf16(o[4], o[5]); w.w = cvt_pk_bf16(o[6], o[7]);
                *(u32x4*)rowp = w; }
    }
};
struct EpiSwiglu8 {
    static constexpr bool PERM = true;
    unsigned char* ACT; const float* bgu;
    struct Pre { f32x4 a, b, c, d; };
    __device__ __forceinline__ Pre pre(const Unit& u, int wr, int wc, int fr, int fq) const {
        const float* bg = bgu + (size_t)u.e * 2 * FF + u.pn * HALF + wc * 32 + 8 * fq;
        Pre q; q.a = *(const f32x4*)bg; q.b = *(const f32x4*)(bg + 4); q.c = *(const f32x4*)(bg + FF); q.d = *(const f32x4*)(bg + FF + 4); return q; }
    __device__ __forceinline__ void post(const f32x4 (&acc)[2][2][4][2], const Pre& q, const Unit& u, int wr, int wc, int fr, int fq) const {
        constexpr float DS = 1.0f / (F8_SH * F8_SW);
        const int row0 = u.pm * BM + wr * 64 + fr, j0 = u.pn * HALF + wc * 32 + 8 * fq;
        float g_b[8], u_b[8];
#pragma unroll
        for (int i = 0; i < 4; ++i) { g_b[i] = q.a[i]; g_b[4 + i] = q.b[i]; u_b[i] = q.c[i]; u_b[4 + i] = q.d[i]; }
#pragma unroll
        for (int ai = 0; ai < 2; ++ai)
#pragma unroll
            for (int m = 0; m < 4; ++m) { unsigned char* rowp = ACT + (size_t)(row0 + ai * HALF + m * 16) * FF + j0;
                float o[8];
#pragma unroll
                for (int n = 0; n < 2; ++n)
#pragma unroll
                    for (int i = 0; i < 4; ++i) { float gt = acc[ai][0][m][n][i] * DS + g_b[4 * n + i], up = acc[ai][1][m][n][i] * DS + u_b[4 * n + i];
                        gt = fminf(gt, 7.0f); up = fminf(fmaxf(up, -7.0f), 7.0f);
                        o[4 * n + i] = gt * __builtin_amdgcn_rcpf(1.0f + __builtin_amdgcn_exp2f(-1.702f * LOG2E * gt)) * (up + 1.0f) * F8_SACT; }
                u32x2 w; w.x = pk4_fp8(o[0], o[1], o[2], o[3]); w.y = pk4_fp8(o[4], o[5], o[6], o[7]);
                NT_STORE(w, (u32x2*)rowp); }
    }
    __device__ __forceinline__ void operator()(const f32x4 (&acc)[2][2][4][2], const Unit& u, int wr, int wc, int fr, int fq) const { const Pre q = pre(u, wr, wc, fr, fq); post(acc, q, u, wr, wc, fr, fq); }
};
struct EpiDown {
    static constexpr bool PERM = true;
    bf16_t* YS; const float* bd; const float* listw; float ds;
    struct Pre { float ws[8]; f32x4 bv[2][2]; };
    __device__ __forceinline__ Pre pre(const Unit& u, int wr, int wc, int fr, int fq) const {
        const int r0 = wr * 64 + fr, col0 = u.pn * BM + wc * 32 + 8 * fq;
        const float* bp = bd + (size_t)u.e * D + col0;
        Pre q;
#pragma unroll
        for (int g = 0; g < 8; ++g) { const int r = r0 + (g >> 2) * HALF + (g & 3) * 16; q.ws[g] = (r < u.nvalid) ? listw[u.lrow + r] : 0.f; }
#pragma unroll
        for (int bj = 0; bj < 2; ++bj) { q.bv[bj][0] = *(const f32x4*)(bp + bj * HALF); q.bv[bj][1] = *(const f32x4*)(bp + bj * HALF + 4); }
        return q; }
    __device__ __forceinline__ void post(const f32x4 (&acc)[2][2][4][2], const Pre& q, const Unit& u, int wr, int wc, int fr, int fq) const {
        const int r0 = wr * 64 + fr, col0 = u.pn * BM + wc * 32 + 8 * fq;
#pragma unroll
        for (int ai = 0; ai < 2; ++ai)
#pragma unroll
            for (int m = 0; m < 4; ++m) { const float w_ = q.ws[ai * 4 + m]; bf16_t* rowp = YS + (size_t)(u.pm * BM + r0 + ai * HALF + m * 16) * D + col0;
#pragma unroll
                for (int bj = 0; bj < 2; ++bj) { const f32x4 v0 = (acc[ai][bj][m][0] * ds + q.bv[bj][0]) * w_, v1 = (acc[ai][bj][m][1] * ds + q.bv[bj][1]) * w_;
                    u32x4 w; w.x = cvt_pk_bf16(v0[0], v0[1]); w.y = cvt_pk_bf16(v0[2], v0[3]); w.z = cvt_pk_bf16(v1[0], v1[1]); w.w = cvt_pk_bf16(v1[2], v1[3]);
                    NT_STORE(w, (u32x4*)(rowp + bj * HALF)); } }
    }
    __device__ __forceinline__ void operator()(const f32x4 (&acc)[2][2][4][2], const Unit& u, int wr, int wc, int fr, int fq) const { const Pre q = pre(u, wr, wc, fr, fq); post(acc, q, u, wr, wc, fr, fq); }
};

struct EpiDown8 {
    static constexpr bool PERM = true; static constexpr bool PERM16 = true;
    unsigned char* YS; const float* bd; const float* listw; float ds;
    struct Pre { float ws[8]; f32x4 bv[4]; };
    __device__ __forceinline__ Pre pre(const Unit& u, int wr, int wc, int fr, int fq) const {
        const int r0 = wr * 64 + fr, col0 = u.pn * BM + wc * 64 + 16 * fq;
        const float* bp = bd + (size_t)u.e * D + col0;
        Pre q;
#pragma unroll
        for (int g = 0; g < 8; ++g) { const int r = r0 + (g >> 2) * HALF + (g & 3) * 16; q.ws[g] = (r < u.nvalid) ? listw[u.lrow + r] * F8_SY : 0.f; }
#pragma unroll
        for (int j = 0; j < 4; ++j) q.bv[j] = *(const f32x4*)(bp + 4 * j);
        return q; }
    __device__ __forceinline__ void post(const f32x4 (&acc)[2][2][4][2], const Pre& q, const Unit& u, int wr, int wc, int fr, int fq) const {
        const int r0 = wr * 64 + fr, col0 = u.pn * BM + wc * 64 + 16 * fq;
#pragma unroll
        for (int ai = 0; ai < 2; ++ai)
#pragma unroll
            for (int m = 0; m < 4; ++m) { const float w_ = q.ws[ai * 4 + m]; unsigned char* rowp = YS + (size_t)(u.pm * BM + r0 + ai * HALF + m * 16) * D + col0;
                u32x4 w;
#pragma unroll
                for (int bj = 0; bj < 2; ++bj)
#pragma unroll
                    for (int n = 0; n < 2; ++n) { const f32x4 v = (acc[ai][bj][m][n] * ds + q.bv[2 * bj + n]) * w_; w[2 * bj + n] = pk4_fp8(v[0], v[1], v[2], v[3]); }
                NT_STORE(w, (u32x4*)rowp); }
    }
    __device__ __forceinline__ void operator()(const f32x4 (&acc)[2][2][4][2], const Unit& u, int wr, int wc, int fr, int fq) const { const Pre q = pre(u, wr, wc, fr, fq); post(acc, q, u, wr, wc, fr, fq); }
};
#ifdef MK_EPIX
template <int MODE> struct EpiDownX {
    static constexpr bool PERM = true;
    bf16_t* YS; const float* bd; const float* listw; float ds;
    __device__ __forceinline__ void operator()(const f32x4 (&acc)[2][2][4][2], const Unit& u, int wr, int wc, int fr, int fq) const {
        const int r0 = wr * 64 + fr, col0 = u.pn * BM + wc * 32 + 8 * fq;
        const float* bp = bd + (size_t)u.e * D + col0;
        float ws[8]; f32x4 bv[2][2];
        if (MODE != 2) {
#pragma unroll
        for (int g = 0; g < 8; ++g) { const int r = r0 + (g >> 2) * HALF + (g & 3) * 16; ws[g] = (r < u.nvalid) ? listw[u.lrow + r] : 0.f; }
#pragma unroll
        for (int bj = 0; bj < 2; ++bj) { bv[bj][0] = *(const f32x4*)(bp + bj * HALF); bv[bj][1] = *(const f32x4*)(bp + bj * HALF + 4); }
        } else {
#pragma unroll
        for (int g = 0; g < 8; ++g) ws[g] = ds;
#pragma unroll
        for (int bj = 0; bj < 2; ++bj) { bv[bj][0] = (f32x4){ds, ds, ds, ds}; bv[bj][1] = bv[bj][0]; } }
#pragma unroll
        for (int ai = 0; ai < 2; ++ai)
#pragma unroll
            for (int m = 0; m < 4; ++m) { const float w_ = ws[ai * 4 + m]; bf16_t* rowp = YS + (size_t)(u.pm * BM + r0 + ai * HALF + m * 16) * D + col0;
#pragma unroll
                for (int bj = 0; bj < 2; ++bj) { const f32x4 v0 = (acc[ai][bj][m][0] * ds + bv[bj][0]) * w_, v1 = (acc[ai][bj][m][1] * ds + bv[bj][1]) * w_;
                    u32x4 w; w.x = cvt_pk_bf16(v0[0], v0[1]); w.y = cvt_pk_bf16(v0[2], v0[3]); w.z = cvt_pk_bf16(v1[0], v1[1]); w.w = cvt_pk_bf16(v1[2], v1[3]);
                    if (MODE != 1) *(u32x4*)(rowp + bj * HALF) = w; else asm volatile("" :: "v"(w)); } }
    }
};
#endif
struct EpiNull {
    static constexpr bool PERM = true;
    __device__ __forceinline__ void operator()(const f32x4 (&acc)[2][2][4][2], const Unit& u, int wr, int wc, int fr, int fq) const {
#pragma unroll
        for (int ai = 0; ai < 2; ++ai)
#pragma unroll
            for (int bj = 0; bj < 2; ++bj)
#pragma unroll
                for (int m = 0; m < 4; ++m) asm volatile("" :: "v"(acc[ai][bj][m][0]), "v"(acc[ai][bj][m][1]));
    }
};
template <class Epi, class Sched, bool GATHER, bool ALIGN_EPI, bool F8 = false, bool PFA = false>
__device__ __forceinline__ void gemm_phase(LAS unsigned char* lds, const Gemm g, const Sched& S, const Epi& E) {
    int tid = threadIdx.x; asm volatile("" : "+v"(tid));
    const int wid = __builtin_amdgcn_readfirstlane(tid >> 6), lane = tid & 63, wr = wid >> 2, wc = wid & 3, fr = lane & 15, fq = lane >> 4;
    const int K = g.K, nt = K / BK;
    unsigned voffA[2], voffB[2]; int Rg[2], Cg[2];
#pragma unroll
    for (int i = 0; i < 2; ++i) { int R, C; stage_rc(tid * 16 + i * 8192, R, C); const int Rb = Perm16<Epi>::v ? perm16x(R) : Epi::PERM ? ((R & ~31) + perm32(R & 31)) : R;
        voffA[i] = (unsigned)(R * K + C) * 2u; voffB[i] = (unsigned)(Rb * K + C) * 2u; Rg[i] = R; Cg[i] = C; }
    const size_t kstep = (size_t)(BK * 2);
    const size_t hstep = (size_t)HALF * K * 2;
    const size_t tstep = 2 * hstep;
    const unsigned ldsw = (unsigned)wid * 1024u;
    const int aoff = lds_byte(wr * 64 + fr, fq * 8), boff = lds_byte(wc * 32 + fr, fq * 8);
    unsigned vAc[2][2], vAn[2][2];
#define PG8_SA(b, h) (((b) * 2 + (h)) * HTB)
#define PG8_SB(b, h) ((4 + (b) * 2 + (h)) * HTB)
#define PG8_STAGE2(bufoff, gbase, v0, v1) do { \
        __builtin_amdgcn_global_load_lds((const unsigned*)((const char*)(gbase) + (v0)), (LAS unsigned*)(lds + (bufoff) + ldsw), 16, 0, 0); \
        __builtin_amdgcn_global_load_lds((const unsigned*)((const char*)(gbase) + (v1)), (LAS unsigned*)(lds + (bufoff) + ldsw + 8192), 16, 0, 0); } while (0)
#define PG8_STA(bufoff, ap, h, usen) do { if constexpr (GATHER) { const unsigned o0_ = (usen) ? vAn[h][0] : vAc[h][0], o1_ = (usen) ? vAn[h][1] : vAc[h][1]; PG8_STAGE2(bufoff, ap, o0_, o1_); } \
        else { PG8_STAGE2(bufoff, (ap) + (h) * hstep, voffA[0], voffA[1]); } } while (0)
#define PG8_STB(bufoff, bp, h) PG8_STAGE2(bufoff, (bp) + (h) * (Perm16<Epi>::v ? (size_t)8 * K * 2 : hstep), voffB[0], voffB[1])
#define PG8_ROWS(u, v) do { _Pragma("unroll") for (int h_ = 0; h_ < 2; ++h_) _Pragma("unroll") for (int i_ = 0; i_ < 2; ++i_) { const int rr_ = h_ * HALF + Rg[i_]; \
        const int idx_ = (rr_ < (u).nvalid) ? g.rows[(u).lrow + rr_] : 0; v[h_][i_] = (unsigned)((idx_ >> 2) * K + Cg[i_]) * 2u; } \
        asm volatile("" : "+v"(v[0][0]), "+v"(v[0][1]), "+v"(v[1][0]), "+v"(v[1][1])); } while (0)
#define PG8_LDA(dst, b, h) do { _Pragma("unroll") for (int m = 0; m < 4; ++m) _Pragma("unroll") for (int k = 0; k < 2; ++k) dst[m][k] = *(const LAS bf16x8*)(lds + PG8_SA(b, h) + aoff + m * 2048 + k * 1024); } while (0)
#define PG8_LDB(dst, b, h) do { _Pragma("unroll") for (int n = 0; n < 2; ++n) _Pragma("unroll") for (int k = 0; k < 2; ++k) dst[n][k] = *(const LAS bf16x8*)(lds + PG8_SB(b, h) + boff + n * 2048 + k * 1024); } while (0)
#define PG8_CAT(x, y) __builtin_shufflevector(__builtin_bit_cast(v4i_t, x), __builtin_bit_cast(v4i_t, y), 0, 1, 2, 3, 4, 5, 6, 7)
#define PG8_MMA(ai, bj, At, Bt) do { __builtin_amdgcn_s_setprio(1); if constexpr (F8) { \
        _Pragma("unroll") for (int m = 0; m < 4; ++m) _Pragma("unroll") for (int n = 0; n < 2; ++n) \
            { const v8i_t b8_ = PG8_CAT(Bt[n][0], Bt[n][1]), a8_ = PG8_CAT(At[m][0], At[m][1]);     \
              asm volatile("v_mfma_scale_f32_16x16x128_f8f6f4 %0, %1, %2, %0, %3, %3 op_sel_hi:[0,0,0]" : "+v"(acc[ai][bj][m][n]) : "v"(b8_), "v"(a8_), "v"(f8one)); } \
        } else { _Pragma("unroll") for (int m = 0; m < 4; ++m) _Pragma("unroll") for (int n = 0; n < 2; ++n) _Pragma("unroll") for (int k = 0; k < 2; ++k) \
        acc[ai][bj][m][n] = __builtin_amdgcn_mfma_f32_16x16x32_bf16(Bt[n][k], At[m][k], acc[ai][bj][m][n], 0, 0, 0); } __builtin_amdgcn_s_setprio(0); } while (0)
#define PG8_WAIT_V(n) asm volatile("s_waitcnt vmcnt(" #n ")" ::: "memory")
#define PG8_WAIT_L(n) asm volatile("s_waitcnt lgkmcnt(" #n ")" ::: "memory")
#define PG8_BAR __builtin_amdgcn_s_barrier()
#define PG8_SCHED __builtin_amdgcn_sched_barrier(0)
    Unit cur, nxt; int ui = 0;
    if (!S.next(0, cur)) return;
    f32x4 acc[2][2][4][2];
#pragma unroll
    for (int a = 0; a < 2; ++a)
#pragma unroll
        for (int b = 0; b < 2; ++b)
#pragma unroll
            for (int m = 0; m < 4; ++m)
#pragma unroll
                for (int n = 0; n < 2; ++n) acc[a][b][m][n] = (f32x4){0.f, 0.f, 0.f, 0.f};
    bf16x8 At[4][2], B0[2][2], B1[2][2];
    const int f8one = 0x7f7f7f7f;
    const char* cA = GATHER ? (const char*)g.A : (const char*)g.A + (size_t)cur.pm * tstep;
    const char* cB = (const char*)g.Bt + ((size_t)cur.e * g.estride) * 2 + (size_t)cur.pn * tstep;
    if constexpr (GATHER) { PG8_ROWS(cur, vAc); }
    PG8_STB(PG8_SB(0, 0), cB, 0); PG8_STB(PG8_SB(0, 1), cB, 1); PG8_STA(PG8_SA(0, 0), cA, 0, false); PG8_STA(PG8_SA(0, 1), cA, 1, false);
    if (wr == 1) PG8_BAR;
    PG8_WAIT_V(2); PG8_BAR;
    PG8_STB(PG8_SB(1, 0), cB + kstep, 0); PG8_STA(PG8_SA(1, 0), cA + kstep, 0, false); PG8_STB(PG8_SB(1, 1), cB + kstep, 1);
    PG8_WAIT_V(6); PG8_BAR;
    for (;;) {
        const bool has_next = S.next(ui + 1, nxt);
        const char* nA = GATHER ? (const char*)g.A : (has_next ? (const char*)g.A + (size_t)nxt.pm * tstep : cA);
        const char* nB = has_next ? (const char*)g.Bt + ((size_t)nxt.e * g.estride) * 2 + (size_t)nxt.pn * tstep : cB;
        if constexpr (GATHER) { if (has_next) { PG8_ROWS(nxt, vAn); } else {
#pragma unroll
            for (int h = 0; h < 2; ++h) { vAn[h][0] = vAc[h][0]; vAn[h][1] = vAc[h][1]; } } }
        for (int t = 0; t < nt; t += 2) {
            const bool last = (t == nt - 2);
            const char* a1 = cA + (size_t)(t + 1) * kstep;
            const char* a2 = last ? nA : cA + (size_t)(t + 2) * kstep; const char* b2 = last ? nB : cB + (size_t)(t + 2) * kstep;
            const char* a3 = a2 + kstep; const char* b3 = b2 + kstep;
            PG8_LDB(B0, 0, 0); PG8_LDB(B1, 0, 1); PG8_SCHED; PG8_LDA(At, 0, 0); PG8_STA(PG8_SA(1, 1), a1, 1, false);
            PG8_WAIT_V(8); PG8_WAIT_L(0); PG8_BAR; PG8_MMA(0, 0, At, B0); PG8_MMA(0, 1, At, B1); PG8_BAR; PG8_SCHED;
            PG8_LDA(At, 0, 1); PG8_STB(PG8_SB(0, 0), b2, 0); PG8_STB(PG8_SB(0, 1), b2, 1); PG8_STA(PG8_SA(0, 0), a2, 0, last);
            PG8_WAIT_V(8); PG8_WAIT_L(0); PG8_BAR; PG8_MMA(1, 0, At, B0); PG8_MMA(1, 1, At, B1); PG8_BAR; PG8_SCHED;
            PG8_LDB(B0, 1, 0); PG8_LDB(B1, 1, 1); PG8_SCHED; PG8_LDA(At, 1, 0); PG8_STA(PG8_SA(0, 1), a2, 1, last);
            PG8_WAIT_V(8); PG8_WAIT_L(0); PG8_BAR; PG8_MMA(0, 0, At, B0); PG8_MMA(0, 1, At, B1); PG8_BAR; PG8_SCHED;
            PG8_LDA(At, 1, 1); PG8_STB(PG8_SB(1, 0), b3, 0); PG8_STB(PG8_SB(1, 1), b3, 1); PG8_STA(PG8_SA(1, 0), a3, 0, last);
            PG8_WAIT_V(8); PG8_WAIT_L(0); PG8_BAR; PG8_MMA(1, 0, At, B0); PG8_MMA(1, 1, At, B1); PG8_BAR; PG8_SCHED;
        }
        if constexpr (ALIGN_EPI) { if (wr == 0) PG8_BAR; }
        if constexpr (F8) asm volatile("s_nop 15\n\ts_nop 15" ::: "memory");
        if constexpr (PFA) {
            const auto q_ = E.pre(cur, wr, wc, fr, fq);
            PG8_SCHED;
            if (has_next) { LAS unsigned* dump_ = (LAS unsigned*)(lds + STAGE_BYTES + 8192 + ldsw / 4);
                for (int kb = 0; kb < nt * 128; kb += 1024) if (kb > 0 || Cg[0] >= 16) {
#pragma unroll
                    for (int h = 0; h < 2; ++h)
#pragma unroll
                        for (int i = 0; i < 2; ++i) { const char* pa_ = GATHER ? nA + vAn[h][i] : nA + h * hstep + voffA[i];
                            __builtin_amdgcn_global_load_lds((const unsigned*)(pa_ + Cg[i] * 14 + kb), dump_, 4, 0, 0); } } }
            PG8_SCHED;
            E.post(acc, q_, cur, wr, wc, fr, fq);
        } else E(acc, cur, wr, wc, fr, fq);
        if (!has_next) break;
#pragma unroll
        for (int a = 0; a < 2; ++a)
#pragma unroll
            for (int b = 0; b < 2; ++b)
#pragma unroll
                for (int m = 0; m < 4; ++m)
#pragma unroll
                    for (int n = 0; n < 2; ++n) acc[a][b][m][n] = (f32x4){0.f, 0.f, 0.f, 0.f};
        cur = nxt; cA = nA; cB = nB; ++ui;
        if constexpr (GATHER) {
#pragma unroll
            for (int h = 0; h < 2; ++h) { vAc[h][0] = vAn[h][0]; vAc[h][1] = vAn[h][1]; } }
        if constexpr (ALIGN_EPI) { if (wr == 1) PG8_BAR; }
    }
    PG8_WAIT_V(0);
    if constexpr (!ALIGN_EPI) { if (wr == 0) PG8_BAR; }
    PG8_BAR;
#undef PG8_SA
#undef PG8_SB
#undef PG8_STAGE2
#undef PG8_STA
#undef PG8_STB
#undef PG8_ROWS
#undef PG8_LDA
#undef PG8_LDB
#undef PG8_MMA
#undef PG8_CAT
#undef PG8_WAIT_V
#undef PG8_WAIT_L
#undef PG8_BAR
#undef PG8_SCHED
}
}
namespace attn_body {
using bf16x8 = __attribute__((ext_vector_type(8))) short;
using s16x4 = __attribute__((ext_vector_type(4))) short;
using f32x16 = __attribute__((ext_vector_type(16))) float;
constexpr int NW = 8, QBLK = 32, QB = QBLK * NW, KVBLK = 64;
__device__ __forceinline__ int crow(int r, int hi) { return (r & 3) + 8 * (r >> 2) + 4 * hi; }
#define SBAR() __builtin_amdgcn_sched_barrier(0)
constexpr int NSLOT = 4, SLOTK = 8192, SLOTV = 16384;
constexpr int LDS_K = 0, LDS_V = NSLOT * SLOTK, LDS_WS = LDS_V + NSLOT * SLOTV, LDS_TAB = LDS_WS + NW * 64 * 4, TAB_N = 640, LDS_BYTES = LDS_TAB + TAB_N * 4;
__device__ __forceinline__ void glds16(const void* gsrc, unsigned lds_dst) { unsigned keep;
  asm volatile("s_mov_b32 %0, m0\n\ts_mov_b32 m0, %2\n\ts_nop 0\n\tglobal_load_lds_dwordx4 %1, off\n\ts_mov_b32 m0, %0" : "=&s"(keep) : "v"(gsrc), "s"(lds_dst) : "memory"); }
typedef float f32x2_t __attribute__((ext_vector_type(2))); typedef __bf16 bf16x2_t __attribute__((ext_vector_type(2)));
__device__ __forceinline__ unsigned cvtpk_s(float lo, float hi) { f32x2_t v = {lo, hi}; bf16x2_t b = __builtin_convertvector(v, bf16x2_t); return __builtin_bit_cast(unsigned, b); }
#define WAIT_BAR(N) asm volatile("s_waitcnt vmcnt(" #N ") lgkmcnt(0)\n\ts_barrier" ::: "memory")

__device__ __forceinline__ void kload8(bf16x8* kf, const LAS char* Kslot, int r32, int hi);
__device__ __forceinline__ void qkt_r(f32x16& p0, f32x16& p1, const bf16x8* kf, const bf16x8* qr, const f32x16& negm);
__device__ __forceinline__ void qkt(f32x16& p0, f32x16& p1, const LAS char* Kslot, const bf16x8* qr, const f32x16& negm, int r32, int hi) { bf16x8 kf[8]; kload8(kf, Kslot, r32, hi); qkt_r(p0, p1, kf, qr, negm); }
__device__ __forceinline__ float fadd_s(float a, float b) { float r; asm("v_add_f32_e32 %0, %1, %2" : "=v"(r) : "v"(a), "v"(b)); return r; }
__device__ __forceinline__ void kload8(bf16x8* kf, const LAS char* Kslot, int r32, int hi) {
  const unsigned a0 = (unsigned)(uintptr_t)Kslot + r32 * 128 + ((hi ^ ((r32 >> 1) & 7)) << 4);
  #pragma unroll
  for (int d0 = 0; d0 < 4; ++d0) { const LAS char* kb = (const LAS char*)(uintptr_t)(a0 ^ (d0 << 5)); kf[2 * d0] = *(const LAS bf16x8*)(kb); kf[2 * d0 + 1] = *(const LAS bf16x8*)(kb + 4096); }
}
__device__ __forceinline__ void qkt_r(f32x16& p0, f32x16& p1, const bf16x8* kf, const bf16x8* qr, const f32x16& negm) {
  asm volatile("v_mfma_f32_32x32x16_bf16 %0, %1, %2, %3" : "=&v"(p0) : "v"(kf[0]), "v"(qr[0]), "v"(negm));
  asm volatile("v_mfma_f32_32x32x16_bf16 %0, %1, %2, %3" : "=&v"(p1) : "v"(kf[1]), "v"(qr[0]), "v"(negm));
  #pragma unroll
  for (int d0 = 1; d0 < 4; ++d0) {
    asm volatile("v_mfma_f32_32x32x16_bf16 %0, %1, %2, %0" : "+v"(p0) : "v"(kf[2 * d0]), "v"(qr[d0]));
    asm volatile("v_mfma_f32_32x32x16_bf16 %0, %1, %2, %0" : "+v"(p1) : "v"(kf[2 * d0 + 1]), "v"(qr[d0])); }
}
#define MX3(a, b, c) __builtin_fmaxf(__builtin_fmaxf((a), (b)), (c))
__device__ __forceinline__ float rowmax(const f32x16& p0, const f32x16& p1) {
  float a = MX3(p0[0], p0[1], p1[0]), b = MX3(p0[2], p0[3], p1[1]); a = MX3(a, p1[2], p1[3]);
  #pragma unroll
  for (int r = 4; r < 16; r += 4) { a = MX3(a, p0[r], p0[r + 1]); b = MX3(b, p0[r + 2], p0[r + 3]); a = MX3(a, p1[r], p1[r + 1]); b = MX3(b, p1[r + 2], p1[r + 3]); }
  float rm = __builtin_fmaxf(a, b);
  auto rr = __builtin_amdgcn_permlane32_swap(__float_as_uint(rm), __float_as_uint(rm), false, false);
  return __builtin_fmaxf(__uint_as_float(rr[0]), __uint_as_float(rr[1]));
}
__device__ __forceinline__ void bmask(f32x16& p0, f32x16& p1, int jb, int qrel, int hi, const LAS float* tab) {
  const unsigned ta = (unsigned)(uintptr_t)(tab + (255 + qrel - 64 * jb - 4 * hi - 59));
  #pragma unroll
  for (int g = 0; g < 4; ++g) {
    float a0, a1, a2, a3, b0, b1, b2, b3;
    asm volatile("ds_read_b32 %0, %8 offset:%c9\n\tds_read_b32 %1, %8 offset:%c10\n\tds_read_b32 %2, %8 offset:%c11\n\tds_read_b32 %3, %8 offset:%c12\n\t"
                 "ds_read_b32 %4, %8 offset:%c13\n\tds_read_b32 %5, %8 offset:%c14\n\tds_read_b32 %6, %8 offset:%c15\n\tds_read_b32 %7, %8 offset:%c16\n\ts_waitcnt lgkmcnt(0)"
                 : "=&v"(a0), "=&v"(a1), "=&v"(a2), "=&v"(a3), "=&v"(b0), "=&v"(b1), "=&v"(b2), "=&v"(b3)
                 : "v"(ta), "i"(4 * (59 - 8 * g)), "i"(4 * (59 - 8 * g - 1)), "i"(4 * (59 - 8 * g - 2)), "i"(4 * (59 - 8 * g - 3)),
                   "i"(4 * (59 - 8 * g - 32)), "i"(4 * (59 - 8 * g - 33)), "i"(4 * (59 - 8 * g - 34)), "i"(4 * (59 - 8 * g - 35)) : "memory");
    p0[4 * g] += a0; p0[4 * g + 1] += a1; p0[4 * g + 2] += a2; p0[4 * g + 3] += a3;
    p1[4 * g] += b0; p1[4 * g + 1] += b1; p1[4 * g + 2] += b2; p1[4 * g + 3] += b3;
  }
}
template <int ND>
__device__ __forceinline__ void pv(f32x16* o, int vb, bf16x8 pa0, bf16x8 pa1, bf16x8 pa2, bf16x8 pa3) {
  #pragma unroll
  for (int d0 = 0; d0 < ND; d0 += 2) { s16x4 lo[2][4], hi[2][4];
    #pragma unroll
    for (int e = 0; e < 2; ++e)
      #pragma unroll
      for (int ks = 0; ks < 4; ++ks) {
        asm volatile("ds_read_b64_tr_b16 %0,%1 offset:%c2" : "=&v"(lo[e][ks]) : "v"(vb), "i"((d0 + e) * 4096 + ks * 1024) : "memory");
        asm volatile("ds_read_b64_tr_b16 %0,%1 offset:%c2" : "=&v"(hi[e][ks]) : "v"(vb), "i"((d0 + e) * 4096 + ks * 1024 + 512) : "memory"); }
    asm volatile("s_waitcnt lgkmcnt(0)" ::: "memory"); SBAR();
    #define PK(e, k) (bf16x8){lo[e][k][0], lo[e][k][1], lo[e][k][2], lo[e][k][3], hi[e][k][0], hi[e][k][1], hi[e][k][2], hi[e][k][3]}
    o[d0]     = __builtin_amdgcn_mfma_f32_32x32x16_bf16(pa0, PK(0, 0), o[d0], 0, 0, 0);
    o[d0 + 1] = __builtin_amdgcn_mfma_f32_32x32x16_bf16(pa0, PK(1, 0), o[d0 + 1], 0, 0, 0);
    o[d0]     = __builtin_amdgcn_mfma_f32_32x32x16_bf16(pa1, PK(0, 1), o[d0], 0, 0, 0);
    o[d0 + 1] = __builtin_amdgcn_mfma_f32_32x32x16_bf16(pa1, PK(1, 1), o[d0 + 1], 0, 0, 0);
    o[d0]     = __builtin_amdgcn_mfma_f32_32x32x16_bf16(pa2, PK(0, 2), o[d0], 0, 0, 0);
    o[d0 + 1] = __builtin_amdgcn_mfma_f32_32x32x16_bf16(pa2, PK(1, 2), o[d0 + 1], 0, 0, 0);
    o[d0]     = __builtin_amdgcn_mfma_f32_32x32x16_bf16(pa3, PK(0, 3), o[d0], 0, 0, 0);
    o[d0 + 1] = __builtin_amdgcn_mfma_f32_32x32x16_bf16(pa3, PK(1, 3), o[d0 + 1], 0, 0, 0);
    #undef PK
    SBAR();
  }
}

#ifndef MK_TIM
#define MK_TIM 0
#endif
#if MK_TIM
__device__ unsigned long long g_tim[2];
#endif
template <int THRL, int PQ, int PO, int NV>
__device__ __forceinline__ void attn_unit(const bf16_t* Qp, const bf16_t* __restrict__ Kp, const bf16_t* __restrict__ Vp, bf16_t* Op, const int NT, const float mfloor, const float sink2, char* shm, const int dbg = 0,
                                          const bf16_t* O1p = nullptr, const float lam = 0.f, const float* gsub = nullptr, const float post = 0.f) {
  constexpr int ND = 2 * NV;
  int tid = threadIdx.x; asm volatile("" : "+v"(tid));
  const int lane = tid & 63, r32 = lane & 31, hi = lane >> 5; const int wid = __builtin_amdgcn_readfirstlane(tid >> 6);
  const unsigned lds0 = (unsigned)(uintptr_t)shm;
  const LAS char* shm3 = (const LAS char*)shm;
  LAS float* wsf = (LAS float*)((LAS char*)shm + LDS_WS) + wid * 64;
  const LAS float* tab = (const LAS float*)((LAS char*)shm + LDS_TAB);
  const bf16_t* Qw = Qp + (long)(wid * QBLK) * PQ;
  bf16x8 qr[4];
  #pragma unroll
  for (int d0 = 0; d0 < 4; ++d0) qr[d0] = *reinterpret_cast<const bf16x8*>(&Qw[(long)r32 * PQ + d0 * 16 + hi * 8]);
  const bf16_t* ksrc = Kp + (long)(8 * wid + (lane >> 3)) * PQ + (((lane & 7) ^ ((4 * wid + (lane >> 4)) & 7)) * 8);
  const bf16_t* vsrc = Vp + (long)(8 * wid + (lane >> 3)) * PQ + ((((lane >> 2) ^ (lane >> 4)) & 1) * 32) + (lane & 3) * 8;
  const unsigned kdst = lds0 + LDS_K + wid * 1024, vdst = lds0 + LDS_V + wid * 1024;
  #define DMA_K(t, sl) glds16(ksrc + (long)(t) * KVBLK * PQ, (unsigned)__builtin_amdgcn_readfirstlane(kdst + (sl) * SLOTK))
#ifndef MK_DMAX
#define MK_DMAX 0
#endif
  #define DMA_V(t, sl) do { if (MK_DMAX == 1) break; if (MK_DMAX == 2) { const long go_ = (long)(t) * KVBLK * PQ; asm volatile("global_load_lds_dwordx4 %0, off\n\tglobal_load_lds_dwordx4 %1, off" :: "v"(vsrc + go_), "v"(vsrc + go_ + 64) : "memory"); break; } \
      if (MK_DMAX == 3) { const long go_ = (long)(t) * KVBLK * PQ; asm volatile("s_mov_b32 m0, %1\n\ts_nop 0\n\tglobal_load_lds_dwordx4 %0, off" :: "v"(vsrc + go_), "s"((unsigned)__builtin_amdgcn_readfirstlane(vdst + (sl) * SLOTV)) : "memory"); \
        asm volatile("s_mov_b32 m0, %1\n\ts_nop 0\n\tglobal_load_lds_dwordx4 %0, off" :: "v"(vsrc + go_ + 64), "s"((unsigned)__builtin_amdgcn_readfirstlane(vdst + (sl) * SLOTV + 8192)) : "memory"); break; } \
      DMA_V_(t, sl); } while (0)
  #define DMA_V_(t, sl) do { const long go_ = (long)(t) * KVBLK * PQ; glds16(vsrc + go_, (unsigned)__builtin_amdgcn_readfirstlane(vdst + (sl) * SLOTV)); \
      if (NV == 2) glds16(vsrc + go_ + 64, (unsigned)__builtin_amdgcn_readfirstlane(vdst + (sl) * SLOTV + 8192)); } while (0)
  const int vb0 = (int)(lds0 + LDS_V) + (4 * hi + ((lane & 15) >> 2)) * 128 + ((lane >> 3) & 1) * 64 + ((lane >> 4) & 1) * 32 + (lane & 3) * 8;
  float mhat = mfloor, l_reg = 0.f; f32x16 o[ND], negm;
  { float zf = 0.f; asm volatile("" : "+v"(zf));
    _Pragma("unroll") for (int r = 0; r < 16; ++r) { _Pragma("unroll") for (int d = 0; d < ND; ++d) o[d][r] = zf; negm[r] = -mhat; } }
  const int qrel = wid * QBLK + r32;
  DMA_K(0, 0); DMA_V(0, 3); DMA_K(1, 1); DMA_V(0, 0); DMA_K(2, 2); DMA_V(1, 1);
  asm volatile("" :: "v"(qr[0]), "v"(qr[1]), "v"(qr[2]), "v"(qr[3]));
  const int grp = wid >> 2;
  u32x4 pw0, pw1, pw2, pw3; pw0 = pw1 = pw2 = pw3 = (u32x4){0u, 0u, 0u, 0u};
  bool resc = false;
  f32x16 c0, c1;
#ifndef ATT_STAGGER
#define ATT_STAGGER 0
#endif
  if (ATT_STAGGER && grp == 1) { if (NV == 2) WAIT_BAR(6); else WAIT_BAR(4); }
  bf16x8 kf[8];
#ifndef ATT_QKAHEAD
#define ATT_QKAHEAD 0
#endif
  if (!ATT_STAGGER) { if (NV == 2) WAIT_BAR(8); else WAIT_BAR(5); kload8(kf, shm3 + LDS_K, r32, hi); if (ATT_QKAHEAD) { qkt_r(c0, c1, kf, qr, negm); SBAR(); } }
#if MK_TIM
  unsigned long long tim_a = 0ull; unsigned tim_sum = 0u, tim_cnt = 0u; bool tim_have = false;
  #define TIM_AT(k) do { if (NV == 2 && ((k) == MK_TIM_A || (k) == MK_TIM_B)) { unsigned long long tn_; asm volatile("s_memtime %0\n\ts_waitcnt lgkmcnt(0)" : "=s"(tn_) :: "memory"); \
      if ((k) == MK_TIM_B && tim_have) { tim_sum += (unsigned)(tn_ - tim_a); ++tim_cnt; } \
      if ((k) == MK_TIM_A) { tim_a = tn_; tim_have = true; } } } while (0)
#else
  #define TIM_AT(k) do { } while (0)
#endif
#ifndef ATT_SPREAD
#define ATT_SPREAD 0
#endif
#ifndef ATT_DMAPT
#define ATT_DMAPT 1
#endif
  #define DMA_PT(k) do { if ((NV == 2 && ATT_SPREAD) ? (wid == (k)) : ((k) == ATT_DMAPT)) { const int tk_ = t + 3 < NT ? t + 3 : NT - 1, tv_ = t + 2 < NT ? t + 2 : NT - 1; DMA_K(tk_, (t + 3) & 3); DMA_V(tv_, (t + 2) & 3); } } while (0)
  #pragma unroll 1
  for (int t = 0; t <= NT; ++t) {
    TIM_AT(0);
    if (dbg & 32) { } else if (ATT_STAGGER) { if (NV == 2) WAIT_BAR(6); else WAIT_BAR(4); } else { if (NV == 2) WAIT_BAR(5); else WAIT_BAR(3); }
    TIM_AT(1);
    DMA_PT(0);
    TIM_AT(2);
    if (ATT_QKAHEAD) { kload8(kf, shm3 + LDS_K + ((t + 1) & 3) * SLOTK, r32, hi); SBAR(); TIM_AT(3); DMA_PT(1); }
    else { qkt_r(c0, c1, kf, qr, negm); SBAR(); TIM_AT(3); kload8(kf, shm3 + LDS_K + ((t + 1) & 3) * SLOTK, r32, hi); SBAR(); DMA_PT(1); }
    SBAR();
    const int jb = t - (NT - 4);
    if (jb >= -2 && jb <= 3) bmask(c0, c1, jb, qrel, hi, tab);
    const float rm = rowmax(c0, c1);
    if (t < NT && __any(rm > (float)THRL)) {
      const float dl = __builtin_fmaxf(rm, 0.f);
      mhat += dl;
      #pragma unroll
      for (int r = 0; r < 16; ++r) { c0[r] -= dl; c1[r] -= dl; negm[r] = -mhat; }
      const float f = __builtin_amdgcn_exp2f(-dl); l_reg *= f;
      if (hi == 0) wsf[r32] = f;
      resc = true;
    }
    if ((dbg & 32) || !ATT_STAGGER) { } else if (NV == 2) WAIT_BAR(5); else WAIT_BAR(3);
    if (ATT_STAGGER) { const int tk = t + 3 < NT ? t + 3 : NT - 1, tv = t + 2 < NT ? t + 2 : NT - 1;
      if (!(dbg & 4)) { DMA_K(tk, (t + 3) & 3); DMA_V(tv, (t + 2) & 3); } }
    { const int vb = vb0 + ((t + 3) & 3) * SLOTV, vbo = vb ^ 64;
      s16x4 lo[2][4], hi_[2][4];
      #define RD(b, d0) do { _Pragma("unroll") for (int ks = 0; ks < 4; ++ks) { \
          asm volatile("ds_read_b64_tr_b16 %0,%1 offset:%c2" : "=v"(lo[b][ks]) : "v"(((d0) & 1) ? vbo : vb), "i"(((d0) >> 1) * 8192 + ks * 2048) : "memory"); \
          asm volatile("ds_read_b64_tr_b16 %0,%1 offset:%c2" : "=v"(hi_[b][ks]) : "v"(((d0) & 1) ? vbo : vb), "i"(((d0) >> 1) * 8192 + ks * 2048 + 1024) : "memory"); } } while (0)
      #define WT(b) asm volatile("s_waitcnt lgkmcnt(0)" : "+v"(lo[b][0]), "+v"(lo[b][1]), "+v"(lo[b][2]), "+v"(lo[b][3]), "+v"(hi_[b][0]), "+v"(hi_[b][1]), "+v"(hi_[b][2]), "+v"(hi_[b][3]) :: "memory")
      #define PK(b, k) (bf16x8){lo[b][k][0], lo[b][k][1], lo[b][k][2], lo[b][k][3], hi_[b][k][0], hi_[b][k][1], hi_[b][k][2], hi_[b][k][3]}
      #define EXQ(e) do { if (dbg & 1) { if ((e) < 16) c0[(e)] = 0.25f; else c1[(e) - 16] = 0.25f; } else if ((e) < 16) { c0[(e)] = __builtin_amdgcn_exp2f(c0[(e)]); } else { c1[(e) - 16] = __builtin_amdgcn_exp2f(c1[(e) - 16]); } } while (0)
      #define CE(e) ((e) < 16 ? c0[(e) & 15] : c1[(e) & 15])
      #define SUMQ(e) do { if ((e) >= 0) { if ((e) & 1) so_ = fadd_s(so_, CE(e)); else se_ = fadd_s(se_, CE(e)); } } while (0)
      constexpr int EPM = 32 / (4 * ND);
      #define MM(b, d0) do { _Pragma("unroll") for (int k = 0; k < 4; ++k) { \
          const bf16x8 pa_ = __builtin_bit_cast(bf16x8, k == 0 ? pw0 : k == 1 ? pw1 : k == 2 ? pw2 : pw3); \
          if (!(dbg & 2)) o[d0] = __builtin_amdgcn_mfma_f32_32x32x16_bf16(pa_, PK(b, k), o[d0], 0, 0, 0); \
          _Pragma("unroll") for (int x = 0; x < EPM; ++x) EXQ(((d0) * 4 + k) * EPM + x); \
          _Pragma("unroll") for (int x = 0; x < EPM; ++x) SUMQ(((d0) * 4 + k) * EPM + x - EPM); \
          asm volatile("" : "+v"(c0), "+v"(c1)); SBAR(); } } while (0)
      DMA_PT(2);
      float se_ = 0.f, so_ = 0.f;
      if (!(dbg & 16)) { RD(0, 0); WT(0); } else { _Pragma("unroll") for (int b_ = 0; b_ < 2; ++b_) _Pragma("unroll") for (int k_ = 0; k_ < 4; ++k_) { lo[b_][k_] = (s16x4){0, 0, 0, 0}; hi_[b_][k_] = (s16x4){0, 0, 0, 0}; } }
      #pragma unroll
      for (int d0 = 0; d0 < ND; ++d0) {
        if (d0 + 1 < ND && !(dbg & 16)) { if ((d0 & 1) == 0) RD(1, d0 + 1); else RD(0, d0 + 1); }
        SBAR();
        if (ND == 4) DMA_PT(3 + d0);
        if ((d0 & 1) == 0) MM(0, d0); else MM(1, d0);
        if (d0 + 1 < ND && !(dbg & 16)) { if ((d0 & 1) == 0) WT(1); else WT(0); }
      }
      _Pragma("unroll") for (int x = 0; x < EPM; ++x) SUMQ(32 - EPM + x);
      if (t < NT) l_reg += se_ + so_;
      DMA_PT(7);
      #undef RD
      #undef WT
      #undef PK
      #undef EXQ
      #undef MM
      #undef SUMQ
      #undef CE
    }
    TIM_AT(5);
    if (resc) { resc = false;
      asm volatile("s_waitcnt lgkmcnt(0)" ::: "memory");
      #pragma unroll
      for (int c8 = 0; c8 < 2; ++c8) { float fr_[8];
        #pragma unroll
        for (int r = 0; r < 8; ++r) fr_[r] = wsf[crow(8 * c8 + r, hi)];
        asm volatile("s_waitcnt lgkmcnt(0)" ::: "memory");
        #pragma unroll
        for (int r = 0; r < 8; ++r)
          #pragma unroll
          for (int d = 0; d < ND; ++d) o[d][8 * c8 + r] *= fr_[r]; } }
    if (t < NT) {
      #define PKW(P, B) cvtpk_s(P[B], P[B + 1])
      pw0 = (u32x4){PKW(c0, 0), PKW(c0, 2), PKW(c0, 4), PKW(c0, 6)}; pw1 = (u32x4){PKW(c0, 8), PKW(c0, 10), PKW(c0, 12), PKW(c0, 14)};
      pw2 = (u32x4){PKW(c1, 0), PKW(c1, 2), PKW(c1, 4), PKW(c1, 6)}; pw3 = (u32x4){PKW(c1, 8), PKW(c1, 10), PKW(c1, 12), PKW(c1, 14)};
      #undef PKW
      if (ATT_QKAHEAD) { SBAR(); qkt_r(c0, c1, kf, qr, negm); SBAR(); }
    }
  }
  if (ATT_STAGGER && grp == 0) asm volatile("s_barrier" ::: "memory");
#if MK_TIM
  if (NV == 2 && lane == 0 && tim_cnt) { atomicAdd(&g_tim[0], (unsigned long long)tim_sum); atomicAdd(&g_tim[1], (unsigned long long)tim_cnt); }
#endif
  { auto rr = __builtin_amdgcn_permlane32_swap(__float_as_uint(l_reg), __float_as_uint(l_reg), false, false); l_reg = __uint_as_float(rr[0]) + __uint_as_float(rr[1]); }
  l_reg += __builtin_amdgcn_exp2f(sink2 - mhat);
  if (hi == 0) wsf[32 + r32] = l_reg;
  asm volatile("s_waitcnt vmcnt(0) lgkmcnt(0)\n\ts_barrier" ::: "memory");
  float rli[16];
  #pragma unroll
  for (int c8 = 0; c8 < 2; ++c8) {
    #pragma unroll
    for (int r = 0; r < 8; ++r) rli[8 * c8 + r] = wsf[32 + crow(8 * c8 + r, hi)];
    asm volatile("s_waitcnt lgkmcnt(0)" ::: "memory"); }
  #pragma unroll
  for (int r = 0; r < 16; ++r) rli[r] = __builtin_amdgcn_rcpf(rli[r]);
  bf16_t* Ow = Op + (long)(wid * QBLK) * PO;
  { LAS bf16_t* stg = (LAS bf16_t*)((LAS char*)shm) + wid * (32 * 64 * NV);
    #pragma unroll
    for (int r = 0; r < 16; ++r) { const int orow = crow(r, hi);
      #pragma unroll
      for (int d0 = 0; d0 < ND; ++d0) stg[orow * (64 * NV) + d0 * 32 + r32] = (bf16_t)(cvtpk_s(o[d0][r] * rli[r], 0.f) & 0xffffu); }
    asm volatile("s_waitcnt lgkmcnt(0)" ::: "memory");
    constexpr int CPR = 8 * NV, RPI = 64 / CPR;
    if (NV == 2 && O1p != nullptr) {
      const bf16_t* O1w = O1p + (long)(wid * QBLK) * PO; const int ch = lane % CPR;
      float gv[8];
      { const f32x4 ga = *(const f32x4*)(gsub + ch * 8), gb = *(const f32x4*)(gsub + ch * 8 + 4);
        gv[0] = ga[0] * post; gv[1] = ga[1] * post; gv[2] = ga[2] * post; gv[3] = ga[3] * post; gv[4] = gb[0] * post; gv[5] = gb[1] * post; gv[6] = gb[2] * post; gv[7] = gb[3] * post; }
      #pragma unroll
      for (int i = 0; i < 32 / RPI; ++i) { const int row = i * RPI + lane / CPR;
        const u32x4 q = *(const LAS u32x4*)(stg + row * (64 * NV) + ch * 8); const u32x4 p = *(const u32x4*)(O1w + (long)row * PO + ch * 8);
        float x[8];
        x[0] = bf_lo(p.x) - lam * bf_lo(q.x); x[1] = bf_hi(p.x) - lam * bf_hi(q.x); x[2] = bf_lo(p.y) - lam * bf_lo(q.y); x[3] = bf_hi(p.y) - lam * bf_hi(q.y);
        x[4] = bf_lo(p.z) - lam * bf_lo(q.z); x[5] = bf_hi(p.z) - lam * bf_hi(q.z); x[6] = bf_lo(p.w) - lam * bf_lo(q.w); x[7] = bf_hi(p.w) - lam * bf_hi(q.w);
        float ss = 0.f;
        #pragma unroll
        for (int k = 0; k < 8; ++k) ss += x[k] * x[k];
        #pragma unroll
        for (int sh = 1; sh < 16; sh <<= 1) ss += __int_as_float(__builtin_amdgcn_ds_bpermute((lane ^ sh) << 2, __float_as_int(ss)));
        const float rn = 1.0f / sqrtf(ss * (1.0f / 128.0f) + SUBLN_EPS);
        u32x4 w; w.x = cvtpk_s(x[0] * rn * gv[0], x[1] * rn * gv[1]); w.y = cvtpk_s(x[2] * rn * gv[2], x[3] * rn * gv[3]);
        w.z = cvtpk_s(x[4] * rn * gv[4], x[5] * rn * gv[5]); w.w = cvtpk_s(x[6] * rn * gv[6], x[7] * rn * gv[7]);
        *(u32x4*)(Ow + (long)row * PO + ch * 8) = w; }
    } else {
    #pragma unroll
    for (int i = 0; i < 32 / RPI; ++i) { const int row = i * RPI + lane / CPR, ch = lane % CPR; const u32x4 v = *(const LAS u32x4*)(stg + row * (64 * NV) + ch * 8); *(u32x4*)(Ow + (long)row * PO + ch * 8) = v; } } }
  asm volatile("s_waitcnt lgkmcnt(0)\n\ts_barrier" ::: "memory");
  #undef DMA_K
  #undef DMA_V
}
#undef SBAR
#undef WAIT_BAR
#undef MX3
}
#ifndef XC_SLOT
#define XC_SLOT(b) (((b) >> 3) & 3)
#endif
constexpr size_t MiB = 1u << 20;
constexpr size_t WS_CTL = 0, CTL_ZERO_BYTES = 1 * MiB;
constexpr size_t WS_MOD = 1 * MiB;
constexpr size_t WS_LAM = WS_MOD + 512 * 1024;
constexpr size_t WS_WIN = 2 * MiB;
constexpr size_t WS_WOA = 20 * MiB, WS_WOB = 22 * MiB;
constexpr size_t WS_WR = 24 * MiB;
constexpr size_t WS_WGU = 32 * MiB;
constexpr size_t WS_WD = 288 * MiB;
constexpr size_t WS_H = 416 * MiB;
constexpr size_t WS_P = 480 * MiB;
constexpr size_t WS_OA = 752 * MiB, WS_OD = 784 * MiB, WS_OB = 848 * MiB;
constexpr size_t WS_YA = 880 * MiB, WS_Y = 944 * MiB;
constexpr size_t WS_LOG = 1008 * MiB;
constexpr size_t WS_LIST = 1012 * MiB;
constexpr size_t WS_WSLOT = 1016 * MiB;
constexpr size_t WS_LISTW = 1017 * MiB;
constexpr size_t WS_ACT = 1024 * MiB;
constexpr size_t WS_YS = 1296 * MiB;
constexpr size_t WS_SPOS = 1021 * MiB;
constexpr size_t WS_H8 = 1568 * MiB;
constexpr size_t WS_H8M = 1600 * MiB;
constexpr size_t WS_WIN8 = 14 * MiB;
constexpr size_t WS_END = 1632 * MiB;
static_assert((size_t)ACT_ROWS * D * 2 <= WS_H8 - WS_YS && (size_t)ACT_ROWS * FF * 2 <= WS_YS - WS_ACT && (size_t)M * INW * 2 <= WS_OA - WS_P, "ws map");
constexpr int CW_BAR = 4096;
constexpr int CW_CNT = 8192;
constexpr int CW_Q = 16384;

constexpr int RING_OFF = 0, RING_BYTES = 131072;
constexpr int LDSCTL_OFF = RING_BYTES;
constexpr int LW_TOFF = 64, LW_CL = 128, LW_LCNT = 192, LW_LBASE = 256, LW_QK = 320;
constexpr int LDS_BYTES = 147456;
static_assert(attn_body::LDS_BYTES <= RING_BYTES && pg8::STAGE_BYTES <= RING_BYTES, "ring");

#define RLX_AGENT __ATOMIC_RELAXED, __HIP_MEMORY_SCOPE_AGENT
#define LDS_WAIT() asm volatile("s_waitcnt lgkmcnt(0)" ::: "memory")
__device__ __forceinline__ unsigned f2bf(float f) { unsigned u = __builtin_bit_cast(unsigned, f); return (u + 0x7fffu + ((u >> 16) & 1u)) >> 16; }
__device__ __forceinline__ unsigned pk2(float lo, float hi) { return f2bf(lo) | (f2bf(hi) << 16); }

#define XB_TMO      128
#define XB_XCNT(j)  (256  + 64 * (j))
#define XB_XSUB(j)  (1280 + 64 * (j))
#define XB_XGEN(j)  (2304 + 64 * (j))
#define XB_TOP      3328
#define XB_TOPGEN   3392
#define XCD_BAR_WORDS 3456
#define XB_SPIN_CAP (1u << 18)
__device__ __forceinline__ unsigned xb_ld(unsigned* p)              { return __hip_atomic_load(p, __ATOMIC_RELAXED, __HIP_MEMORY_SCOPE_AGENT); }
__device__ __forceinline__ unsigned xb_add(unsigned* p, unsigned v) { return __hip_atomic_fetch_add(p, v, __ATOMIC_RELAXED, __HIP_MEMORY_SCOPE_AGENT); }
__device__ __forceinline__ unsigned xb_xcc_id() { return (unsigned)__builtin_amdgcn_s_getreg((3 << 11) | 20) & 0xFu; }
#define XB_SPIN(cond, bar) do { unsigned _sp = 0; while (cond) { __builtin_amdgcn_s_sleep(1); \
    if ((++_sp & 255u) == 0u) { if (xb_ld(&(bar)[XB_TMO])) break; if (_sp > XB_SPIN_CAP) { atomicAdd(&(bar)[XB_TMO], 1u); break; } } } } while (0)
struct XcdBarrier { unsigned* bar; unsigned x; volatile LAS unsigned* st; };
__device__ __forceinline__ XcdBarrier xcd_barrier_post(unsigned* bar, volatile LAS unsigned* st) {
    XcdBarrier b; b.bar = bar; b.x = xb_xcc_id(); b.st = st;
    if (threadIdx.x == 0) (void)xb_add(&bar[XB_XCNT(b.x)], 1u);
    return b;
}
__device__ __forceinline__ void xcd_barrier_complete(unsigned* bar, unsigned x, unsigned& nloc, unsigned& nx) {
    const unsigned G = gridDim.x * gridDim.y * gridDim.z;
    unsigned sum, cnt, mine, sp = 0u;
    for (;;) {
        sum = 0u; cnt = 0u; mine = 0u;
#pragma unroll
        for (unsigned j = 0; j < 16; ++j) { const unsigned c = xb_ld(&bar[XB_XCNT(j)]); sum += c; cnt += (c > 0u) ? 1u : 0u; mine = (j == x) ? c : mine; }
        if (sum == G) break;
        __builtin_amdgcn_s_sleep(1);
        if ((++sp & 255u) == 0u) { if (xb_ld(&bar[XB_TMO])) break; if (sp > XB_SPIN_CAP) { atomicAdd(&bar[XB_TMO], 1u); break; } }
    }
    nloc = mine > 0u ? mine : 1u; nx = cnt > 0u ? cnt : 1u;
}
__device__ __forceinline__ void xcd_barrier(const XcdBarrier& b) {
    asm volatile("s_waitcnt vmcnt(0)" ::: "memory");
    __syncthreads();
    if (threadIdx.x == 0) {
        unsigned* bar = b.bar; unsigned bx_ = b.x;
        asm volatile("" : "+s"(bar), "+s"(bx_));
        __builtin_amdgcn_s_waitcnt(0);
        unsigned nloc = b.st[0], nx = b.st[1];
        if (nloc == 0u) { xcd_barrier_complete(bar, bx_, nloc, nx); b.st[0] = nloc; b.st[1] = nx; }
        const unsigned old = xb_add(&bar[XB_XSUB(bx_)], 1u);
        const unsigned gen = old / nloc;
        if (old + 1u == (gen + 1u) * nloc) {
            __builtin_amdgcn_fence(__ATOMIC_RELEASE, "agent");
            asm volatile("s_waitcnt vmcnt(0)" ::: "memory");
            const unsigned og = xb_add(&bar[XB_TOP], 1u);
            const unsigned tg = og / nx;
            if (og + 1u == (tg + 1u) * nx) xb_add(&bar[XB_TOPGEN], 1u);
            else XB_SPIN(xb_ld(&bar[XB_TOPGEN]) == tg, bar);
            __builtin_amdgcn_fence(__ATOMIC_ACQUIRE, "agent");
            xb_add(&bar[XB_XGEN(bx_)], 1u);
            asm volatile("s_waitcnt vmcnt(0)" ::: "memory");
        } else {
            XB_SPIN(xb_ld(&bar[XB_XGEN(bx_)]) == gen, bar);
            __builtin_amdgcn_fence(__ATOMIC_ACQUIRE, "agent");
            asm volatile("s_waitcnt vmcnt(0)" ::: "memory");
        }
    }
    __syncthreads();
}

struct Args { const float* in[20]; float* out; unsigned char* ws; };
typedef const __attribute__((address_space(4))) Args* CArgs;
__device__ __forceinline__ CArgs launder(CArgs p) { asm volatile("" : "+s"(p)); return p; }
__device__ __forceinline__ Args load_args(CArgs p) { Args a;
#pragma unroll
    for (int i = 0; i < 20; ++i) a.in[i] = p->in[i];
    a.out = p->out; a.ws = p->ws; return a; }
constexpr int NWAVES = 8;
__device__ __forceinline__ int tid_now() { int t = threadIdx.x; asm volatile("" : "+v"(t)); return t; }
__device__ __forceinline__ float shfl_xor_l(float v, int o, int lane) { return __int_as_float(__builtin_amdgcn_ds_bpermute((lane ^ o) << 2, __float_as_int(v))); }
__device__ __forceinline__ float wave_sum(float v, int lane) {
#pragma unroll
    for (int o = 1; o < 64; o <<= 1) v += shfl_xor_l(v, o, lane);
    return v;
}
__device__ __forceinline__ float lam_init_of(int l) { return 0.8f - 0.6f * expf(-0.3f * (float)l); }
__device__ __forceinline__ int t5_bucket(int n) {
    if (n < 16) return n;
    const float v = logf((float)n / 16.0f) / 2.0794415416798357f * 16.0f;
    const int lg = 16 + (int)v; return lg < 31 ? lg : 31;
}
__device__ __forceinline__ void p0_transpose_item(const float* W, int K, int N, bf16_t* WT, int drow0, float scale, LAS float* scr, int kb, int nb, int lane) {
    const int k0 = 64 * kb, n0 = 32 * nb;
#pragma unroll 8
    for (int i = 0; i < 32; ++i) { const int kk = 2 * i + (lane >> 5); scr[kk * 33 + (lane & 31)] = W[(size_t)(k0 + kk) * N + n0 + (lane & 31)] * scale; }
    LDS_WAIT(); asm volatile("" ::: "memory");
    const int c = lane & 7;
#pragma unroll
    for (int j = 0; j < 4; ++j) { const int n = (lane >> 3) + 8 * j; const LAS float* s = scr + (8 * c) * 33 + n;
        u32x4 o; o.x = pk2(s[0 * 33], s[1 * 33]); o.y = pk2(s[2 * 33], s[3 * 33]); o.z = pk2(s[4 * 33], s[5 * 33]); o.w = pk2(s[6 * 33], s[7 * 33]);
        *(u32x4*)(WT + (size_t)(drow0 + n) * K + k0 + 8 * c) = o; }
    LDS_WAIT(); asm volatile("" ::: "memory");
}

__device__ __forceinline__ void p0_transpose64(const float* W, int K, int N, bf16_t* WT, int drow0, float scale, LAS unsigned* scr, int kb, int nb, int lane) {
    const int k0 = 64 * kb, n0 = 64 * nb, q = lane & 15, kk = lane >> 4;
    f32x4 v[16];
#pragma unroll
    for (int t = 0; t < 16; ++t) { const int k = 8 * (t >> 1) + 2 * kk + (t & 1); v[t] = *(const f32x4*)(W + (size_t)(k0 + k) * N + n0 + 4 * q); }
#pragma unroll
    for (int u = 0; u < 8; ++u)
#pragma unroll
        for (int i = 0; i < 4; ++i) scr[(4 * q + i) * 33 + 4 * u + kk] = cvt_pk_bf16(v[2 * u][i] * scale, v[2 * u + 1][i] * scale);
    LDS_WAIT(); asm volatile("" ::: "memory");
    const int nr = lane >> 3, c = lane & 7;
#pragma unroll
    for (int p = 0; p < 8; ++p) { const int n = 8 * p + nr; const LAS unsigned* s_ = scr + n * 33 + 4 * c;
        u32x4 o; o.x = s_[0]; o.y = s_[1]; o.z = s_[2]; o.w = s_[3];
        *(u32x4*)(WT + (size_t)(drow0 + n) * K + k0 + 8 * c) = o; }
    LDS_WAIT(); asm volatile("" ::: "memory");
}

template <bool NTL = false>
__device__ __forceinline__ void p0_transpose64_f8(const float* W, int K, int N, unsigned char* WT, int drow0, float scale, LAS unsigned* scr, int kb, int nb, int lane) {
    const int k0 = 64 * kb, n0 = 64 * nb, q = lane & 15, kk = lane >> 4;
    f32x4 v[16];
#pragma unroll
    for (int t = 0; t < 16; ++t) { const int k = 16 * (t >> 2) + 4 * kk + (t & 3); const f32x4* p_ = (const f32x4*)(W + (size_t)(k0 + k) * N + n0 + 4 * q); v[t] = NTL ? __builtin_nontemporal_load(p_) : *p_; }
#pragma unroll
    for (int u = 0; u < 4; ++u)
#pragma unroll
        for (int i = 0; i < 4; ++i) scr[(4 * q + i) * 17 + 4 * u + kk] = pk4_fp8(v[4 * u][i] * scale, v[4 * u + 1][i] * scale, v[4 * u + 2][i] * scale, v[4 * u + 3][i] * scale);
    LDS_WAIT(); asm volatile("" ::: "memory");
    const int nr = lane >> 2, c = lane & 3;
#pragma unroll
    for (int p = 0; p < 4; ++p) { const int n = 16 * p + nr; const LAS unsigned* s_ = scr + n * 17 + 4 * c;
        u32x4 o; o.x = s_[0]; o.y = s_[1]; o.z = s_[2]; o.w = s_[3];
        *(u32x4*)(WT + (size_t)(drow0 + n) * K + k0 + 16 * c) = o; }
    LDS_WAIT(); asm volatile("" ::: "memory");
}

template <int MODE>
__device__ __forceinline__ void row_pass(CArgs ap, int l, int vcu, int G, const LAS int* toffl = nullptr) {
    ap = launder(ap); const int tid_ = tid_now(), lane = tid_ & 63, wave = __builtin_amdgcn_readfirstlane(tid_ >> 6); const Args a = load_args(ap);
    unsigned char* ws = a.ws;
    const float* mod = (const float*)(ws + WS_MOD);
    const bf16_t* Y = (const bf16_t*)(ws + WS_Y); const bf16_t* YS = (const bf16_t*)(ws + WS_YS); bf16_t* H = (bf16_t*)(ws + WS_H);
    const float* xin = (MODE == 0 || (MODE == 1 && l == 0)) ? a.in[0] : a.out;
    const bool need_h = (MODE != 2) || (l + 1 < DEPTH);
    const int lh = (MODE == 2) ? l + 1 : l;
    const float* gpre = (MODE == 1) ? a.in[7] + (size_t)l * D : a.in[5] + (size_t)(lh < DEPTH ? lh : 0) * D;
    const float* gpost = (MODE == 1) ? a.in[6] + (size_t)l * D : a.in[8] + (size_t)l * D;
    const int gw = vcu * NWAVES + wave, NGW = G * NWAVES, RPW = (M + NGW - 1) / NGW;
    int m0 = gw * RPW, m1 = m0 + RPW; if (m1 > M) m1 = M;
    f32x4 a_r[4], a_h[4], s_h[4]; int curb = -1;
#ifndef ROWS_PER_STEP
#define ROWS_PER_STEP 2
#endif
    constexpr int RR = ROWS_PER_STEP;
    for (int mb_ = m0; mb_ < m1; mb_ += RR) {
        const int b = mb_ / SEQ;
        if (b != curb) { curb = b;
            const float* mb = mod + (size_t)((l * BATCH + b) * 6) * D; const float* mh = mod + (size_t)(((lh < DEPTH ? lh : 0) * BATCH + b) * 6) * D;
#pragma unroll
            for (int j = 0; j < 4; ++j) { const int c = 4 * lane + 256 * j;
                if (MODE == 1) { a_r[j] = *(const f32x4*)(mb + 2 * D + c) * *(const f32x4*)(gpost + c); a_h[j] = *(const f32x4*)(gpre + c) * (*(const f32x4*)(mb + 4 * D + c) + 1.0f); s_h[j] = *(const f32x4*)(mb + 3 * D + c); }
                else { if (MODE == 2) a_r[j] = *(const f32x4*)(mb + 5 * D + c) * *(const f32x4*)(gpost + c);
                       a_h[j] = *(const f32x4*)(gpre + c) * (*(const f32x4*)(mh + 1 * D + c) + 1.0f); s_h[j] = *(const f32x4*)(mh + 0 * D + c); } } }
        f32x4 xv[RR][4], yv[RR][4]; int mrow[RR];
#pragma unroll
        for (int r = 0; r < RR; ++r) { mrow[r] = (mb_ + r < m1) ? mb_ + r : m1 - 1;
#pragma unroll
            for (int j = 0; j < 4; ++j) xv[r][j] = *(const f32x4*)(xin + (size_t)mrow[r] * D + 4 * lane + 256 * j); }
        if (MODE != 0) {
            if (MODE == 1) {
#pragma unroll
                for (int r = 0; r < RR; ++r)
#pragma unroll
                    for (int j = 0; j < 4; ++j) { const u32x2 w = *(const u32x2*)(Y + (size_t)mrow[r] * D + 4 * lane + 256 * j); yv[r][j] = (f32x4){bf_lo(w.x), bf_hi(w.x), bf_lo(w.y), bf_hi(w.y)}; }
            } else {
                u32x4 sp[RR];
#pragma unroll
                for (int r = 0; r < RR; ++r) sp[r] = *(const u32x4*)(ws + WS_SPOS + (size_t)mrow[r] * TOPK * 4);
                unsigned w8[RR][TOPK][4];
#pragma unroll
                for (int r = 0; r < RR; ++r) { int srow[TOPK];
                    srow[0] = toffl[sp[r].x >> 16] * 256 + (int)(sp[r].x & 0xffffu); srow[1] = toffl[sp[r].y >> 16] * 256 + (int)(sp[r].y & 0xffffu);
                    srow[2] = toffl[sp[r].z >> 16] * 256 + (int)(sp[r].z & 0xffffu); srow[3] = toffl[sp[r].w >> 16] * 256 + (int)(sp[r].w & 0xffffu);
#pragma unroll
                    for (int k = 0; k < TOPK; ++k)
#pragma unroll
                        for (int j = 0; j < 4; ++j) w8[r][k][j] = *(const unsigned*)((const unsigned char*)YS + (size_t)srow[k] * D + 4 * lane + 256 * j); }
#pragma unroll
                for (int r = 0; r < RR; ++r)
#pragma unroll
                    for (int j = 0; j < 4; ++j) { yv[r][j] = (f32x4){0.f, 0.f, 0.f, 0.f};
#pragma unroll
                        for (int k = 0; k < TOPK; ++k) { const auto lo2 = __builtin_amdgcn_cvt_pk_f32_fp8(w8[r][k][j], false), hi2 = __builtin_amdgcn_cvt_pk_f32_fp8(w8[r][k][j], true); yv[r][j] += (f32x4){lo2[0], lo2[1], hi2[0], hi2[1]}; }
                        yv[r][j] = yv[r][j] * (1.0f / F8_SY); }
            }
            float ss[RR];
#pragma unroll
            for (int r = 0; r < RR; ++r) { ss[r] = 0.f;
#pragma unroll
                for (int j = 0; j < 4; ++j) ss[r] += (yv[r][j].x * yv[r][j].x + yv[r][j].y * yv[r][j].y) + (yv[r][j].z * yv[r][j].z + yv[r][j].w * yv[r][j].w); }
#pragma unroll
            for (int r = 0; r < RR; ++r) { const float rn = 1.0f / sqrtf(wave_sum(ss[r], lane) * (1.0f / D) + NORM_EPS);
#pragma unroll
                for (int j = 0; j < 4; ++j) { xv[r][j] = xv[r][j] + a_r[j] * (yv[r][j] * rn); *(f32x4*)(a.out + (size_t)mrow[r] * D + 4 * lane + 256 * j) = xv[r][j]; } }
        }
        if (need_h) {
            float ss[RR];
#pragma unroll
            for (int r = 0; r < RR; ++r) { ss[r] = 0.f;
#pragma unroll
                for (int j = 0; j < 4; ++j) ss[r] += (xv[r][j].x * xv[r][j].x + xv[r][j].y * xv[r][j].y) + (xv[r][j].z * xv[r][j].z + xv[r][j].w * xv[r][j].w); }
#pragma unroll
            for (int r = 0; r < RR; ++r) { const float rn = 1.0f / sqrtf(wave_sum(ss[r], lane) * (1.0f / D) + NORM_EPS);
#pragma unroll
                for (int j = 0; j < 4; ++j) { const f32x4 h = (xv[r][j] * rn) * a_h[j] + s_h[j]; u32x2 w; w.x = cvt_pk_bf16(h.x, h.y); w.y = cvt_pk_bf16(h.z, h.w);
                    *(u32x2*)(H + (size_t)mrow[r] * D + 4 * lane + 256 * j) = w;
                    *(unsigned*)(ws + (MODE == 1 ? WS_H8 : WS_H8M) + (size_t)mrow[r] * D + 4 * lane + 256 * j) = pk4_fp8(h.x * F8_SH, h.y * F8_SH, h.z * F8_SH, h.w * F8_SH); } }
        }
    }
}

__device__ __forceinline__ void diff_combine(CArgs ap, int l, int vcu, int G) {
    ap = launder(ap); const int tid_ = tid_now(), lane = tid_ & 63, wave = __builtin_amdgcn_readfirstlane(tid_ >> 6);
    unsigned char* ws = ap->ws; struct { const float* in[14]; } a; a.in[13] = ap->in[13];
    const bf16_t* O1 = (const bf16_t*)(ws + WS_OD); const bf16_t* O2 = O1 + (size_t)M * 512; bf16_t* OB = (bf16_t*)(ws + WS_OB);
    const float lam = ((const float*)(ws + WS_LAM))[l]; const float post = 1.0f - lam_init_of(l);
    const float* g = a.in[13] + (size_t)l * 128 + (8 * lane) % 128;
    float gv[8];
#pragma unroll
    for (int i = 0; i < 8; ++i) gv[i] = g[i] * post;
    const int gw = vcu * NWAVES + wave, NGW = G * NWAVES;
    for (int m = gw; m < M; m += NGW) {
        const u32x4 p = *(const u32x4*)(O1 + (size_t)m * 512 + 8 * lane), q = *(const u32x4*)(O2 + (size_t)m * 512 + 8 * lane);
        float o[8];
        o[0] = bf_lo(p.x) - lam * bf_lo(q.x); o[1] = bf_hi(p.x) - lam * bf_hi(q.x); o[2] = bf_lo(p.y) - lam * bf_lo(q.y); o[3] = bf_hi(p.y) - lam * bf_hi(q.y);
        o[4] = bf_lo(p.z) - lam * bf_lo(q.z); o[5] = bf_hi(p.z) - lam * bf_hi(q.z); o[6] = bf_lo(p.w) - lam * bf_lo(q.w); o[7] = bf_hi(p.w) - lam * bf_hi(q.w);
        float ss = 0.f;
#pragma unroll
        for (int i = 0; i < 8; ++i) ss += o[i] * o[i];
        ss += shfl_xor_l(ss, 1, lane); ss += shfl_xor_l(ss, 2, lane); ss += shfl_xor_l(ss, 4, lane); ss += shfl_xor_l(ss, 8, lane);
        const float r = 1.0f / sqrtf(ss * (1.0f / 128.0f) + SUBLN_EPS);
        u32x4 w; w.x = cvt_pk_bf16(o[0] * r * gv[0], o[1] * r * gv[1]); w.y = cvt_pk_bf16(o[2] * r * gv[2], o[3] * r * gv[3]);
        w.z = cvt_pk_bf16(o[4] * r * gv[4], o[5] * r * gv[5]); w.w = cvt_pk_bf16(o[6] * r * gv[6], o[7] * r * gv[7]);
        *(u32x4*)(OB + (size_t)m * 512 + 8 * lane) = w;
    }
}

__device__ __forceinline__ void topk_lists(CArgs ap, int l, int G, volatile LAS unsigned* LW) {
    ap = launder(ap);
    unsigned char* ws = ap->ws;
    const float* LOG = (const float*)(ws + WS_LOG); int* LIST = (int*)(ws + WS_LIST); float* WSLOT = (float*)(ws + WS_WSLOT);
    unsigned* CNT = (unsigned*)(ws + WS_CTL) + CW_CNT + l * NE;
    int tid = threadIdx.x; asm volatile("" : "+v"(tid)); const int TPW = (M + G - 1) / G;
    for (int base = blockIdx.x * TPW, done = 0; done < TPW; done += 512) {
        if (tid < NE) LW[LW_LCNT + tid] = 0u;
        __syncthreads();
        const int m = base + done + tid; const bool act = (done + tid < TPW) && (m < M);
        int ek[TOPK]; float wk[TOPK]; unsigned lp[TOPK];
        if (act) {
            float v[NE];
#pragma unroll
            for (int q = 0; q < NE / 4; ++q) { const f32x4 t = *(const f32x4*)(LOG + (size_t)m * NE + 4 * q); v[4 * q] = t.x; v[4 * q + 1] = t.y; v[4 * q + 2] = t.z; v[4 * q + 3] = t.w; }
            unsigned taken = 0u;
#pragma unroll
            for (int k = 0; k < TOPK; ++k) { float best = -INFINITY; int bi = 0;
#pragma unroll
                for (int e = 0; e < NE; ++e) { const bool ok = !((taken >> e) & 1u) && (v[e] > best); best = ok ? v[e] : best; bi = ok ? e : bi; }
                taken |= 1u << bi; ek[k] = bi; wk[k] = best; }
            float s = 0.f; const float mx = wk[0];
#pragma unroll
            for (int k = 0; k < TOPK; ++k) { wk[k] = expf(wk[k] - mx > -80.f ? wk[k] - mx : -80.f); s += wk[k]; }
#pragma unroll
            for (int k = 0; k < TOPK; ++k) { wk[k] = wk[k] / s; lp[k] = __hip_atomic_fetch_add((LAS unsigned*)&LW[LW_LCNT + ek[k]], 1u, __ATOMIC_RELAXED, __HIP_MEMORY_SCOPE_WORKGROUP); }
        }
        __syncthreads();
        if (tid < NE) { const unsigned c = LW[LW_LCNT + tid]; LW[LW_LBASE + tid] = c ? __hip_atomic_fetch_add(CNT + tid, c, RLX_AGENT) : 0u; }
        __syncthreads();
        if (act) {
#pragma unroll
            for (int k = 0; k < TOPK; ++k) { const unsigned pos = LW[LW_LBASE + ek[k]] + lp[k]; __hip_atomic_store(LIST + (size_t)ek[k] * CAP + pos, m * TOPK + k, RLX_AGENT);
                __hip_atomic_store((float*)(ws + WS_LISTW) + (size_t)ek[k] * CAP + pos, wk[k], RLX_AGENT);
                ((unsigned*)(ws + WS_SPOS))[(size_t)m * TOPK + k] = ((unsigned)ek[k] << 16) | pos; }
        }
        __syncthreads();
    }
}

__device__ __forceinline__ void p0_prologue(CArgs ap, LAS unsigned char* lds, int vcu, int G) {
    ap = launder(ap); const Args a = load_args(ap);
    unsigned char* ws = a.ws; const int tid = tid_now(), lane = tid & 63, wave = __builtin_amdgcn_readfirstlane(tid >> 6);
    LAS float* ca = (LAS float*)(lds + RING_OFF); LAS float* red = (LAS float*)(lds + RING_OFF + 8192);
    for (int i = tid; i < BATCH * D; i += NWAVES * 64) { const float v = a.in[1][i]; ca[i] = v / (1.0f + expf(-v)); }
    __syncthreads();
    float* mod = (float*)(ws + WS_MOD);
    for (int it = blockIdx.x; it < DEPTH * (6 * D / 32); it += G) {
        const int l = it / (6 * D / 32), cg = it % (6 * D / 32), c = tid & 31, kc = tid >> 5;
        const float* w = a.in[3] + (size_t)l * D * 6 * D + cg * 32 + c;
        float s0 = 0.f, s1 = 0.f;
#pragma unroll 8
        for (int k = kc * 64; k < kc * 64 + 64; ++k) { const float wv = w[(size_t)k * 6 * D]; s0 += ca[k] * wv; s1 += ca[D + k] * wv; }
        red[(kc * 32 + c) * 2] = s0; red[(kc * 32 + c) * 2 + 1] = s1;
        __syncthreads();
        if (tid < 64) { const int cc = tid & 31, b = tid >> 5; float s = 0.f;
#pragma unroll
            for (int k = 0; k < 16; ++k) s += red[(k * 32 + cc) * 2 + b];
            mod[(size_t)(l * BATCH + b) * 6 * D + cg * 32 + cc] = s + a.in[4][(size_t)l * 6 * D + cg * 32 + cc]; }
        __syncthreads();
    }
    if (blockIdx.x == 0 && wave == 0) {
        for (int l = 0; l < DEPTH; ++l) { const float* lp = a.in[12] + (size_t)l * 256;
            const float s01 = wave_sum(lp[lane] * lp[64 + lane], lane), s23 = wave_sum(lp[128 + lane] * lp[192 + lane], lane);
            if (lane == 0) ((float*)(ws + WS_LAM))[l] = expf(s01) - expf(s23) + lam_init_of(l); }
    }
    { u32x4* z = (u32x4*)(ws + WS_WR); const u32x4 zero = {0u, 0u, 0u, 0u};
      for (int l = 0; l < DEPTH; ++l) for (int i = blockIdx.x * NWAVES * 64 + tid; i < 224 * D * 2 / 16; i += G * NWAVES * 64) z[(size_t)l * (256 * D * 2 / 16) + 32 * D * 2 / 16 + i] = zero; }
    LAS float* scr = (LAS float*)(lds + RING_OFF + wave * 16384); LAS unsigned* scru = (LAS unsigned*)scr;
    const int gw = vcu * NWAVES + wave, NGW = G * NWAVES;
    constexpr int I_IN = 16 * (INW / 64), I_O = 8 * (D / 64), I_R = 16, I_GU1 = 16 * (2 * FF / 64), I_GU = NE * I_GU1, I_D1 = 16 * (D / 64), I_DN = NE * I_D1;
    constexpr int I_LAYER = I_IN + 2 * I_O + I_R + I_GU + I_DN;
    for (int it = gw; it < DEPTH * I_LAYER; it += NGW) {
        const int l = it / I_LAYER; int r = it - l * I_LAYER;
        if (r < I_IN) { const int nblk = INW / 64, kb = r / nblk, nb = r % nblk, n0 = 64 * nb;
            const float sc = (n0 < C_KA || (n0 >= C_QB && n0 < C_KB)) ? QSCALE : 1.0f;
            if (n0 < C_GZA) p0_transpose64(a.in[9] + (size_t)l * D * INW, D, INW, (bf16_t*)(ws + WS_WIN) + (size_t)l * C_GZA * D, n0, sc, scru, kb, nb, lane);
            else p0_transpose64_f8(a.in[9] + (size_t)l * D * INW, D, INW, ws + WS_WIN8 + (size_t)l * (INW - C_GZA) * D, n0 - C_GZA, F8_SW, scru, kb, nb, lane);
            continue; }
        r -= I_IN;
        if (r < 2 * I_O) { const int half = r / I_O; r -= half * I_O; const int nblk = D / 64, kb = r / nblk, nb = r % nblk;
            p0_transpose64(a.in[10] + (size_t)l * D * D + (size_t)half * 512 * D, 512, D, (bf16_t*)(ws + (half ? WS_WOB : WS_WOA)) + (size_t)l * D * 512, 64 * nb, 1.0f, scru, kb, nb, lane); continue; }
        r -= 2 * I_O;
        if (r < I_R) { p0_transpose_item(a.in[14] + (size_t)l * D * NE, D, NE, (bf16_t*)(ws + WS_WR) + (size_t)l * 256 * D, 0, 1.0f, scr, r, 0, lane); continue; }
    }
}

__device__ __forceinline__ void expert_convert(CArgs ap, int l, LAS unsigned char* lds, int c, int G) {
    ap = launder(ap); const Args a = load_args(ap);
    unsigned char* ws = a.ws; const int tid = tid_now(), lane = tid & 63, wave = __builtin_amdgcn_readfirstlane(tid >> 6);
    LAS unsigned* scru = (LAS unsigned*)(lds + RING_OFF + wave * 4608);
    constexpr int I_GU1 = 16 * (2 * FF / 64), I_GU = NE * I_GU1, I_D1 = 16 * (D / 64), I_DN = NE * I_D1;
    const int gw = c * NWAVES + wave, NGW = G * NWAVES;
#pragma unroll 1
    for (int it = gw; it < I_GU + I_DN; it += NGW) { int r = it;
        if (r < I_GU) { const int e = r / I_GU1; r -= e * I_GU1; const int nblk = 2 * FF / 64, kb = r / nblk, nb = r % nblk, n0 = 64 * nb;
            const int j = n0 % FF, drow = (j / 128) * 256 + (n0 >= FF ? 128 : 0) + (j % 128);
            p0_transpose64_f8<true>(a.in[16] + ((size_t)l * NE + e) * D * 2 * FF, D, 2 * FF, ws + WS_WGU + ((size_t)l * NE + e) * 2 * FF * D, drow, F8_SW, scru, kb, nb, lane); continue; }
        r -= I_GU;
        { const int e = r / I_D1; r -= e * I_D1; const int nblk = D / 64, kb = r / nblk, nb = r % nblk;
            p0_transpose64_f8<true>(a.in[18] + ((size_t)l * NE + e) * FF * D, FF, D, ws + WS_WD + ((size_t)l * NE + e) * D * FF, 64 * nb, F8_SW, scru, kb, nb, lane); }
    }
    __syncthreads();
}

__device__ __forceinline__ void attn_fill_tab(const float* rel, int col, bool swa, LAS float* tab) {
    for (int j = tid_now(); j < attn_body::TAB_N; j += NWAVES * 64) {
        const int dist = j - 255; float v;
        if (dist < 0) v = -INFINITY;
        else if (swa) v = dist >= 128 ? -INFINITY : rel[t5_bucket(dist) * NBH + col] * LOG2E;
        else v = (rel[t5_bucket(dist < 127 ? dist : 127) * NBH + col] - rel[31 * NBH + col]) * LOG2E;
        tab[j] = v;
    }
}
#ifndef MK_ADBG
#define MK_ADBG 0
#endif
__device__ __forceinline__ void attn_phase(CArgs ap, int l, char* lds, int vcu, int G, int rep = 0) {
    ap = launder(ap);
    unsigned char* ws = ap->ws; struct { const float* in[14]; } a; a.in[2] = ap->in[2]; a.in[11] = ap->in[11]; a.in[13] = ap->in[13];
    const int dbg = rep ? MK_ADBG : 0;
    const bf16_t* P = (const bf16_t*)(ws + WS_P); bf16_t* OA = (bf16_t*)(ws + (rep ? WS_YA : WS_OA)); bf16_t* OD = (bf16_t*)(ws + (rep ? WS_YA + 32 * MiB : WS_OD)); bf16_t* OBo = (bf16_t*)(ws + (rep ? WS_Y : WS_OB));
    LAS float* tab = (LAS float*)((LAS char*)lds + attn_body::LDS_TAB);
    const float* rel = a.in[2];
    for (int v = vcu; v < 256; v += G) {
        const int u = v & 31, h = (v >> 5) & 3, b = v >> 7;
        attn_fill_tab(rel, HA + h, false, tab);
        const float lam = ((const float*)(ws + WS_LAM))[l], post = 1.0f - lam_init_of(l);
        const float* gsub = a.in[13] + (size_t)l * 128;
#pragma unroll 1
        for (int i = 0; i < 4; ++i) {
            const int mp = i & 1, qb = (i >> 1) ? u : 63 - u;
            const size_t row0 = (size_t)b * SEQ + (size_t)qb * 256;
            const bf16_t* Kp = P + (size_t)b * SEQ * PITCH + C_KB + h * 128 + mp * 64;
            const bf16_t* Vp = P + (size_t)b * SEQ * PITCH + C_VB + h * 128;
            bf16_t* O1 = OD + row0 * 512 + h * 128;
            attn_body::attn_unit<8, PITCH, 512, 2>(P + row0 * PITCH + C_QB + h * 128 + mp * 64, Kp, Vp, mp ? OBo + row0 * 512 + h * 128 : O1,
                                                   (dbg & 64) ? 4 : 4 * (qb + 1), -30.0f, -INFINITY, lds, dbg, mp ? O1 : nullptr, lam, gsub, post);
            if (!rep && i == XC_SLOT(blockIdx.x)) expert_convert(ap, l, (LAS unsigned char*)((LAS char*)lds - RING_OFF), blockIdx.x, G);
        }
        if (G == 256) {
            unsigned* Q = (unsigned*)(ws + WS_CTL) + CW_Q + (l * 2 + (rep ? 1 : 0)) * 8;
            volatile LAS unsigned* LWq = (volatile LAS unsigned*)((LAS char*)lds + LDSCTL_OFF - RING_OFF) + LW_QK;
            int qx = blockIdx.x & 7, tries = 0, cur_ha = -1, k0 = 0, kn = 0;
#pragma unroll 1
            for (;;) {
                if (k0 >= kn) {
                    if (tries >= 8) break;
                    const unsigned take = tries == 0 ? 2u : 1u;
                    if (tid_now() == 0) LWq[0] = __hip_atomic_fetch_add(Q + qx, take, RLX_AGENT);
                    __syncthreads(); k0 = (int)LWq[0]; __syncthreads();
                    kn = k0 + (int)take; kn = kn > 128 ? 128 : kn;
                    if (k0 >= 128) { qx = (qx + 1) & 7; ++tries; k0 = kn = 0; continue; }
                }
                const int id = qx * 128 + k0; ++k0;
                const int qb = id & 63, ha = (id >> 6) & 7, bb = id >> 9;
                if (ha != cur_ha) { attn_fill_tab(rel, ha, true, tab); cur_ha = ha; }
                const size_t row0 = (size_t)bb * SEQ + (size_t)qb * 256, krow = row0 - (qb ? 128 : 0);
                const float sink2 = a.in[11][l * HA + ha] * LOG2E;
                attn_body::attn_unit<8, PITCH, 512, 1>(P + row0 * PITCH + C_QA + ha * 64, P + krow * PITCH + C_KA + (ha >> 2) * 64, P + krow * PITCH + C_VA + (ha >> 2) * 64,
                                                       OA + row0 * 512 + ha * 64, qb ? 6 : 4, sink2, sink2, lds, dbg);
            }
        } else {
#pragma unroll 1
        for (int i = 0; i < 4; ++i) {
            const int id = v * 4 + i, qb = id & 63, ha = (id >> 6) & 7, bb = id >> 9;
            if (i == 0) attn_fill_tab(rel, ha, true, tab);
            const size_t row0 = (size_t)bb * SEQ + (size_t)qb * 256, krow = row0 - (qb ? 128 : 0);
            const float sink2 = a.in[11][l * HA + ha] * LOG2E;
            attn_body::attn_unit<8, PITCH, 512, 1>(P + row0 * PITCH + C_QA + ha * 64, P + krow * PITCH + C_KA + (ha >> 2) * 64, P + krow * PITCH + C_VA + (ha >> 2) * 64,
                                                   OA + row0 * 512 + ha * 64, qb ? 6 : 4, sink2, sink2, lds, dbg);
        } }
    }
}

#ifndef MK_PROBE
#define MK_PROBE 0
#endif
#ifndef MK_PFA
#define MK_PFA 0
#endif
constexpr bool PFA_ON = MK_PFA != 0;
#ifndef MK_DUP
#define MK_DUP 0
#endif
constexpr int CW_DIG = 12288;
__device__ __forceinline__ void probe_rows(CArgs ap, const bf16_t* base, int nrows_total, bool by_tile, const LAS int* toff, const LAS int* cl, int vcu, int G) {
    unsigned* DIG = (unsigned*)(launder(ap)->ws + WS_CTL) + CW_DIG;
    const int tid = tid_now(), lane = tid & 63, wave = tid >> 6;
    if (by_tile) {
        const int ntile = toff[NE];
        for (int gt = vcu; gt < ntile; gt += G) {
            int e = 0;
            for (int k = 16; k >= 1; k >>= 1) if (toff[e + k] <= gt) e += k;
            const int rt = gt - toff[e]; int nv = cl[e] - rt * 256; nv = nv > 256 ? 256 : nv;
            unsigned s = 0u;
            for (int r = wave; r < nv; r += NWAVES) { const u32x4* p = (const u32x4*)(base + ((size_t)gt * 256 + r) * 1024 + lane * 16); const u32x4 a = p[0], b = p[1];
                s += (a.x & 0xffffu) + (a.x >> 16) + (a.y & 0xffffu) + (a.y >> 16) + (a.z & 0xffffu) + (a.z >> 16) + (a.w & 0xffffu) + (a.w >> 16);
                s += (b.x & 0xffffu) + (b.x >> 16) + (b.y & 0xffffu) + (b.y >> 16) + (b.z & 0xffffu) + (b.z >> 16) + (b.w & 0xffffu) + (b.w >> 16); }
            __hip_atomic_fetch_add(DIG + e, s, RLX_AGENT);
        }
    } else {
        for (int r = vcu * NWAVES + wave; r < nrows_total; r += G * NWAVES) { const u32x4* p = (const u32x4*)(base + (size_t)r * 1024 + lane * 16); const u32x4 a = p[0], b = p[1];
            unsigned s = (a.x & 0xffffu) + (a.x >> 16) + (a.y & 0xffffu) + (a.y >> 16) + (a.z & 0xffffu) + (a.z >> 16) + (a.w & 0xffffu) + (a.w >> 16);
            s += (b.x & 0xffffu) + (b.x >> 16) + (b.y & 0xffffu) + (b.y >> 16) + (b.z & 0xffffu) + (b.z >> 16) + (b.w & 0xffffu) + (b.w >> 16);
            __hip_atomic_fetch_add(DIG + (r & 31), s, RLX_AGENT); }
    }
}
__device__ __forceinline__ void probe_lists(CArgs ap, int l, int vcu, int G) {
    unsigned char* ws = launder(ap)->ws; unsigned* DIG = (unsigned*)(ws + WS_CTL) + CW_DIG; const int* LIST = (const int*)(ws + WS_LIST);
    const int tid = tid_now();
    for (int e = vcu; e < NE; e += G) { const int cnt = (int)__hip_atomic_load((unsigned*)(ws + WS_CTL) + CW_CNT + l * NE + e, RLX_AGENT);
        unsigned s1 = 0u, s2 = 0u;
        for (int i = tid; i < cnt; i += NWAVES * 64) { const unsigned v = (unsigned)LIST[(size_t)e * CAP + i]; s1 += v; s2 += (v * 2654435761u) >> 9; }
        __hip_atomic_fetch_add(DIG + e, s1, RLX_AGENT); __hip_atomic_fetch_add(DIG + 32 + e, s2 + (unsigned)cnt * 7919u, RLX_AGENT); }
}
__device__ __forceinline__ void probe_dump(CArgs ap) {
    const CArgs aq = launder(ap); const unsigned* DIG = (const unsigned*)(aq->ws + WS_CTL) + CW_DIG; float* out = aq->out; const int tid = tid_now();
    if (blockIdx.x == 0 && tid < 64) out[tid] = (float)(__hip_atomic_load((unsigned*)DIG + tid, RLX_AGENT) & 0x7fffffu) * (1.0f / 65536.0f);
}

__device__ __forceinline__ void probe_region(CArgs ap, size_t off, size_t nwords, int G) {
    unsigned char* ws = launder(ap)->ws; unsigned* DIG = (unsigned*)(ws + WS_CTL) + CW_DIG; const unsigned* src = (const unsigned*)(ws + off);
    const int t = tid_now(); unsigned sacc = 0u;
    for (size_t i = (size_t)blockIdx.x * NWAVES * 64 + t; i < nwords; i += (size_t)G * NWAVES * 64) { const unsigned v = src[i]; sacc += (v & 0xffffu) + (v >> 16); }
    __hip_atomic_fetch_add(DIG + (t & 63), sacc, RLX_AGENT);
}
#define PROBE_AT(id, off, nwords) do { if (MK_PROBE == (id)) { probe_region(ap, off, nwords, G); GRID_BAR(); probe_dump(ap); return; } } while (0)

__global__ void __launch_bounds__(NWAVES * 64, 2) mk_fwd(Args a) {
    extern __shared__ __attribute__((aligned(16))) unsigned char lds_raw[];
    LAS unsigned char* lds = (LAS unsigned char*)lds_raw;
    volatile LAS unsigned* LW = (volatile LAS unsigned*)(lds + LDSCTL_OFF);
    const int tid = tid_now();
    const int G = gridDim.x; const int bx = blockIdx.x; const int vcu = (G % 8 == 0) ? (bx % 8) * (G / 8) + bx / 8 : bx;
    const CArgs ap = (CArgs)__builtin_amdgcn_kernarg_segment_ptr();
    for (int u = tid; u < (LDS_BYTES - LDSCTL_OFF) / 4; u += NWAVES * 64) ((LAS unsigned*)(lds + LDSCTL_OFF))[u] = 0u;
    __syncthreads();
    XcdBarrier bar = xcd_barrier_post((unsigned*)(ap->ws + WS_CTL) + CW_BAR, LW + 8);
#define GRID_BAR() xcd_barrier(bar)

#ifndef PH_MASK
#define PH_MASK 0xFFFF
#endif
#define PH(k) ((PH_MASK >> (k)) & 1)
#pragma unroll 1
    for (int rep = 0; rep < ((MK_DUP & 1) ? 2 : 1); ++rep) {
    if (PH(0)) p0_prologue(ap, lds, vcu, G);
    GRID_BAR(); }
    PROBE_AT(10, WS_MOD, (size_t)DEPTH * BATCH * 6 * D);
    PROBE_AT(11, WS_WIN, (size_t)DEPTH * INW * D / 2);
    PROBE_AT(12, WS_WOA, (size_t)4 * MiB / 4);
    if (PH(0)) row_pass<0>(ap, 0, vcu, G);
    GRID_BAR();
    PROBE_AT(13, WS_H, (size_t)M * D / 2);

#pragma unroll 1
    for (int l = 0; l < DEPTH; ++l) {
#pragma unroll 1
        for (int rep = 0; rep < ((MK_DUP & 2) ? 2 : 1); ++rep) {
        if (PH(1)) { unsigned char* ws = launder(ap)->ws; bf16_t* H = (bf16_t*)(ws + WS_H); bf16_t* P = (bf16_t*)(ws + WS_P);
          { pg8::Gemm g{H, (const bf16_t*)(ws + WS_WIN) + (size_t)l * C_GZA * D, D, 0, nullptr}; pg8::StaticOrder S; S.init(M, C_GZA, G, bx);
            pg8::EpiBf16 E{P, PITCH, 1.0f};
            pg8::gemm_phase<pg8::EpiBf16, pg8::StaticOrder, false, true>(lds + RING_OFF, g, S, E); }
          { pg8::Gemm g{(const bf16_t*)(ws + WS_H8M), (const bf16_t*)(ws + WS_WIN8 + (size_t)l * (INW - C_GZA) * D), D / 2, 0, nullptr}; pg8::StaticOrder S; S.init(M, INW - C_GZA, G, bx, 1);
            pg8::EpiBf16 E{P + C_GZA, PITCH, 1.0f / (F8_SH * F8_SW)};
            pg8::gemm_phase<pg8::EpiBf16, pg8::StaticOrder, false, true, true>(lds + RING_OFF, g, S, E); } }
        GRID_BAR(); }
        PROBE_AT(14, WS_P, (size_t)M * INW / 2);
#pragma unroll 1
        for (int rep = 0; rep < ((MK_DUP & 4) ? 2 : 1); ++rep) {
        if (PH(2)) attn_phase(ap, l, (char*)lds_raw + RING_OFF, vcu, G, rep);
        GRID_BAR(); }
        PROBE_AT(15, WS_OA, (size_t)M * 512 / 2);
        PROBE_AT(16, WS_OD, (size_t)M * 512);
        PROBE_AT(17, WS_OB, (size_t)M * 512 / 2);
        if (PH(4)) { unsigned char* ws = launder(ap)->ws; bf16_t* P = (bf16_t*)(ws + WS_P); pg8::Gemm g{(const bf16_t*)(ws + WS_OA), (const bf16_t*)(ws + WS_WOA) + (size_t)l * D * 512, 512, 0, nullptr}; pg8::StaticOrder S; S.init(M, D, G, bx);
          pg8::EpiGate<true> E{(bf16_t*)(ws + WS_YA), nullptr, P, C_GZA};
          pg8::gemm_phase<pg8::EpiGate<true>, pg8::StaticOrder, false, true>(lds + RING_OFF, g, S, E); }
        GRID_BAR();
        PROBE_AT(18, WS_YA, (size_t)M * D / 2);
        if (PH(5)) { unsigned char* ws = launder(ap)->ws; bf16_t* P = (bf16_t*)(ws + WS_P); pg8::Gemm g{(const bf16_t*)(ws + WS_OB), (const bf16_t*)(ws + WS_WOB) + (size_t)l * D * 512, 512, 0, nullptr}; pg8::StaticOrder S; S.init(M, D, G, bx);
          pg8::EpiGate<false> E{(bf16_t*)(ws + WS_Y), (const bf16_t*)(ws + WS_YA), P, C_GZB};
          pg8::gemm_phase<pg8::EpiGate<false>, pg8::StaticOrder, false, true>(lds + RING_OFF, g, S, E); }
        GRID_BAR();
        PROBE_AT(19, WS_Y, (size_t)M * D / 2);
        if (PH(6)) row_pass<1>(ap, l, vcu, G);
        if (MK_STOP == 1 || (MK_STOP == 3 && l == 1)) return;
        GRID_BAR();
        if (PH(7)) { const CArgs aq = launder(ap); unsigned char* ws = aq->ws; bf16_t* H = (bf16_t*)(ws + WS_H); pg8::Gemm g{H, (const bf16_t*)(ws + WS_WR) + (size_t)l * 256 * D, D, 0, nullptr}; pg8::StaticOrder S; S.init(M, 256, G, bx);
          pg8::EpiRouter E{(float*)(ws + WS_LOG), aq->in[15] + (size_t)l * NE};
          pg8::gemm_phase<pg8::EpiRouter, pg8::StaticOrder, false, true>(lds + RING_OFF, g, S, E); }
        GRID_BAR();
        if (MK_PROBE == 4 || MK_PROBE == 5) { unsigned char* ws = launder(ap)->ws; unsigned* DIG = (unsigned*)(ws + WS_CTL) + CW_DIG; const unsigned* src = (const unsigned*)(ws + (MK_PROBE == 4 ? WS_LOG : WS_H));
            const int n = MK_PROBE == 4 ? M * NE : M * D / 2; const int t = tid_now(); unsigned sacc = 0u;
            for (int i = blockIdx.x * NWAVES * 64 + t; i < n; i += G * NWAVES * 64) { const unsigned v = src[i]; sacc += (v & 0xffffu) + (v >> 16); }
            __hip_atomic_fetch_add(DIG + (t & 63), sacc, RLX_AGENT); GRID_BAR(); probe_dump(ap); return; }
        if (PH(8)) topk_lists(ap, l, G, LW);
        GRID_BAR();
        if (MK_PROBE == 1) { probe_lists(ap, l, vcu, G); GRID_BAR(); probe_dump(ap); return; }
        { unsigned char* ws = launder(ap)->ws; const int tid = tid_now(); if (tid < NE) LW[LW_CL + tid] = __hip_atomic_load((unsigned*)(ws + WS_CTL) + CW_CNT + l * NE + tid, RLX_AGENT);
          __syncthreads();
          if (tid == 0) { unsigned acc = 0u; for (int e = 0; e < NE; ++e) { LW[LW_TOFF + e] = acc; acc += (LW[LW_CL + e] + 255u) >> 8; } LW[LW_TOFF + NE] = acc; }
          __syncthreads(); }
#pragma unroll 1
        for (int rep = 0; rep < ((MK_DUP & 32) ? 2 : 1); ++rep) {
        if (PH(9)) { const CArgs aq = launder(ap); unsigned char* ws = aq->ws; bf16_t* H = (bf16_t*)(ws + WS_H); pg8::Gemm g{(const bf16_t*)(ws + WS_H8), (const bf16_t*)(ws + WS_WGU + (size_t)l * NE * 2 * FF * D), D / 2, (size_t)2 * FF * D / 2, (const int*)(ws + WS_LIST)};
          pg8::MoeOrder S{(const LAS int*)(lds + LDSCTL_OFF) + LW_TOFF, (const LAS int*)(lds + LDSCTL_OFF) + LW_CL, 2 * FF / 256, G, bx};
          pg8::EpiSwiglu8 E{ws + WS_ACT, aq->in[17] + (size_t)l * NE * 2 * FF};
          pg8::gemm_phase<pg8::EpiSwiglu8, pg8::MoeOrder, true, true, true, PFA_ON>(lds + RING_OFF, g, S, E); }
        GRID_BAR(); }
        if (MK_PROBE == 2) { probe_rows(ap, (const bf16_t*)(launder(ap)->ws + WS_ACT), 0, true, (const LAS int*)(lds + LDSCTL_OFF) + LW_TOFF, (const LAS int*)(lds + LDSCTL_OFF) + LW_CL, vcu, G); GRID_BAR(); probe_dump(ap); return; }
#pragma unroll 1
        for (int rep = 0; rep < ((MK_DUP & 64) ? 2 : 1); ++rep) {
        if (PH(10)) { const CArgs aq = launder(ap); unsigned char* ws = aq->ws; pg8::Gemm g{(const bf16_t*)(ws + WS_ACT), (const bf16_t*)(ws + WS_WD + (size_t)l * NE * D * FF), FF / 2, (size_t)D * FF / 2, nullptr};
          pg8::MoeOrder S{(const LAS int*)(lds + LDSCTL_OFF) + LW_TOFF, (const LAS int*)(lds + LDSCTL_OFF) + LW_CL, D / 256, G, bx};
          pg8::EpiDown8 E{ws + WS_YS, aq->in[19] + (size_t)l * NE * D, (const float*)(ws + WS_LISTW), 1.0f / (F8_SACT * F8_SW)};
#if defined(MK_EPIX)
          if (rep == 0 && (MK_DUP & 64)) { pg8::EpiDownX<MK_EPIX> EX{(bf16_t*)(ws + WS_YS), aq->in[19] + (size_t)l * NE * D, (const float*)(ws + WS_LISTW), 1.0f / (F8_SACT * F8_SW)}; pg8::gemm_phase<pg8::EpiDownX<MK_EPIX>, pg8::MoeOrder, false, true, true>(lds + RING_OFF, g, S, EX); } else
#elif defined(MK_NULLEPI)
          if (rep) { pg8::EpiNull EN; pg8::gemm_phase<pg8::EpiNull, pg8::MoeOrder, false, true, true>(lds + RING_OFF, g, S, EN); } else
#endif
          pg8::gemm_phase<pg8::EpiDown8, pg8::MoeOrder, false, true, true, PFA_ON>(lds + RING_OFF, g, S, E); }
        GRID_BAR(); }
        if (MK_PROBE == 3) { probe_rows(ap, (const bf16_t*)(launder(ap)->ws + WS_YS), M * TOPK, false, nullptr, nullptr, vcu, G); GRID_BAR(); probe_dump(ap); return; }
        if (PH(11)) row_pass<2>(ap, l, vcu, G, (const LAS int*)(lds + LDSCTL_OFF) + LW_TOFF);
        if (MK_STOP == 2) return;
        if (l + 1 < DEPTH) GRID_BAR();
    }
#if MK_TIM
    GRID_BAR();
    { const CArgs aq = launder(ap); const float* x = aq->in[0]; float* out = aq->out; const int t = tid_now();
      const unsigned long long s_ = __hip_atomic_load(&attn_body::g_tim[0], RLX_AGENT), c_ = __hip_atomic_load(&attn_body::g_tim[1], RLX_AGENT);
      float sc = (float)((double)s_ / (double)(c_ ? c_ : 1ull)) * (1.0f / MK_TIM);
#ifdef MK_TIM_Q
      sc = MK_TIM_Q * floorf(sc / MK_TIM_Q + 0.5f);
#endif
      for (size_t i = (size_t)blockIdx.x * NWAVES * 64 + t; i < (size_t)M * D; i += (size_t)G * NWAVES * 64) out[i] = x[i] * sc; }
#endif
}

extern "C" void kernel_launch(void* const* d_in, const int* in_sizes, int n_in, void* d_out, int out_size, void* d_ws, size_t ws_size, hipStream_t stream) {
    static int grid = 0;
    if (grid == 0) {
        if (n_in != 20 || in_sizes[0] != M * D || out_size != M * D || ws_size < WS_END) { fprintf(stderr, "kernel_launch: unexpected shapes (n_in %d, in0 %d, out %d, ws %zu < %zu); nothing launched\n", n_in, n_in > 0 ? in_sizes[0] : -1, out_size, ws_size, (size_t)WS_END); grid = -1; return; }
        int dev = 0, cus = 0, per_cu = 0;
        if (hipGetDevice(&dev) != hipSuccess || hipDeviceGetAttribute(&cus, hipDeviceAttributeMultiprocessorCount, dev) != hipSuccess) { grid = -1; return; }
        if (hipFuncSetAttribute((const void*)mk_fwd, hipFuncAttributeMaxDynamicSharedMemorySize, LDS_BYTES) != hipSuccess) { fprintf(stderr, "kernel_launch: hipFuncSetAttribute failed\n"); grid = -1; return; }
        if (hipOccupancyMaxActiveBlocksPerMultiprocessor(&per_cu, (const void*)mk_fwd, NWAVES * 64, LDS_BYTES) != hipSuccess || per_cu < 1)
            fprintf(stderr, "kernel_launch: note: occupancy query reports %d workgroups per CU\n", per_cu);
        (void)hipGetLastError();
        grid = cus > 256 ? 256 : cus;
    }
    if (grid < 0) return;
    if (hipMemsetAsync((char*)d_ws + WS_CTL, 0, CTL_ZERO_BYTES, stream) != hipSuccess) return;
    Args a{};
    for (int i = 0; i < 20; ++i) a.in[i] = (const float*)d_in[i];
    a.out = (float*)d_out; a.ws = (unsigned char*)d_ws;
    hipLaunchKernelGGL(mk_fwd, dim3(grid), dim3(NWAVES * 64), LDS_BYTES, stream, a);
}
```

```cpp
#include <hip/hip_runtime.h>
#include <cstdio>
#include <cstdint>
#include <cmath>

#ifndef MK_STOP
#define MK_STOP 0
#endif

constexpr int BATCH = 2, SEQ = 16384, D = 1024, M = BATCH * SEQ, DEPTH = 2;
constexpr int INW = 4352, PITCH = INW;
constexpr int C_QA = 0, C_KA = 512, C_VA = 640, C_QB = 768, C_KB = 1280, C_VB = 1792, C_GZA = 2304, C_GZB = 3328;
constexpr int NE = 32, TOPK = 4, FF = 1024, CAP = M;
constexpr int NBH = 12, HA = 8;
constexpr float LOG2E = 1.4426950408889634f, QSCALE = 0.125f * LOG2E;
constexpr float NORM_EPS = 1e-6f, SUBLN_EPS = 1e-5f;
constexpr int ACT_ROWS = M * TOPK + NE * 256;

#define LAS __attribute__((address_space(3)))
#define GAS __attribute__((address_space(1)))
typedef unsigned short bf16_t;
typedef short bf16x8 __attribute__((ext_vector_type(8)));
typedef float f32x4 __attribute__((ext_vector_type(4)));
typedef float f32x2 __attribute__((ext_vector_type(2)));
typedef unsigned u32x4 __attribute__((ext_vector_type(4)));
typedef unsigned u32x2 __attribute__((ext_vector_type(2)));
typedef int v4i_t __attribute__((ext_vector_type(4)));
typedef int v8i_t __attribute__((ext_vector_type(8)));
constexpr float F8_SW = 128.0f, F8_SH = 16.0f, F8_SACT = 4.0f, F8_SY = 32.0f, F8_MAX = 448.0f;
__device__ __forceinline__ float f8clamp(float v) { return fminf(fmaxf(v, -F8_MAX), F8_MAX); }
__device__ __forceinline__ unsigned pk4_fp8(float a, float b, float c, float d) { unsigned w = 0u; w = __builtin_amdgcn_cvt_pk_fp8_f32(f8clamp(a), f8clamp(b), w, false); w = __builtin_amdgcn_cvt_pk_fp8_f32(f8clamp(c), f8clamp(d), w, true); return w; }

__device__ __forceinline__ unsigned cvt_pk_bf16(float lo, float hi) { unsigned r; asm volatile("v_cvt_pk_bf16_f32 %0, %1, %2" : "=v"(r) : "v"(lo), "v"(hi)); return r; }
__device__ __forceinline__ float bf_lo(unsigned w) { return __uint_as_float(w << 16); }
__device__ __forceinline__ float bf_hi(unsigned w) { return __uint_as_float(w & 0xffff0000u); }
__device__ __forceinline__ float sigmoidf_(float v) { return __builtin_amdgcn_rcpf(1.0f + __builtin_amdgcn_exp2f(-v * LOG2E)); }

namespace pg8 {
constexpr int BM = 256, BK = 64, HALF = 128, HTB = HALF * BK * 2, STAGE_BYTES = 8 * HTB, NXCD = 8, WGM = 8;
__host__ __device__ __forceinline__ int lds_byte(int r, int c) { const int st = (r >> 4) * 2 + (c >> 5), rr = r & 15, cc = c & 31, ob = rr * 64 + cc * 2; return st * 1024 + (ob ^ (((ob >> 9) & 1) << 5)); }
__host__ __device__ __forceinline__ void stage_rc(int b, int& R, int& C) { const int st = b / 1024, sb = b % 1024, swz = sb ^ (((sb >> 9) & 1) << 5); R = (st >> 1) * 16 + swz / 64; C = (st & 1) * 32 + (swz % 64) / 2; }
__host__ __device__ __forceinline__ int perm32(int rho) { const int n = rho >> 4, i = rho & 15; return 8 * (i >> 2) + 4 * n + (i & 3); }

template <class E, class = void> struct Perm16 { static constexpr bool v = false; };
template <class E> struct Perm16<E, decltype((void)E::PERM16)> { static constexpr bool v = E::PERM16; };
__host__ __device__ __forceinline__ int perm16x(int R) { return 64 * (R >> 5) + 16 * ((R >> 2) & 3) + 4 * ((R >> 4) & 1) + (R & 3); }
struct Unit { int pm, pn, e, lrow, nvalid; };
struct Gemm { const bf16_t* A; const bf16_t* Bt; int K; size_t estride; const int* rows; };

struct StaticOrder {
    int nM, nN, nwg, G, c, skew;
    __device__ void init(int Mr, int N, int G_, int c_, int skew_ = 0) { nM = Mr / BM; nN = N / BM; nwg = nM * nN; G = G_; c = c_; skew = (skew_ && G_ == 256 && nwg == 1024) ? 1 : 0; }
    __device__ bool next(int i, Unit& u) const {
        long L = (long)i * G + c;
        if (skew) { if (c >= 128) { if (i >= 5) return false; L = (c - 128) + 128 * i; } else { if (i >= 3) return false; L = 640 + c + 128 * i; } }
        if (L >= nwg) return false;
        int wgid = (int)L; { const int q = nwg / NXCD, r = nwg % NXCD, xcd = wgid % NXCD, off = wgid / NXCD; wgid = (xcd < r ? xcd * (q + 1) : r * (q + 1) + (xcd - r) * q) + off; }
        const int nig = WGM * nN, gid = wgid / nig, fm = gid * WGM, gsz = (nM - fm) < WGM ? (nM - fm) : WGM;
        u.pm = fm + ((wgid % nig) % gsz); u.pn = (wgid % nig) / gsz; u.e = 0; u.lrow = 0; u.nvalid = 256; return true;
    }
};
struct MoeOrder {
    const LAS int* toff; const LAS int* cl; int nN, G, c;
    __device__ bool next(int i, Unit& u) const {
        const int ntile = toff[NE]; int gt, pn;
        if ((G & 7) == 0) { const int x = c & 7, s = c >> 3, per = G >> 3, t0 = (ntile * x) >> 3, t1 = (ntile * (x + 1)) >> 3, Lx = i * per + s;
            if (Lx >= (t1 - t0) * nN) return false;
            const int q = Lx / nN; gt = t0 + q; pn = Lx - q * nN; }
        else { const int L = i * G + c; if (L >= ntile * nN) return false; gt = L / nN; pn = L - gt * nN; }
        int e = 0;
#pragma unroll
        for (int k = 16; k >= 1; k >>= 1) if (toff[e + k] <= gt) e += k;
        const int rt = gt - toff[e]; int nv = cl[e] - rt * 256; nv = nv > 256 ? 256 : nv;
        u.pm = __builtin_amdgcn_readfirstlane(gt); u.pn = __builtin_amdgcn_readfirstlane(pn); u.e = __builtin_amdgcn_readfirstlane(e);
        u.lrow = __builtin_amdgcn_readfirstlane(e * CAP + rt * 256); u.nvalid = __builtin_amdgcn_readfirstlane(nv); return true;
    }
};

#ifndef MK_NT
#define MK_NT 1
#endif
#if MK_NT
#define NT_STORE(v, p) __builtin_nontemporal_store(v, p)
#else
#define NT_STORE(v, p) (*(p) = (v))
#endif
struct EpiBf16 {
    static constexpr bool PERM = true;
    bf16_t* O; int ldc; float sc;
    __device__ __forceinline__ void operator()(const f32x4 (&acc)[2][2][4][2], const Unit& u, int wr, int wc, int fr, int fq) const {
        const int row0 = u.pm * BM + wr * 64 + fr, col0 = u.pn * BM + wc * 32 + 8 * fq;
#pragma unroll
        for (int ai = 0; ai < 2; ++ai)
#pragma unroll
            for (int m = 0; m < 4; ++m) { bf16_t* rowp = O + (size_t)(row0 + ai * HALF + m * 16) * ldc + col0;
#pragma unroll
                for (int bj = 0; bj < 2; ++bj) { const f32x4 v0 = acc[ai][bj][m][0] * sc, v1 = acc[ai][bj][m][1] * sc;
                    u32x4 w; w.x = cvt_pk_bf16(v0[0], v0[1]); w.y = cvt_pk_bf16(v0[2], v0[3]); w.z = cvt_pk_bf16(v1[0], v1[1]); w.w = cvt_pk_bf16(v1[2], v1[3]);
                    NT_STORE(w, (u32x4*)(rowp + bj * HALF)); } }
    }
};
template <bool FIRST> struct EpiGate {
    static constexpr bool PERM = true;
    bf16_t* O; const bf16_t* prev; const bf16_t* P; int gcol;
    __device__ __forceinline__ void operator()(const f32x4 (&acc)[2][2][4][2], const Unit& u, int wr, int wc, int fr, int fq) const {
        const int row0 = u.pm * BM + wr * 64 + fr, col0 = u.pn * BM + wc * 32 + 8 * fq;
#pragma unroll
        for (int ai = 0; ai < 2; ++ai)
#pragma unroll
            for (int m = 0; m < 4; ++m) { const size_t row = (size_t)(row0 + ai * HALF + m * 16);
#pragma unroll
                for (int bj = 0; bj < 2; ++bj) { const int col = col0 + bj * HALF;
                    const u32x4 gz = *(const u32x4*)(P + row * PITCH + gcol + col);
                    const f32x4 v0 = acc[ai][bj][m][0], v1 = acc[ai][bj][m][1];
                    float o[8];
                    o[0] = v0[0] * sigmoidf_(bf_lo(gz.x)); o[1] = v0[1] * sigmoidf_(bf_hi(gz.x)); o[2] = v0[2] * sigmoidf_(bf_lo(gz.y)); o[3] = v0[3] * sigmoidf_(bf_hi(gz.y));
                    o[4] = v1[0] * sigmoidf_(bf_lo(gz.z)); o[5] = v1[1] * sigmoidf_(bf_hi(gz.z)); o[6] = v1[2] * sigmoidf_(bf_lo(gz.w)); o[7] = v1[3] * sigmoidf_(bf_hi(gz.w));
                    if (!FIRST) { const u32x4 pv = *(const u32x4*)(prev + row * D + col);
                        o[0] += bf_lo(pv.x); o[1] += bf_hi(pv.x); o[2] += bf_lo(pv.y); o[3] += bf_hi(pv.y); o[4] += bf_lo(pv.z); o[5] += bf_hi(pv.z); o[6] += bf_lo(pv.w); o[7] += bf_hi(pv.w); }
                    u32x4 w; w.x = cvt_pk_bf16(o[0], o[1]); w.y = cvt_pk_bf16(o[2], o[3]); w.z = cvt_pk_bf16(o[4], o[5]); w.w = cvt_pk_bf16(o[6], o[7]);
                    *(u32x4*)(O + row * D + col) = w; } }
    }
};
struct EpiRouter {
    static constexpr bool PERM = false;
    float* L; const float* bias;
    __device__ __forceinline__ void operator()(const f32x4 (&acc)[2][2][4][2], const Unit& u, int wr, int wc, int fr, int fq) const {
        if (wc != 0) return;
        const int row0 = u.pm * BM + wr * 64 + fr, col0 = 4 * fq;
        const f32x4 b0 = *(const f32x4*)(bias + col0), b1 = *(const f32x4*)(bias + col0 + 16);
#pragma unroll
        for (int ai = 0; ai < 2; ++ai)
#pragma unroll
            for (int m = 0; m < 4; ++m) { float* rowp = L + (size_t)(row0 + ai * HALF + m * 16) * NE + col0;
                *(f32x4*)(rowp) = acc[ai][0][m][0] + b0; *(f32x4*)(rowp + 16) = acc[ai][0][m][1] + b1; }
    }
};
struct EpiSwiglu {
    static constexpr bool PERM = true;
    bf16_t* ACT; const float* bgu;
    __device__ __forceinline__ void operator()(const f32x4 (&acc)[2][2][4][2], const Unit& u, int wr, int wc, int fr, int fq) const {
        const int row0 = u.pm * BM + wr * 64 + fr, j0 = u.pn * HALF + wc * 32 + 8 * fq;
        const float* bg = bgu + (size_t)u.e * 2 * FF + j0;
        float g_b[8], u_b[8];
        { const f32x4 a = *(const f32x4*)bg, b = *(const f32x4*)(bg + 4), c = *(const f32x4*)(bg + FF), d = *(const f32x4*)(bg + FF + 4);
#pragma unroll
          for (int i = 0; i < 4; ++i) { g_b[i] = a[i]; g_b[4 + i] = b[i]; u_b[i] = c[i]; u_b[4 + i] = d[i]; } }
#pragma unroll
        for (int ai = 0; ai < 2; ++ai)
#pragma unroll
            for (int m = 0; m < 4; ++m) { bf16_t* rowp = ACT + (size_t)(row0 + ai * HALF + m * 16) * FF + j0;
                float o[8];
#pragma unroll
                for (int n = 0; n < 2; ++n)
#pragma unroll
                    for (int i = 0; i < 4; ++i) { float gt = acc[ai][0][m][n][i] + g_b[4 * n + i], up = acc[ai][1][m][n][i] + u_b[4 * n + i];
                        gt = fminf(gt, 7.0f); up = fminf(fmaxf(up, -7.0f), 7.0f);
                        o[4 * n + i] = gt * __builtin_amdgcn_rcpf(1.0f + __builtin_amdgcn_exp2f(-1.702f * LOG2E * gt)) * (up + 1.0f); }
                u32x4 w; w.x = cvt_pk_bf16(o[0], o[1]); w.y = cvt_pk_bf16(o[2], o[3]); w.z = cvt_pk_bf16(o[4], o[5]); w.w = cvt_pk_bf16(o[6], o[7]);
                *(u32x4*)rowp = w; }
    }
};
struct EpiSwiglu8 {
    static constexpr bool PERM = true;
    unsigned char* ACT; const float* bgu;
    struct Pre { f32x4 a, b, c, d; };
    __device__ __forceinline__ Pre pre(const Unit& u, int wr, int wc, int fr, int fq) const {
        const float* bg = bgu + (size_t)u.e * 2 * FF + u.pn * HALF + wc * 32 + 8 * fq;
        Pre q; q.a = *(const f32x4*)bg; q.b = *(const f32x4*)(bg + 4); q.c = *(const f32x4*)(bg + FF); q.d = *(const f32x4*)(bg + FF + 4); return q; }
    __device__ __forceinline__ void post(const f32x4 (&acc)[2][2][4][2], const Pre& q, const Unit& u, int wr, int wc, int fr, int fq) const {
        constexpr float DS = 1.0f / (F8_SH * F8_SW);
        const int row0 = u.pm * BM + wr * 64 + fr, j0 = u.pn * HALF + wc * 32 + 8 * fq;
        float g_b[8], u_b[8];
#pragma unroll
        for (int i = 0; i < 4; ++i) { g_b[i] = q.a[i]; g_b[4 + i] = q.b[i]; u_b[i] = q.c[i]; u_b[4 + i] = q.d[i]; }
#pragma unroll
        for (int ai = 0; ai < 2; ++ai)
#pragma unroll
            for (int m = 0; m < 4; ++m) { unsigned char* rowp = ACT + (size_t)(row0 + ai * HALF + m * 16) * FF + j0;
                float o[8];
#pragma unroll
                for (int n = 0; n < 2; ++n)
#pragma unroll
                    for (int i = 0; i < 4; ++i) { float gt = acc[ai][0][m][n][i] * DS + g_b[4 * n + i], up = acc[ai][1][m][n][i] * DS + u_b[4 * n + i];
                        gt = fminf(gt, 7.0f); up = fminf(fmaxf(up, -7.0f), 7.0f);
                        o[4 * n + i] = gt * __builtin_amdgcn_rcpf(1.0f + __builtin_amdgcn_exp2f(-1.702f * LOG2E * gt)) * (up + 1.0f) * F8_SACT; }
                u32x2 w; w.x = pk4_fp8(o[0], o[1], o[2], o[3]); w.y = pk4_fp8(o[4], o[5], o[6], o[7]);
                NT_STORE(w, (u32x2*)rowp); }
    }
    __device__ __forceinline__ void operator()(const f32x4 (&acc)[2][2][4][2], const Unit& u, int wr, int wc, int fr, int fq) const { const Pre q = pre(u, wr, wc, fr, fq); post(acc, q, u, wr, wc, fr, fq); }
};
struct EpiDown {
    static constexpr bool PERM = true;
    bf16_t* YS; const float* bd; const float* listw; float ds;
    struct Pre { float ws[8]; f32x4 bv[2][2]; };
    __device__ __forceinline__ Pre pre(const Unit& u, int wr, int wc, int fr, int fq) const {
        const int r0 = wr * 64 + fr, col0 = u.pn * BM + wc * 32 + 8 * fq;
        const float* bp = bd + (size_t)u.e * D + col0;
        Pre q;
#pragma unroll
        for (int g = 0; g < 8; ++g) { const int r = r0 + (g >> 2) * HALF + (g & 3) * 16; q.ws[g] = (r < u.nvalid) ? listw[u.lrow + r] : 0.f; }
#pragma unroll
        for (int bj = 0; bj < 2; ++bj) { q.bv[bj][0] = *(const f32x4*)(bp + bj * HALF); q.bv[bj][1] = *(const f32x4*)(bp + bj * HALF + 4); }
        return q; }
    __device__ __forceinline__ void post(const f32x4 (&acc)[2][2][4][2], const Pre& q, const Unit& u, int wr, int wc, int fr, int fq) const {
        const int r0 = wr * 64 + fr, col0 = u.pn * BM + wc * 32 + 8 * fq;
#pragma unroll
        for (int ai = 0; ai < 2; ++ai)
#pragma unroll
            for (int m = 0; m < 4; ++m) { const float w_ = q.ws[ai * 4 + m]; bf16_t* rowp = YS + (size_t)(u.pm * BM + r0 + ai * HALF + m * 16) * D + col0;
#pragma unroll
                for (int bj = 0; bj < 2; ++bj) { const f32x4 v0 = (acc[ai][bj][m][0] * ds + q.bv[bj][0]) * w_, v1 = (acc[ai][bj][m][1] * ds + q.bv[bj][1]) * w_;
                    u32x4 w; w.x = cvt_pk_bf16(v0[0], v0[1]); w.y = cvt_pk_bf16(v0[2], v0[3]); w.z = cvt_pk_bf16(v1[0], v1[1]); w.w = cvt_pk_bf16(v1[2], v1[3]);
                    NT_STORE(w, (u32x4*)(rowp + bj * HALF)); } }
    }
    __device__ __forceinline__ void operator()(const f32x4 (&acc)[2][2][4][2], const Unit& u, int wr, int wc, int fr, int fq) const { const Pre q = pre(u, wr, wc, fr, fq); post(acc, q, u, wr, wc, fr, fq); }
};

struct EpiDown8 {
    static constexpr bool PERM = true; static constexpr bool PERM16 = true;
    unsigned char* YS; const float* bd; const float* listw; float ds;
    struct Pre { float ws[8]; f32x4 bv[4]; };
    __device__ __forceinline__ Pre pre(const Unit& u, int wr, int wc, int fr, int fq) const {
        const int r0 = wr * 64 + fr, col0 = u.pn * BM + wc * 64 + 16 * fq;
        const float* bp = bd + (size_t)u.e * D + col0;
        Pre q;
#pragma unroll
        for (int g = 0; g < 8; ++g) { const int r = r0 + (g >> 2) * HALF + (g & 3) * 16; q.ws[g] = (r < u.nvalid) ? listw[u.lrow + r] * F8_SY : 0.f; }
#pragma unroll
        for (int j = 0; j < 4; ++j) q.bv[j] = *(const f32x4*)(bp + 4 * j);
        return q; }
    __device__ __forceinline__ void post(const f32x4 (&acc)[2][2][4][2], const Pre& q, const Unit& u, int wr, int wc, int fr, int fq) const {
        const int r0 = wr * 64 + fr, col0 = u.pn * BM + wc * 64 + 16 * fq;
#pragma unroll
        for (int ai = 0; ai < 2; ++ai)
#pragma unroll
            for (int m = 0; m < 4; ++m) { const float w_ = q.ws[ai * 4 + m]; unsigned char* rowp = YS + (size_t)(u.pm * BM + r0 + ai * HALF + m * 16) * D + col0;
                u32x4 w;
#pragma unroll
                for (int bj = 0; bj < 2; ++bj)
#pragma unroll
                    for (int n = 0; n < 2; ++n) { const f32x4 v = (acc[ai][bj][m][n] * ds + q.bv[2 * bj + n]) * w_; w[2 * bj + n] = pk4_fp8(v[0], v[1], v[2], v[3]); }
                NT_STORE(w, (u32x4*)rowp); }
    }
    __device__ __forceinline__ void operator()(const f32x4 (&acc)[2][2][4][2], const Unit& u, int wr, int wc, int fr, int fq) const { const Pre q = pre(u, wr, wc, fr, fq); post(acc, q, u, wr, wc, fr, fq); }
};
#ifdef MK_EPIX
template <int MODE> struct EpiDownX {
    static constexpr bool PERM = true;
    bf16_t* YS; const float* bd; const float* listw; float ds;
    __device__ __forceinline__ void operator()(const f32x4 (&acc)[2][2][4][2], const Unit& u, int wr, int wc, int fr, int fq) const {
        const int r0 = wr * 64 + fr, col0 = u.pn * BM + wc * 32 + 8 * fq;
        const float* bp = bd + (size_t)u.e * D + col0;
        float ws[8]; f32x4 bv[2][2];
        if (MODE != 2) {
#pragma unroll
        for (int g = 0; g < 8; ++g) { const int r = r0 + (g >> 2) * HALF + (g & 3) * 16; ws[g] = (r < u.nvalid) ? listw[u.lrow + r] : 0.f; }
#pragma unroll
        for (int bj = 0; bj < 2; ++bj) { bv[bj][0] = *(const f32x4*)(bp + bj * HALF); bv[bj][1] = *(const f32x4*)(bp + bj * HALF + 4); }
        } else {
#pragma unroll
        for (int g = 0; g < 8; ++g) ws[g] = ds;
#pragma unroll
        for (int bj = 0; bj < 2; ++bj) { bv[bj][0] = (f32x4){ds, ds, ds, ds}; bv[bj][1] = bv[bj][0]; } }
#pragma unroll
        for (int ai = 0; ai < 2; ++ai)
#pragma unroll
            for (int m = 0; m < 4; ++m) { const float w_ = ws[ai * 4 + m]; bf16_t* rowp = YS + (size_t)(u.pm * BM + r0 + ai * HALF + m * 16) * D + col0;
#pragma unroll
                for (int bj = 0; bj < 2; ++bj) { const f32x4 v0 = (acc[ai][bj][m][0] * ds + bv[bj][0]) * w_, v1 = (acc[ai][bj][m][1] * ds + bv[bj][1]) * w_;
                    u32x4 w; w.x = cvt_pk_bf16(v0[0], v0[1]); w.y = cvt_pk_bf16(v0[2], v0[3]); w.z = cvt_pk_bf16(v1[0], v1[1]); w.w = cvt_pk_bf16(v1[2], v1[3]);
                    if (MODE != 1) *(u32x4*)(rowp + bj * HALF) = w; else asm volatile("" :: "v"(w)); } }
    }
};
#endif
struct EpiNull {
    static constexpr bool PERM = true;
    __device__ __forceinline__ void operator()(const f32x4 (&acc)[2][2][4][2], const Unit& u, int wr, int wc, int fr, int fq) const {
#pragma unroll
        for (int ai = 0; ai < 2; ++ai)
#pragma unroll
            for (int bj = 0; bj < 2; ++bj)
#pragma unroll
                for (int m = 0; m < 4; ++m) asm volatile("" :: "v"(acc[ai][bj][m][0]), "v"(acc[ai][bj][m][1]));
    }
};
template <class Epi, class Sched, bool GATHER, bool ALIGN_EPI, bool F8 = false, bool PFA = false>
__device__ __forceinline__ void gemm_phase(LAS unsigned char* lds, const Gemm g, const Sched& S, const Epi& E) {
    int tid = threadIdx.x; asm volatile("" : "+v"(tid));
    const int wid = __builtin_amdgcn_readfirstlane(tid >> 6), lane = tid & 63, wr = wid >> 2, wc = wid & 3, fr = lane & 15, fq = lane >> 4;
    const int K = g.K, nt = K / BK;
    unsigned voffA[2], voffB[2]; int Rg[2], Cg[2];
#pragma unroll
    for (int i = 0; i < 2; ++i) { int R, C; stage_rc(tid * 16 + i * 8192, R, C); const int Rb = Perm16<Epi>::v ? perm16x(R) : Epi::PERM ? ((R & ~31) + perm32(R & 31)) : R;
        voffA[i] = (unsigned)(R * K + C) * 2u; voffB[i] = (unsigned)(Rb * K + C) * 2u; Rg[i] = R; Cg[i] = C; }
    const size_t kstep = (size_t)(BK * 2);
    const size_t hstep = (size_t)HALF * K * 2;
    const size_t tstep = 2 * hstep;
    const unsigned ldsw = (unsigned)wid * 1024u;
    const int aoff = lds_byte(wr * 64 + fr, fq * 8), boff = lds_byte(wc * 32 + fr, fq * 8);
    unsigned vAc[2][2], vAn[2][2];
#define PG8_SA(b, h) (((b) * 2 + (h)) * HTB)
#define PG8_SB(b, h) ((4 + (b) * 2 + (h)) * HTB)
#define PG8_STAGE2(bufoff, gbase, v0, v1) do { \
        __builtin_amdgcn_global_load_lds((const unsigned*)((const char*)(gbase) + (v0)), (LAS unsigned*)(lds + (bufoff) + ldsw), 16, 0, 0); \
        __builtin_amdgcn_global_load_lds((const unsigned*)((const char*)(gbase) + (v1)), (LAS unsigned*)(lds + (bufoff) + ldsw + 8192), 16, 0, 0); } while (0)
#define PG8_STA(bufoff, ap, h, usen) do { if constexpr (GATHER) { const unsigned o0_ = (usen) ? vAn[h][0] : vAc[h][0], o1_ = (usen) ? vAn[h][1] : vAc[h][1]; PG8_STAGE2(bufoff, ap, o0_, o1_); } \
        else { PG8_STAGE2(bufoff, (ap) + (h) * hstep, voffA[0], voffA[1]); } } while (0)
#define PG8_STB(bufoff, bp, h) PG8_STAGE2(bufoff, (bp) + (h) * (Perm16<Epi>::v ? (size_t)8 * K * 2 : hstep), voffB[0], voffB[1])
#define PG8_ROWS(u, v) do { _Pragma("unroll") for (int h_ = 0; h_ < 2; ++h_) _Pragma("unroll") for (int i_ = 0; i_ < 2; ++i_) { const int rr_ = h_ * HALF + Rg[i_]; \
        const int idx_ = (rr_ < (u).nvalid) ? g.rows[(u).lrow + rr_] : 0; v[h_][i_] = (unsigned)((idx_ >> 2) * K + Cg[i_]) * 2u; } \
        asm volatile("" : "+v"(v[0][0]), "+v"(v[0][1]), "+v"(v[1][0]), "+v"(v[1][1])); } while (0)
#define PG8_LDA(dst, b, h) do { _Pragma("unroll") for (int m = 0; m < 4; ++m) _Pragma("unroll") for (int k = 0; k < 2; ++k) dst[m][k] = *(const LAS bf16x8*)(lds + PG8_SA(b, h) + aoff + m * 2048 + k * 1024); } while (0)
#define PG8_LDB(dst, b, h) do { _Pragma("unroll") for (int n = 0; n < 2; ++n) _Pragma("unroll") for (int k = 0; k < 2; ++k) dst[n][k] = *(const LAS bf16x8*)(lds + PG8_SB(b, h) + boff + n * 2048 + k * 1024); } while (0)
#define PG8_CAT(x, y) __builtin_shufflevector(__builtin_bit_cast(v4i_t, x), __builtin_bit_cast(v4i_t, y), 0, 1, 2, 3, 4, 5, 6, 7)
#define PG8_MMA(ai, bj, At, Bt) do { __builtin_amdgcn_s_setprio(1); if constexpr (F8) { \
        _Pragma("unroll") for (int m = 0; m < 4; ++m) _Pragma("unroll") for (int n = 0; n < 2; ++n) \
            { const v8i_t b8_ = PG8_CAT(Bt[n][0], Bt[n][1]), a8_ = PG8_CAT(At[m][0], At[m][1]);     \
              asm volatile("v_mfma_scale_f32_16x16x128_f8f6f4 %0, %1, %2, %0, %3, %3 op_sel_hi:[0,0,0]" : "+v"(acc[ai][bj][m][n]) : "v"(b8_), "v"(a8_), "v"(f8one)); } \
        } else { _Pragma("unroll") for (int m = 0; m < 4; ++m) _Pragma("unroll") for (int n = 0; n < 2; ++n) _Pragma("unroll") for (int k = 0; k < 2; ++k) \
        acc[ai][bj][m][n] = __builtin_amdgcn_mfma_f32_16x16x32_bf16(Bt[n][k], At[m][k], acc[ai][bj][m][n], 0, 0, 0); } __builtin_amdgcn_s_setprio(0); } while (0)
#define PG8_WAIT_V(n) asm volatile("s_waitcnt vmcnt(" #n ")" ::: "memory")
#define PG8_WAIT_L(n) asm volatile("s_waitcnt lgkmcnt(" #n ")" ::: "memory")
#define PG8_BAR __builtin_amdgcn_s_barrier()
#define PG8_SCHED __builtin_amdgcn_sched_barrier(0)
    Unit cur, nxt; int ui = 0;
    if (!S.next(0, cur)) return;
    f32x4 acc[2][2][4][2];
#pragma unroll
    for (int a = 0; a < 2; ++a)
#pragma unroll
        for (int b = 0; b < 2; ++b)
#pragma unroll
            for (int m = 0; m < 4; ++m)
#pragma unroll
                for (int n = 0; n < 2; ++n) acc[a][b][m][n] = (f32x4){0.f, 0.f, 0.f, 0.f};
    bf16x8 At[4][2], B0[2][2], B1[2][2];
    const int f8one = 0x7f7f7f7f;
    const char* cA = GATHER ? (const char*)g.A : (const char*)g.A + (size_t)cur.pm * tstep;
    const char* cB = (const char*)g.Bt + ((size_t)cur.e * g.estride) * 2 + (size_t)cur.pn * tstep;
    if constexpr (GATHER) { PG8_ROWS(cur, vAc); }
    PG8_STB(PG8_SB(0, 0), cB, 0); PG8_STB(PG8_SB(0, 1), cB, 1); PG8_STA(PG8_SA(0, 0), cA, 0, false); PG8_STA(PG8_SA(0, 1), cA, 1, false);
    if (wr == 1) PG8_BAR;
    PG8_WAIT_V(2); PG8_BAR;
    PG8_STB(PG8_SB(1, 0), cB + kstep, 0); PG8_STA(PG8_SA(1, 0), cA + kstep, 0, false); PG8_STB(PG8_SB(1, 1), cB + kstep, 1);
    PG8_WAIT_V(6); PG8_BAR;
    for (;;) {
        const bool has_next = S.next(ui + 1, nxt);
        const char* nA = GATHER ? (const char*)g.A : (has_next ? (const char*)g.A + (size_t)nxt.pm * tstep : cA);
        const char* nB = has_next ? (const char*)g.Bt + ((size_t)nxt.e * g.estride) * 2 + (size_t)nxt.pn * tstep : cB;
        if constexpr (GATHER) { if (has_next) { PG8_ROWS(nxt, vAn); } else {
#pragma unroll
            for (int h = 0; h < 2; ++h) { vAn[h][0] = vAc[h][0]; vAn[h][1] = vAc[h][1]; } } }
        for (int t = 0; t < nt; t += 2) {
            const bool last = (t == nt - 2);
            const char* a1 = cA + (size_t)(t + 1) * kstep;
            const char* a2 = last ? nA : cA + (size_t)(t + 2) * kstep; const char* b2 = last ? nB : cB + (size_t)(t + 2) * kstep;
            const char* a3 = a2 + kstep; const char* b3 = b2 + kstep;
            PG8_LDB(B0, 0, 0); PG8_LDB(B1, 0, 1); PG8_SCHED; PG8_LDA(At, 0, 0); PG8_STA(PG8_SA(1, 1), a1, 1, false);
            PG8_WAIT_V(8); PG8_WAIT_L(0); PG8_BAR; PG8_MMA(0, 0, At, B0); PG8_MMA(0, 1, At, B1); PG8_BAR; PG8_SCHED;
            PG8_LDA(At, 0, 1); PG8_STB(PG8_SB(0, 0), b2, 0); PG8_STB(PG8_SB(0, 1), b2, 1); PG8_STA(PG8_SA(0, 0), a2, 0, last);
            PG8_WAIT_V(8); PG8_WAIT_L(0); PG8_BAR; PG8_MMA(1, 0, At, B0); PG8_MMA(1, 1, At, B1); PG8_BAR; PG8_SCHED;
            PG8_LDB(B0, 1, 0); PG8_LDB(B1, 1, 1); PG8_SCHED; PG8_LDA(At, 1, 0); PG8_STA(PG8_SA(0, 1), a2, 1, last);
            PG8_WAIT_V(8); PG8_WAIT_L(0); PG8_BAR; PG8_MMA(0, 0, At, B0); PG8_MMA(0, 1, At, B1); PG8_BAR; PG8_SCHED;
            PG8_LDA(At, 1, 1); PG8_STB(PG8_SB(1, 0), b3, 0); PG8_STB(PG8_SB(1, 1), b3, 1); PG8_STA(PG8_SA(1, 0), a3, 0, last);
            PG8_WAIT_V(8); PG8_WAIT_L(0); PG8_BAR; PG8_MMA(1, 0, At, B0); PG8_MMA(1, 1, At, B1); PG8_BAR; PG8_SCHED;
        }
        if constexpr (ALIGN_EPI) { if (wr == 0) PG8_BAR; }
        if constexpr (F8) asm volatile("s_nop 15\n\ts_nop 15" ::: "memory");
        if constexpr (PFA) {
            const auto q_ = E.pre(cur, wr, wc, fr, fq);
            PG8_SCHED;
            if (has_next) { LAS unsigned* dump_ = (LAS unsigned*)(lds + STAGE_BYTES + 8192 + ldsw / 4);
                for (int kb = 0; kb < nt * 128; kb += 1024) if (kb > 0 || Cg[0] >= 16) {
#pragma unroll
                    for (int h = 0; h < 2; ++h)
#pragma unroll
                        for (int i = 0; i < 2; ++i) { const char* pa_ = GATHER ? nA + vAn[h][i] : nA + h * hstep + voffA[i];
                            __builtin_amdgcn_global_load_lds((const unsigned*)(pa_ + Cg[i] * 14 + kb), dump_, 4, 0, 0); } } }
            PG8_SCHED;
            E.post(acc, q_, cur, wr, wc, fr, fq);
        } else E(acc, cur, wr, wc, fr, fq);
        if (!has_next) break;
#pragma unroll
        for (int a = 0; a < 2; ++a)
#pragma unroll
            for (int b = 0; b < 2; ++b)
#pragma unroll
                for (int m = 0; m < 4; ++m)
#pragma unroll
                    for (int n = 0; n < 2; ++n) acc[a][b][m][n] = (f32x4){0.f, 0.f, 0.f, 0.f};
        cur = nxt; cA = nA; cB = nB; ++ui;
        if constexpr (GATHER) {
#pragma unroll
            for (int h = 0; h < 2; ++h) { vAc[h][0] = vAn[h][0]; vAc[h][1] = vAn[h][1]; } }
        if constexpr (ALIGN_EPI) { if (wr == 1) PG8_BAR; }
    }
    PG8_WAIT_V(0);
    if constexpr (!ALIGN_EPI) { if (wr == 0) PG8_BAR; }
    PG8_BAR;
#undef PG8_SA
#undef PG8_SB
#undef PG8_STAGE2
#undef PG8_STA
#undef PG8_STB
#undef PG8_ROWS
#undef PG8_LDA
#undef PG8_LDB
#undef PG8_MMA
#undef PG8_CAT
#undef PG8_WAIT_V
#undef PG8_WAIT_L
#undef PG8_BAR
#undef PG8_SCHED
}
}
namespace attn_body {
using bf16x8 = __attribute__((ext_vector_type(8))) short;
using s16x4 = __attribute__((ext_vector_type(4))) short;
using f32x16 = __attribute__((ext_vector_type(16))) float;
constexpr int NW = 8, QBLK = 32, QB = QBLK * NW, KVBLK = 64;
__device__ __forceinline__ int crow(int r, int hi) { return (r & 3) + 8 * (r >> 2) + 4 * hi; }
#define SBAR() __builtin_amdgcn_sched_barrier(0)
constexpr int NSLOT = 4, SLOTK = 8192, SLOTV = 16384;
constexpr int LDS_K = 0, LDS_V = NSLOT * SLOTK, LDS_WS = LDS_V + NSLOT * SLOTV, LDS_TAB = LDS_WS + NW * 64 * 4, TAB_N = 640, LDS_BYTES = LDS_TAB + TAB_N * 4;
__device__ __forceinline__ void glds16(const void* gsrc, unsigned lds_dst) { unsigned keep;
  asm volatile("s_mov_b32 %0, m0\n\ts_mov_b32 m0, %2\n\ts_nop 0\n\tglobal_load_lds_dwordx4 %1, off\n\ts_mov_b32 m0, %0" : "=&s"(keep) : "v"(gsrc), "s"(lds_dst) : "memory"); }
typedef float f32x2_t __attribute__((ext_vector_type(2))); typedef __bf16 bf16x2_t __attribute__((ext_vector_type(2)));
__device__ __forceinline__ unsigned cvtpk_s(float lo, float hi) { f32x2_t v = {lo, hi}; bf16x2_t b = __builtin_convertvector(v, bf16x2_t); return __builtin_bit_cast(unsigned, b); }
#define WAIT_BAR(N) asm volatile("s_waitcnt vmcnt(" #N ") lgkmcnt(0)\n\ts_barrier" ::: "memory")

__device__ __forceinline__ void kload8(bf16x8* kf, const LAS char* Kslot, int r32, int hi);
__device__ __forceinline__ void qkt_r(f32x16& p0, f32x16& p1, const bf16x8* kf, const bf16x8* qr, const f32x16& negm);
__device__ __forceinline__ void qkt(f32x16& p0, f32x16& p1, const LAS char* Kslot, const bf16x8* qr, const f32x16& negm, int r32, int hi) { bf16x8 kf[8]; kload8(kf, Kslot, r32, hi); qkt_r(p0, p1, kf, qr, negm); }
__device__ __forceinline__ float fadd_s(float a, float b) { float r; asm("v_add_f32_e32 %0, %1, %2" : "=v"(r) : "v"(a), "v"(b)); return r; }
__device__ __forceinline__ void kload8(bf16x8* kf, const LAS char* Kslot, int r32, int hi) {
  const unsigned a0 = (unsigned)(uintptr_t)Kslot + r32 * 128 + ((hi ^ ((r32 >> 1) & 7)) << 4);
  #pragma unroll
  for (int d0 = 0; d0 < 4; ++d0) { const LAS char* kb = (const LAS char*)(uintptr_t)(a0 ^ (d0 << 5)); kf[2 * d0] = *(const LAS bf16x8*)(kb); kf[2 * d0 + 1] = *(const LAS bf16x8*)(kb + 4096); }
}
__device__ __forceinline__ void qkt_r(f32x16& p0, f32x16& p1, const bf16x8* kf, const bf16x8* qr, const f32x16& negm) {
  asm volatile("v_mfma_f32_32x32x16_bf16 %0, %1, %2, %3" : "=&v"(p0) : "v"(kf[0]), "v"(qr[0]), "v"(negm));
  asm volatile("v_mfma_f32_32x32x16_bf16 %0, %1, %2, %3" : "=&v"(p1) : "v"(kf[1]), "v"(qr[0]), "v"(negm));
  #pragma unroll
  for (int d0 = 1; d0 < 4; ++d0) {
    asm volatile("v_mfma_f32_32x32x16_bf16 %0, %1, %2, %0" : "+v"(p0) : "v"(kf[2 * d0]), "v"(qr[d0]));
    asm volatile("v_mfma_f32_32x32x16_bf16 %0, %1, %2, %0" : "+v"(p1) : "v"(kf[2 * d0 + 1]), "v"(qr[d0])); }
}
#define MX3(a, b, c) __builtin_fmaxf(__builtin_fmaxf((a), (b)), (c))
__device__ __forceinline__ float rowmax(const f32x16& p0, const f32x16& p1) {
  float a = MX3(p0[0], p0[1], p1[0]), b = MX3(p0[2], p0[3], p1[1]); a = MX3(a, p1[2], p1[3]);
  #pragma unroll
  for (int r = 4; r < 16; r += 4) { a = MX3(a, p0[r], p0[r + 1]); b = MX3(b, p0[r + 2], p0[r + 3]); a = MX3(a, p1[r], p1[r + 1]); b = MX3(b, p1[r + 2], p1[r + 3]); }
  float rm = __builtin_fmaxf(a, b);
  auto rr = __builtin_amdgcn_permlane32_swap(__float_as_uint(rm), __float_as_uint(rm), false, false);
  return __builtin_fmaxf(__uint_as_float(rr[0]), __uint_as_float(rr[1]));
}
__device__ __forceinline__ void bmask(f32x16& p0, f32x16& p1, int jb, int qrel, int hi, const LAS float* tab) {
  const unsigned ta = (unsigned)(uintptr_t)(tab + (255 + qrel - 64 * jb - 4 * hi - 59));
  #pragma unroll
  for (int g = 0; g < 4; ++g) {
    float a0, a1, a2, a3, b0, b1, b2, b3;
    asm volatile("ds_read_b32 %0, %8 offset:%c9\n\tds_read_b32 %1, %8 offset:%c10\n\tds_read_b32 %2, %8 offset:%c11\n\tds_read_b32 %3, %8 offset:%c12\n\t"
                 "ds_read_b32 %4, %8 offset:%c13\n\tds_read_b32 %5, %8 offset:%c14\n\tds_read_b32 %6, %8 offset:%c15\n\tds_read_b32 %7, %8 offset:%c16\n\ts_waitcnt lgkmcnt(0)"
                 : "=&v"(a0), "=&v"(a1), "=&v"(a2), "=&v"(a3), "=&v"(b0), "=&v"(b1), "=&v"(b2), "=&v"(b3)
                 : "v"(ta), "i"(4 * (59 - 8 * g)), "i"(4 * (59 - 8 * g - 1)), "i"(4 * (59 - 8 * g - 2)), "i"(4 * (59 - 8 * g - 3)),
                   "i"(4 * (59 - 8 * g - 32)), "i"(4 * (59 - 8 * g - 33)), "i"(4 * (59 - 8 * g - 34)), "i"(4 * (59 - 8 * g - 35)) : "memory");
    p0[4 * g] += a0; p0[4 * g + 1] += a1; p0[4 * g + 2] += a2; p0[4 * g + 3] += a3;
    p1[4 * g] += b0; p1[4 * g + 1] += b1; p1[4 * g + 2] += b2; p1[4 * g + 3] += b3;
  }
}
template <int ND>
__device__ __forceinline__ void pv(f32x16* o, int vb, bf16x8 pa0, bf16x8 pa1, bf16x8 pa2, bf16x8 pa3) {
  #pragma unroll
  for (int d0 = 0; d0 < ND; d0 += 2) { s16x4 lo[2][4], hi[2][4];
    #pragma unroll
    for (int e = 0; e < 2; ++e)
      #pragma unroll
      for (int ks = 0; ks < 4; ++ks) {
        asm volatile("ds_read_b64_tr_b16 %0,%1 offset:%c2" : "=&v"(lo[e][ks]) : "v"(vb), "i"((d0 + e) * 4096 + ks * 1024) : "memory");
        asm volatile("ds_read_b64_tr_b16 %0,%1 offset:%c2" : "=&v"(hi[e][ks]) : "v"(vb), "i"((d0 + e) * 4096 + ks * 1024 + 512) : "memory"); }
    asm volatile("s_waitcnt lgkmcnt(0)" ::: "memory"); SBAR();
    #define PK(e, k) (bf16x8){lo[e][k][0], lo[e][k][1], lo[e][k][2], lo[e][k][3], hi[e][k][0], hi[e][k][1], hi[e][k][2], hi[e][k][3]}
    o[d0]     = __builtin_amdgcn_mfma_f32_32x32x16_bf16(pa0, PK(0, 0), o[d0], 0, 0, 0);
    o[d0 + 1] = __builtin_amdgcn_mfma_f32_32x32x16_bf16(pa0, PK(1, 0), o[d0 + 1], 0, 0, 0);
    o[d0]     = __builtin_amdgcn_mfma_f32_32x32x16_bf16(pa1, PK(0, 1), o[d0], 0, 0, 0);
    o[d0 + 1] = __builtin_amdgcn_mfma_f32_32x32x16_bf16(pa1, PK(1, 1), o[d0 + 1], 0, 0, 0);
    o[d0]     = __builtin_amdgcn_mfma_f32_32x32x16_bf16(pa2, PK(0, 2), o[d0], 0, 0, 0);
    o[d0 + 1] = __builtin_amdgcn_mfma_f32_32x32x16_bf16(pa2, PK(1, 2), o[d0 + 1], 0, 0, 0);
    o[d0]     = __builtin_amdgcn_mfma_f32_32x32x16_bf16(pa3, PK(0, 3), o[d0], 0, 0, 0);
    o[d0 + 1] = __builtin_amdgcn_mfma_f32_32x32x16_bf16(pa3, PK(1, 3), o[d0 + 1], 0, 0, 0);
    #undef PK
    SBAR();
  }
}

#ifndef MK_TIM
#define MK_TIM 0
#endif
#if MK_TIM
__device__ unsigned long long g_tim[2];
#endif
template <int THRL, int PQ, int PO, int NV>
__device__ __forceinline__ void attn_unit(const bf16_t* Qp, const bf16_t* __restrict__ Kp, const bf16_t* __restrict__ Vp, bf16_t* Op, const int NT, const float mfloor, const float sink2, char* shm, const int dbg = 0,
                                          const bf16_t* O1p = nullptr, const float lam = 0.f, const float* gsub = nullptr, const float post = 0.f) {
  constexpr int ND = 2 * NV;
  int tid = threadIdx.x; asm volatile("" : "+v"(tid));
  const int lane = tid & 63, r32 = lane & 31, hi = lane >> 5; const int wid = __builtin_amdgcn_readfirstlane(tid >> 6);
  const unsigned lds0 = (unsigned)(uintptr_t)shm;
  const LAS char* shm3 = (const LAS char*)shm;
  LAS float* wsf = (LAS float*)((LAS char*)shm + LDS_WS) + wid * 64;
  const LAS float* tab = (const LAS float*)((LAS char*)shm + LDS_TAB);
  const bf16_t* Qw = Qp + (long)(wid * QBLK) * PQ;
  bf16x8 qr[4];
  #pragma unroll
  for (int d0 = 0; d0 < 4; ++d0) qr[d0] = *reinterpret_cast<const bf16x8*>(&Qw[(long)r32 * PQ + d0 * 16 + hi * 8]);
  const bf16_t* ksrc = Kp + (long)(8 * wid + (lane >> 3)) * PQ + (((lane & 7) ^ ((4 * wid + (lane >> 4)) & 7)) * 8);
  const bf16_t* vsrc = Vp + (long)(8 * wid + (lane >> 3)) * PQ + ((((lane >> 2) ^ (lane >> 4)) & 1) * 32) + (lane & 3) * 8;
  const unsigned kdst = lds0 + LDS_K + wid * 1024, vdst = lds0 + LDS_V + wid * 1024;
  #define DMA_K(t, sl) glds16(ksrc + (long)(t) * KVBLK * PQ, (unsigned)__builtin_amdgcn_readfirstlane(kdst + (sl) * SLOTK))
#ifndef MK_DMAX
#define MK_DMAX 0
#endif
  #define DMA_V(t, sl) do { if (MK_DMAX == 1) break; if (MK_DMAX == 2) { const long go_ = (long)(t) * KVBLK * PQ; asm volatile("global_load_lds_dwordx4 %0, off\n\tglobal_load_lds_dwordx4 %1, off" :: "v"(vsrc + go_), "v"(vsrc + go_ + 64) : "memory"); break; } \
      if (MK_DMAX == 3) { const long go_ = (long)(t) * KVBLK * PQ; asm volatile("s_mov_b32 m0, %1\n\ts_nop 0\n\tglobal_load_lds_dwordx4 %0, off" :: "v"(vsrc + go_), "s"((unsigned)__builtin_amdgcn_readfirstlane(vdst + (sl) * SLOTV)) : "memory"); \
        asm volatile("s_mov_b32 m0, %1\n\ts_nop 0\n\tglobal_load_lds_dwordx4 %0, off" :: "v"(vsrc + go_ + 64), "s"((unsigned)__builtin_amdgcn_readfirstlane(vdst + (sl) * SLOTV + 8192)) : "memory"); break; } \
      DMA_V_(t, sl); } while (0)
  #define DMA_V_(t, sl) do { const long go_ = (long)(t) * KVBLK * PQ; glds16(vsrc + go_, (unsigned)__builtin_amdgcn_readfirstlane(vdst + (sl) * SLOTV)); \
      if (NV == 2) glds16(vsrc + go_ + 64, (unsigned)__builtin_amdgcn_readfirstlane(vdst + (sl) * SLOTV + 8192)); } while (0)
  const int vb0 = (int)(lds0 + LDS_V) + (4 * hi + ((lane & 15) >> 2)) * 128 + ((lane >> 3) & 1) * 64 + ((lane >> 4) & 1) * 32 + (lane & 3) * 8;
  float mhat = mfloor, l_reg = 0.f; f32x16 o[ND], negm;
  { float zf = 0.f; asm volatile("" : "+v"(zf));
    _Pragma("unroll") for (int r = 0; r < 16; ++r) { _Pragma("unroll") for (int d = 0; d < ND; ++d) o[d][r] = zf; negm[r] = -mhat; } }
  const int qrel = wid * QBLK + r32;
  DMA_K(0, 0); DMA_V(0, 3); DMA_K(1, 1); DMA_V(0, 0); DMA_K(2, 2); DMA_V(1, 1);
  asm volatile("" :: "v"(qr[0]), "v"(qr[1]), "v"(qr[2]), "v"(qr[3]));
  const int grp = wid >> 2;
  u32x4 pw0, pw1, pw2, pw3; pw0 = pw1 = pw2 = pw3 = (u32x4){0u, 0u, 0u, 0u};
  bool resc = false;
  f32x16 c0, c1;
#ifndef ATT_STAGGER
#define ATT_STAGGER 0
#endif
  if (ATT_STAGGER && grp == 1) { if (NV == 2) WAIT_BAR(6); else WAIT_BAR(4); }
  bf16x8 kf[8];
#ifndef ATT_QKAHEAD
#define ATT_QKAHEAD 0
#endif
  if (!ATT_STAGGER) { if (NV == 2) WAIT_BAR(8); else WAIT_BAR(5); kload8(kf, shm3 + LDS_K, r32, hi); if (ATT_QKAHEAD) { qkt_r(c0, c1, kf, qr, negm); SBAR(); } }
#if MK_TIM
  unsigned long long tim_a = 0ull; unsigned tim_sum = 0u, tim_cnt = 0u; bool tim_have = false;
  #define TIM_AT(k) do { if (NV == 2 && ((k) == MK_TIM_A || (k) == MK_TIM_B)) { unsigned long long tn_; asm volatile("s_memtime %0\n\ts_waitcnt lgkmcnt(0)" : "=s"(tn_) :: "memory"); \
      if ((k) == MK_TIM_B && tim_have) { tim_sum += (unsigned)(tn_ - tim_a); ++tim_cnt; } \
      if ((k) == MK_TIM_A) { tim_a = tn_; tim_have = true; } } } while (0)
#else
  #define TIM_AT(k) do { } while (0)
#endif
#ifndef ATT_SPREAD
#define ATT_SPREAD 0
#endif
#ifndef ATT_DMAPT
#define ATT_DMAPT 1
#endif
  #define DMA_PT(k) do { if ((NV == 2 && ATT_SPREAD) ? (wid == (k)) : ((k) == ATT_DMAPT)) { const int tk_ = t + 3 < NT ? t + 3 : NT - 1, tv_ = t + 2 < NT ? t + 2 : NT - 1; DMA_K(tk_, (t + 3) & 3); DMA_V(tv_, (t + 2) & 3); } } while (0)
  #pragma unroll 1
  for (int t = 0; t <= NT; ++t) {
    TIM_AT(0);
    if (dbg & 32) { } else if (ATT_STAGGER) { if (NV == 2) WAIT_BAR(6); else WAIT_BAR(4); } else { if (NV == 2) WAIT_BAR(5); else WAIT_BAR(3); }
    TIM_AT(1);
    DMA_PT(0);
    TIM_AT(2);
    if (ATT_QKAHEAD) { kload8(kf, shm3 + LDS_K + ((t + 1) & 3) * SLOTK, r32, hi); SBAR(); TIM_AT(3); DMA_PT(1); }
    else { qkt_r(c0, c1, kf, qr, negm); SBAR(); TIM_AT(3); kload8(kf, shm3 + LDS_K + ((t + 1) & 3) * SLOTK, r32, hi); SBAR(); DMA_PT(1); }
    SBAR();
    const int jb = t - (NT - 4);
    if (jb >= -2 && jb <= 3) bmask(c0, c1, jb, qrel, hi, tab);
    const float rm = rowmax(c0, c1);
    if (t < NT && __any(rm > (float)THRL)) {
      const float dl = __builtin_fmaxf(rm, 0.f);
      mhat += dl;
      #pragma unroll
      for (int r = 0; r < 16; ++r) { c0[r] -= dl; c1[r] -= dl; negm[r] = -mhat; }
      const float f = __builtin_amdgcn_exp2f(-dl); l_reg *= f;
      if (hi == 0) wsf[r32] = f;
      resc = true;
    }
    if ((dbg & 32) || !ATT_STAGGER) { } else if (NV == 2) WAIT_BAR(5); else WAIT_BAR(3);
    if (ATT_STAGGER) { const int tk = t + 3 < NT ? t + 3 : NT - 1, tv = t + 2 < NT ? t + 2 : NT - 1;
      if (!(dbg & 4)) { DMA_K(tk, (t + 3) & 3); DMA_V(tv, (t + 2) & 3); } }
    { const int vb = vb0 + ((t + 3) & 3) * SLOTV, vbo = vb ^ 64;
      s16x4 lo[2][4], hi_[2][4];
      #define RD(b, d0) do { _Pragma("unroll") for (int ks = 0; ks < 4; ++ks) { \
          asm volatile("ds_read_b64_tr_b16 %0,%1 offset:%c2" : "=v"(lo[b][ks]) : "v"(((d0) & 1) ? vbo : vb), "i"(((d0) >> 1) * 8192 + ks * 2048) : "memory"); \
          asm volatile("ds_read_b64_tr_b16 %0,%1 offset:%c2" : "=v"(hi_[b][ks]) : "v"(((d0) & 1) ? vbo : vb), "i"(((d0) >> 1) * 8192 + ks * 2048 + 1024) : "memory"); } } while (0)
      #define WT(b) asm volatile("s_waitcnt lgkmcnt(0)" : "+v"(lo[b][0]), "+v"(lo[b][1]), "+v"(lo[b][2]), "+v"(lo[b][3]), "+v"(hi_[b][0]), "+v"(hi_[b][1]), "+v"(hi_[b][2]), "+v"(hi_[b][3]) :: "memory")
      #define PK(b, k) (bf16x8){lo[b][k][0], lo[b][k][1], lo[b][k][2], lo[b][k][3], hi_[b][k][0], hi_[b][k][1], hi_[b][k][2], hi_[b][k][3]}
      #define EXQ(e) do { if (dbg & 1) { if ((e) < 16) c0[(e)] = 0.25f; else c1[(e) - 16] = 0.25f; } else if ((e) < 16) { c0[(e)] = __builtin_amdgcn_exp2f(c0[(e)]); } else { c1[(e) - 16] = __builtin_amdgcn_exp2f(c1[(e) - 16]); } } while (0)
      #define CE(e) ((e) < 16 ? c0[(e) & 15] : c1[(e) & 15])
      #define SUMQ(e) do { if ((e) >= 0) { if ((e) & 1) so_ = fadd_s(so_, CE(e)); else se_ = fadd_s(se_, CE(e)); } } while (0)
      constexpr int EPM = 32 / (4 * ND);
      #define MM(b, d0) do { _Pragma("unroll") for (int k = 0; k < 4; ++k) { \
          const bf16x8 pa_ = __builtin_bit_cast(bf16x8, k == 0 ? pw0 : k == 1 ? pw1 : k == 2 ? pw2 : pw3); \
          if (!(dbg & 2)) o[d0] = __builtin_amdgcn_mfma_f32_32x32x16_bf16(pa_, PK(b, k), o[d0], 0, 0, 0); \
          _Pragma("unroll") for (int x = 0; x < EPM; ++x) EXQ(((d0) * 4 + k) * EPM + x); \
          _Pragma("unroll") for (int x = 0; x < EPM; ++x) SUMQ(((d0) * 4 + k) * EPM + x - EPM); \
          asm volatile("" : "+v"(c0), "+v"(c1)); SBAR(); } } while (0)
      DMA_PT(2);
      float se_ = 0.f, so_ = 0.f;
      if (!(dbg & 16)) { RD(0, 0); WT(0); } else { _Pragma("unroll") for (int b_ = 0; b_ < 2; ++b_) _Pragma("unroll") for (int k_ = 0; k_ < 4; ++k_) { lo[b_][k_] = (s16x4){0, 0, 0, 0}; hi_[b_][k_] = (s16x4){0, 0, 0, 0}; } }
      #pragma unroll
      for (int d0 = 0; d0 < ND; ++d0) {
        if (d0 + 1 < ND && !(dbg & 16)) { if ((d0 & 1) == 0) RD(1, d0 + 1); else RD(0, d0 + 1); }
        SBAR();
        if (ND == 4) DMA_PT(3 + d0);
        if ((d0 & 1) == 0) MM(0, d0); else MM(1, d0);
        if (d0 + 1 < ND && !(dbg & 16)) { if ((d0 & 1) == 0) WT(1); else WT(0); }
      }
      _Pragma("unroll") for (int x = 0; x < EPM; ++x) SUMQ(32 - EPM + x);
      if (t < NT) l_reg += se_ + so_;
      DMA_PT(7);
      #undef RD
      #undef WT
      #undef PK
      #undef EXQ
      #undef MM
      #undef SUMQ
      #undef CE
    }
    TIM_AT(5);
    if (resc) { resc = false;
      asm volatile("s_waitcnt lgkmcnt(0)" ::: "memory");
      #pragma unroll
      for (int c8 = 0; c8 < 2; ++c8) { float fr_[8];
        #pragma unroll
        for (int r = 0; r < 8; ++r) fr_[r] = wsf[crow(8 * c8 + r, hi)];
        asm volatile("s_waitcnt lgkmcnt(0)" ::: "memory");
        #pragma unroll
        for (int r = 0; r < 8; ++r)
          #pragma unroll
          for (int d = 0; d < ND; ++d) o[d][8 * c8 + r] *= fr_[r]; } }
    if (t < NT) {
      #define PKW(P, B) cvtpk_s(P[B], P[B + 1])
      pw0 = (u32x4){PKW(c0, 0), PKW(c0, 2), PKW(c0, 4), PKW(c0, 6)}; pw1 = (u32x4){PKW(c0, 8), PKW(c0, 10), PKW(c0, 12), PKW(c0, 14)};
      pw2 = (u32x4){PKW(c1, 0), PKW(c1, 2), PKW(c1, 4), PKW(c1, 6)}; pw3 = (u32x4){PKW(c1, 8), PKW(c1, 10), PKW(c1, 12), PKW(c1, 14)};
      #undef PKW
      if (ATT_QKAHEAD) { SBAR(); qkt_r(c0, c1, kf, qr, negm); SBAR(); }
    }
  }
  if (ATT_STAGGER && grp == 0) asm volatile("s_barrier" ::: "memory");
#if MK_TIM
  if (NV == 2 && lane == 0 && tim_cnt) { atomicAdd(&g_tim[0], (unsigned long long)tim_sum); atomicAdd(&g_tim[1], (unsigned long long)tim_cnt); }
#endif
  { auto rr = __builtin_amdgcn_permlane32_swap(__float_as_uint(l_reg), __float_as_uint(l_reg), false, false); l_reg = __uint_as_float(rr[0]) + __uint_as_float(rr[1]); }
  l_reg += __builtin_amdgcn_exp2f(sink2 - mhat);
  if (hi == 0) wsf[32 + r32] = l_reg;
  asm volatile("s_waitcnt vmcnt(0) lgkmcnt(0)\n\ts_barrier" ::: "memory");
  float rli[16];
  #pragma unroll
  for (int c8 = 0; c8 < 2; ++c8) {
    #pragma unroll
    for (int r = 0; r < 8; ++r) rli[8 * c8 + r] = wsf[32 + crow(8 * c8 + r, hi)];
    asm volatile("s_waitcnt lgkmcnt(0)" ::: "memory"); }
  #pragma unroll
  for (int r = 0; r < 16; ++r) rli[r] = __builtin_amdgcn_rcpf(rli[r]);
  bf16_t* Ow = Op + (long)(wid * QBLK) * PO;
  { LAS bf16_t* stg = (LAS bf16_t*)((LAS char*)shm) + wid * (32 * 64 * NV);
    #pragma unroll
    for (int r = 0; r < 16; ++r) { const int orow = crow(r, hi);
      #pragma unroll
      for (int d0 = 0; d0 < ND; ++d0) stg[orow * (64 * NV) + d0 * 32 + r32] = (bf16_t)(cvtpk_s(o[d0][r] * rli[r], 0.f) & 0xffffu); }
    asm volatile("s_waitcnt lgkmcnt(0)" ::: "memory");
    constexpr int CPR = 8 * NV, RPI = 64 / CPR;
    if (NV == 2 && O1p != nullptr) {
      const bf16_t* O1w = O1p + (long)(wid * QBLK) * PO; const int ch = lane % CPR;
      float gv[8];
      { const f32x4 ga = *(const f32x4*)(gsub + ch * 8), gb = *(const f32x4*)(gsub + ch * 8 + 4);
        gv[0] = ga[0] * post; gv[1] = ga[1] * post; gv[2] = ga[2] * post; gv[3] = ga[3] * post; gv[4] = gb[0] * post; gv[5] = gb[1] * post; gv[6] = gb[2] * post; gv[7] = gb[3] * post; }
      #pragma unroll
      for (int i = 0; i < 32 / RPI; ++i) { const int row = i * RPI + lane / CPR;
        const u32x4 q = *(const LAS u32x4*)(stg + row * (64 * NV) + ch * 8); const u32x4 p = *(const u32x4*)(O1w + (long)row * PO + ch * 8);
        float x[8];
        x[0] = bf_lo(p.x) - lam * bf_lo(q.x); x[1] = bf_hi(p.x) - lam * bf_hi(q.x); x[2] = bf_lo(p.y) - lam * bf_lo(q.y); x[3] = bf_hi(p.y) - lam * bf_hi(q.y);
        x[4] = bf_lo(p.z) - lam * bf_lo(q.z); x[5] = bf_hi(p.z) - lam * bf_hi(q.z); x[6] = bf_lo(p.w) - lam * bf_lo(q.w); x[7] = bf_hi(p.w) - lam * bf_hi(q.w);
        float ss = 0.f;
        #pragma unroll
        for (int k = 0; k < 8; ++k) ss += x[k] * x[k];
        #pragma unroll
        for (int sh = 1; sh < 16; sh <<= 1) ss += __int_as_float(__builtin_amdgcn_ds_bpermute((lane ^ sh) << 2, __float_as_int(ss)));
        const float rn = 1.0f / sqrtf(ss * (1.0f / 128.0f) + SUBLN_EPS);
        u32x4 w; w.x = cvtpk_s(x[0] * rn * gv[0], x[1] * rn * gv[1]); w.y = cvtpk_s(x[2] * rn * gv[2], x[3] * rn * gv[3]);
        w.z = cvtpk_s(x[4] * rn * gv[4], x[5] * rn * gv[5]); w.w = cvtpk_s(x[6] * rn * gv[6], x[7] * rn * gv[7]);
        *(u32x4*)(Ow + (long)row * PO + ch * 8) = w; }
    } else {
    #pragma unroll
    for (int i = 0; i < 32 / RPI; ++i) { const int row = i * RPI + lane / CPR, ch = lane % CPR; const u32x4 v = *(const LAS u32x4*)(stg + row * (64 * NV) + ch * 8); *(u32x4*)(Ow + (long)row * PO + ch * 8) = v; } } }
  asm volatile("s_waitcnt lgkmcnt(0)\n\ts_barrier" ::: "memory");
  #undef DMA_K
  #undef DMA_V
}
#undef SBAR
#undef WAIT_BAR
#undef MX3
}
#ifndef XC_SLOT
#define XC_SLOT(b) (2)
#endif
constexpr size_t MiB = 1u << 20;
constexpr size_t WS_CTL = 0, CTL_ZERO_BYTES = 1 * MiB;
constexpr size_t WS_MOD = 1 * MiB;
constexpr size_t WS_LAM = WS_MOD + 512 * 1024;
constexpr size_t WS_WIN = 2 * MiB;
constexpr size_t WS_WOA = 20 * MiB, WS_WOB = 22 * MiB;
constexpr size_t WS_WR = 24 * MiB;
constexpr size_t WS_WGU = 32 * MiB;
constexpr size_t WS_WD = 288 * MiB;
constexpr size_t WS_H = 416 * MiB;
constexpr size_t WS_P = 480 * MiB;
constexpr size_t WS_OA = 752 * MiB, WS_OD = 784 * MiB, WS_OB = 848 * MiB;
constexpr size_t WS_YA = 880 * MiB, WS_Y = 944 * MiB;
constexpr size_t WS_LOG = 1008 * MiB;
constexpr size_t WS_LIST = 1012 * MiB;
constexpr size_t WS_WSLOT = 1016 * MiB;
constexpr size_t WS_LISTW = 1017 * MiB;
constexpr size_t WS_ACT = 1024 * MiB;
constexpr size_t WS_YS = 1296 * MiB;
constexpr size_t WS_SPOS = 1021 * MiB;
constexpr size_t WS_H8 = 1568 * MiB;
constexpr size_t WS_H8M = 1600 * MiB;
constexpr size_t WS_WIN8 = 14 * MiB;
constexpr size_t WS_END = 1632 * MiB;
static_assert((size_t)ACT_ROWS * D * 2 <= WS_H8 - WS_YS && (size_t)ACT_ROWS * FF * 2 <= WS_YS - WS_ACT && (size_t)M * INW * 2 <= WS_OA - WS_P, "ws map");
constexpr int CW_BAR = 4096;
constexpr int CW_CNT = 8192;
constexpr int CW_Q = 16384;

constexpr int RING_OFF = 0, RING_BYTES = 131072;
constexpr int LDSCTL_OFF = RING_BYTES;
constexpr int LW_TOFF = 64, LW_CL = 128, LW_LCNT = 192, LW_LBASE = 256, LW_QK = 320;
constexpr int LDS_BYTES = 147456;
static_assert(attn_body::LDS_BYTES <= RING_BYTES && pg8::STAGE_BYTES <= RING_BYTES, "ring");

#define RLX_AGENT __ATOMIC_RELAXED, __HIP_MEMORY_SCOPE_AGENT
#define LDS_WAIT() asm volatile("s_waitcnt lgkmcnt(0)" ::: "memory")
__device__ __forceinline__ unsigned f2bf(float f) { unsigned u = __builtin_bit_cast(unsigned, f); return (u + 0x7fffu + ((u >> 16) & 1u)) >> 16; }
__device__ __forceinline__ unsigned pk2(float lo, float hi) { return f2bf(lo) | (f2bf(hi) << 16); }

#define XB_TMO      128
#define XB_XCNT(j)  (256  + 64 * (j))
#define XB_XSUB(j)  (1280 + 64 * (j))
#define XB_XGEN(j)  (2304 + 64 * (j))
#define XB_TOP      3328
#define XB_TOPGEN   3392
#define XCD_BAR_WORDS 3456
#define XB_SPIN_CAP (1u << 18)
__device__ __forceinline__ unsigned xb_ld(unsigned* p)              { return __hip_atomic_load(p, __ATOMIC_RELAXED, __HIP_MEMORY_SCOPE_AGENT); }
__device__ __forceinline__ unsigned xb_add(unsigned* p, unsigned v) { return __hip_atomic_fetch_add(p, v, __ATOMIC_RELAXED, __HIP_MEMORY_SCOPE_AGENT); }
__device__ __forceinline__ unsigned xb_xcc_id() { return (unsigned)__builtin_amdgcn_s_getreg((3 << 11) | 20) & 0xFu; }
#define XB_SPIN(cond, bar) do { unsigned _sp = 0; while (cond) { __builtin_amdgcn_s_sleep(1); \
    if ((++_sp & 255u) == 0u) { if (xb_ld(&(bar)[XB_TMO])) break; if (_sp > XB_SPIN_CAP) { atomicAdd(&(bar)[XB_TMO], 1u); break; } } } } while (0)
struct XcdBarrier { unsigned* bar; unsigned x; volatile LAS unsigned* st; };
__device__ __forceinline__ XcdBarrier xcd_barrier_post(unsigned* bar, volatile LAS unsigned* st) {
    XcdBarrier b; b.bar = bar; b.x = xb_xcc_id(); b.st = st;
    if (threadIdx.x == 0) (void)xb_add(&bar[XB_XCNT(b.x)], 1u);
    return b;
}
__device__ __forceinline__ void xcd_barrier_complete(unsigned* bar, unsigned x, unsigned& nloc, unsigned& nx) {
    const unsigned G = gridDim.x * gridDim.y * gridDim.z;
    unsigned sum, cnt, mine, sp = 0u;
    for (;;) {
        sum = 0u; cnt = 0u; mine = 0u;
#pragma unroll
        for (unsigned j = 0; j < 16; ++j) { const unsigned c = xb_ld(&bar[XB_XCNT(j)]); sum += c; cnt += (c > 0u) ? 1u : 0u; mine = (j == x) ? c : mine; }
        if (sum == G) break;
        __builtin_amdgcn_s_sleep(1);
        if ((++sp & 255u) == 0u) { if (xb_ld(&bar[XB_TMO])) break; if (sp > XB_SPIN_CAP) { atomicAdd(&bar[XB_TMO], 1u); break; } }
    }
    nloc = mine > 0u ? mine : 1u; nx = cnt > 0u ? cnt : 1u;
}
__device__ __forceinline__ void xcd_barrier(const XcdBarrier& b) {
    asm volatile("s_waitcnt vmcnt(0)" ::: "memory");
    __syncthreads();
    if (threadIdx.x == 0) {
        unsigned* bar = b.bar; unsigned bx_ = b.x;
        asm volatile("" : "+s"(bar), "+s"(bx_));
        __builtin_amdgcn_s_waitcnt(0);
        unsigned nloc = b.st[0], nx = b.st[1];
        if (nloc == 0u) { xcd_barrier_complete(bar, bx_, nloc, nx); b.st[0] = nloc; b.st[1] = nx; }
        const unsigned old = xb_add(&bar[XB_XSUB(bx_)], 1u);
        const unsigned gen = old / nloc;
        if (old + 1u == (gen + 1u) * nloc) {
            __builtin_amdgcn_fence(__ATOMIC_RELEASE, "agent");
            asm volatile("s_waitcnt vmcnt(0)" ::: "memory");
            const unsigned og = xb_add(&bar[XB_TOP], 1u);
            const unsigned tg = og / nx;
            if (og + 1u == (tg + 1u) * nx) xb_add(&bar[XB_TOPGEN], 1u);
            else XB_SPIN(xb_ld(&bar[XB_TOPGEN]) == tg, bar);
            __builtin_amdgcn_fence(__ATOMIC_ACQUIRE, "agent");
            xb_add(&bar[XB_XGEN(bx_)], 1u);
            asm volatile("s_waitcnt vmcnt(0)" ::: "memory");
        } else {
            XB_SPIN(xb_ld(&bar[XB_XGEN(bx_)]) == gen, bar);
            __builtin_amdgcn_fence(__ATOMIC_ACQUIRE, "agent");
            asm volatile("s_waitcnt vmcnt(0)" ::: "memory");
        }
    }
    __syncthreads();
}

struct Args { const float* in[20]; float* out; unsigned char* ws; };
typedef const __attribute__((address_space(4))) Args* CArgs;
__device__ __forceinline__ CArgs launder(CArgs p) { asm volatile("" : "+s"(p)); return p; }
__device__ __forceinline__ Args load_args(CArgs p) { Args a;
#pragma unroll
    for (int i = 0; i < 20; ++i) a.in[i] = p->in[i];
    a.out = p->out; a.ws = p->ws; return a; }
constexpr int NWAVES = 8;
__device__ __forceinline__ int tid_now() { int t = threadIdx.x; asm volatile("" : "+v"(t)); return t; }
__device__ __forceinline__ float shfl_xor_l(float v, int o, int lane) { return __int_as_float(__builtin_amdgcn_ds_bpermute((lane ^ o) << 2, __float_as_int(v))); }
__device__ __forceinline__ float wave_sum(float v, int lane) {
#pragma unroll
    for (int o = 1; o < 64; o <<= 1) v += shfl_xor_l(v, o, lane);
    return v;
}
__device__ __forceinline__ float lam_init_of(int l) { return 0.8f - 0.6f * expf(-0.3f * (float)l); }
__device__ __forceinline__ int t5_bucket(int n) {
    if (n < 16) return n;
    const float v = logf((float)n / 16.0f) / 2.0794415416798357f * 16.0f;
    const int lg = 16 + (int)v; return lg < 31 ? lg : 31;
}
__device__ __forceinline__ void p0_transpose_item(const float* W, int K, int N, bf16_t* WT, int drow0, float scale, LAS float* scr, int kb, int nb, int lane) {
    const int k0 = 64 * kb, n0 = 32 * nb;
#pragma unroll 8
    for (int i = 0; i < 32; ++i) { const int kk = 2 * i + (lane >> 5); scr[kk * 33 + (lane & 31)] = W[(size_t)(k0 + kk) * N + n0 + (lane & 31)] * scale; }
    LDS_WAIT(); asm volatile("" ::: "memory");
    const int c = lane & 7;
#pragma unroll
    for (int j = 0; j < 4; ++j) { const int n = (lane >> 3) + 8 * j; const LAS float* s = scr + (8 * c) * 33 + n;
        u32x4 o; o.x = pk2(s[0 * 33], s[1 * 33]); o.y = pk2(s[2 * 33], s[3 * 33]); o.z = pk2(s[4 * 33], s[5 * 33]); o.w = pk2(s[6 * 33], s[7 * 33]);
        *(u32x4*)(WT + (size_t)(drow0 + n) * K + k0 + 8 * c) = o; }
    LDS_WAIT(); asm volatile("" ::: "memory");
}

__device__ __forceinline__ void p0_transpose64(const float* W, int K, int N, bf16_t* WT, int drow0, float scale, LAS unsigned* scr, int kb, int nb, int lane) {
    const int k0 = 64 * kb, n0 = 64 * nb, q = lane & 15, kk = lane >> 4;
    f32x4 v[16];
#pragma unroll
    for (int t = 0; t < 16; ++t) { const int k = 8 * (t >> 1) + 2 * kk + (t & 1); v[t] = *(const f32x4*)(W + (size_t)(k0 + k) * N + n0 + 4 * q); }
#pragma unroll
    for (int u = 0; u < 8; ++u)
#pragma unroll
        for (int i = 0; i < 4; ++i) scr[(4 * q + i) * 33 + 4 * u + kk] = cvt_pk_bf16(v[2 * u][i] * scale, v[2 * u + 1][i] * scale);
    LDS_WAIT(); asm volatile("" ::: "memory");
    const int nr = lane >> 3, c = lane & 7;
#pragma unroll
    for (int p = 0; p < 8; ++p) { const int n = 8 * p + nr; const LAS unsigned* s_ = scr + n * 33 + 4 * c;
        u32x4 o; o.x = s_[0]; o.y = s_[1]; o.z = s_[2]; o.w = s_[3];
        *(u32x4*)(WT + (size_t)(drow0 + n) * K + k0 + 8 * c) = o; }
    LDS_WAIT(); asm volatile("" ::: "memory");
}

template <bool NTL = false>
__device__ __forceinline__ void p0_transpose64_f8(const float* W, int K, int N, unsigned char* WT, int drow0, float scale, LAS unsigned* scr, int kb, int nb, int lane) {
    const int k0 = 64 * kb, n0 = 64 * nb, q = lane & 15, kk = lane >> 4;
    f32x4 v[16];
#pragma unroll
    for (int t = 0; t < 16; ++t) { const int k = 16 * (t >> 2) + 4 * kk + (t & 3); const f32x4* p_ = (const f32x4*)(W + (size_t)(k0 + k) * N + n0 + 4 * q); v[t] = NTL ? __builtin_nontemporal_load(p_) : *p_; }
#pragma unroll
    for (int u = 0; u < 4; ++u)
#pragma unroll
        for (int i = 0; i < 4; ++i) scr[(4 * q + i) * 17 + 4 * u + kk] = pk4_fp8(v[4 * u][i] * scale, v[4 * u + 1][i] * scale, v[4 * u + 2][i] * scale, v[4 * u + 3][i] * scale);
    LDS_WAIT(); asm volatile("" ::: "memory");
    const int nr = lane >> 2, c = lane & 3;
#pragma unroll
    for (int p = 0; p < 4; ++p) { const int n = 16 * p + nr; const LAS unsigned* s_ = scr + n * 17 + 4 * c;
        u32x4 o; o.x = s_[0]; o.y = s_[1]; o.z = s_[2]; o.w = s_[3];
        *(u32x4*)(WT + (size_t)(drow0 + n) * K + k0 + 16 * c) = o; }
    LDS_WAIT(); asm volatile("" ::: "memory");
}

template <int MODE>
__device__ __forceinline__ void row_pass(CArgs ap, int l, int vcu, int G, const LAS int* toffl = nullptr) {
    ap = launder(ap); const int tid_ = tid_now(), lane = tid_ & 63, wave = __builtin_amdgcn_readfirstlane(tid_ >> 6); const Args a = load_args(ap);
    unsigned char* ws = a.ws;
    const float* mod = (const float*)(ws + WS_MOD);
    const bf16_t* Y = (const bf16_t*)(ws + WS_Y); const bf16_t* YS = (const bf16_t*)(ws + WS_YS); bf16_t* H = (bf16_t*)(ws + WS_H);
    const float* xin = (MODE == 0 || (MODE == 1 && l == 0)) ? a.in[0] : a.out;
    const bool need_h = (MODE != 2) || (l + 1 < DEPTH);
    const int lh = (MODE == 2) ? l + 1 : l;
    const float* gpre = (MODE == 1) ? a.in[7] + (size_t)l * D : a.in[5] + (size_t)(lh < DEPTH ? lh : 0) * D;
    const float* gpost = (MODE == 1) ? a.in[6] + (size_t)l * D : a.in[8] + (size_t)l * D;
    const int gw = vcu * NWAVES + wave, NGW = G * NWAVES, RPW = (M + NGW - 1) / NGW;
    int m0 = gw * RPW, m1 = m0 + RPW; if (m1 > M) m1 = M;
    f32x4 a_r[4], a_h[4], s_h[4]; int curb = -1;
#ifndef ROWS_PER_STEP
#define ROWS_PER_STEP 2
#endif
    constexpr int RR = ROWS_PER_STEP;
    for (int mb_ = m0; mb_ < m1; mb_ += RR) {
        const int b = mb_ / SEQ;
        if (b != curb) { curb = b;
            const float* mb = mod + (size_t)((l * BATCH + b) * 6) * D; const float* mh = mod + (size_t)(((lh < DEPTH ? lh : 0) * BATCH + b) * 6) * D;
#pragma unroll
            for (int j = 0; j < 4; ++j) { const int c = 4 * lane + 256 * j;
                if (MODE == 1) { a_r[j] = *(const f32x4*)(mb + 2 * D + c) * *(const f32x4*)(gpost + c); a_h[j] = *(const f32x4*)(gpre + c) * (*(const f32x4*)(mb + 4 * D + c) + 1.0f); s_h[j] = *(const f32x4*)(mb + 3 * D + c); }
                else { if (MODE == 2) a_r[j] = *(const f32x4*)(mb + 5 * D + c) * *(const f32x4*)(gpost + c);
                       a_h[j] = *(const f32x4*)(gpre + c) * (*(const f32x4*)(mh + 1 * D + c) + 1.0f); s_h[j] = *(const f32x4*)(mh + 0 * D + c); } } }
        f32x4 xv[RR][4], yv[RR][4]; int mrow[RR];
#pragma unroll
        for (int r = 0; r < RR; ++r) { mrow[r] = (mb_ + r < m1) ? mb_ + r : m1 - 1;
#pragma unroll
            for (int j = 0; j < 4; ++j) xv[r][j] = *(const f32x4*)(xin + (size_t)mrow[r] * D + 4 * lane + 256 * j); }
        if (MODE != 0) {
            if (MODE == 1) {
#pragma unroll
                for (int r = 0; r < RR; ++r)
#pragma unroll
                    for (int j = 0; j < 4; ++j) { const u32x2 w = *(const u32x2*)(Y + (size_t)mrow[r] * D + 4 * lane + 256 * j); yv[r][j] = (f32x4){bf_lo(w.x), bf_hi(w.x), bf_lo(w.y), bf_hi(w.y)}; }
            } else {
                u32x4 sp[RR];
#pragma unroll
                for (int r = 0; r < RR; ++r) sp[r] = *(const u32x4*)(ws + WS_SPOS + (size_t)mrow[r] * TOPK * 4);
                unsigned w8[RR][TOPK][4];
#pragma unroll
                for (int r = 0; r < RR; ++r) { int srow[TOPK];
                    srow[0] = toffl[sp[r].x >> 16] * 256 + (int)(sp[r].x & 0xffffu); srow[1] = toffl[sp[r].y >> 16] * 256 + (int)(sp[r].y & 0xffffu);
                    srow[2] = toffl[sp[r].z >> 16] * 256 + (int)(sp[r].z & 0xffffu); srow[3] = toffl[sp[r].w >> 16] * 256 + (int)(sp[r].w & 0xffffu);
#pragma unroll
                    for (int k = 0; k < TOPK; ++k)
#pragma unroll
                        for (int j = 0; j < 4; ++j) w8[r][k][j] = *(const unsigned*)((const unsigned char*)YS + (size_t)srow[k] * D + 4 * lane + 256 * j); }
#pragma unroll
                for (int r = 0; r < RR; ++r)
#pragma unroll
                    for (int j = 0; j < 4; ++j) { yv[r][j] = (f32x4){0.f, 0.f, 0.f, 0.f};
#pragma unroll
                        for (int k = 0; k < TOPK; ++k) { const auto lo2 = __builtin_amdgcn_cvt_pk_f32_fp8(w8[r][k][j], false), hi2 = __builtin_amdgcn_cvt_pk_f32_fp8(w8[r][k][j], true); yv[r][j] += (f32x4){lo2[0], lo2[1], hi2[0], hi2[1]}; }
                        yv[r][j] = yv[r][j] * (1.0f / F8_SY); }
            }
            float ss[RR];
#pragma unroll
            for (int r = 0; r < RR; ++r) { ss[r] = 0.f;
#pragma unroll
                for (int j = 0; j < 4; ++j) ss[r] += (yv[r][j].x * yv[r][j].x + yv[r][j].y * yv[r][j].y) + (yv[r][j].z * yv[r][j].z + yv[r][j].w * yv[r][j].w); }
#pragma unroll
            for (int r = 0; r < RR; ++r) { const float rn = 1.0f / sqrtf(wave_sum(ss[r], lane) * (1.0f / D) + NORM_EPS);
#pragma unroll
                for (int j = 0; j < 4; ++j) { xv[r][j] = xv[r][j] + a_r[j] * (yv[r][j] * rn); *(f32x4*)(a.out + (size_t)mrow[r] * D + 4 * lane + 256 * j) = xv[r][j]; } }
        }
        if (need_h) {
            float ss[RR];
#pragma unroll
            for (int r = 0; r < RR; ++r) { ss[r] = 0.f;
#pragma unroll
                for (int j = 0; j < 4; ++j) ss[r] += (xv[r][j].x * xv[r][j].x + xv[r][j].y * xv[r][j].y) + (xv[r][j].z * xv[r][j].z + xv[r][j].w * xv[r][j].w); }
#pragma unroll
            for (int r = 0; r < RR; ++r) { const float rn = 1.0f / sqrtf(wave_sum(ss[r], lane) * (1.0f / D) + NORM_EPS);
#pragma unroll
                for (int j = 0; j < 4; ++j) { const f32x4 h = (xv[r][j] * rn) * a_h[j] + s_h[j]; u32x2 w; w.x = cvt_pk_bf16(h.x, h.y); w.y = cvt_pk_bf16(h.z, h.w);
                    *(u32x2*)(H + (size_t)mrow[r] * D + 4 * lane + 256 * j) = w;
                    *(unsigned*)(ws + (MODE == 1 ? WS_H8 : WS_H8M) + (size_t)mrow[r] * D + 4 * lane + 256 * j) = pk4_fp8(h.x * F8_SH, h.y * F8_SH, h.z * F8_SH, h.w * F8_SH); } }
        }
    }
}

__device__ __forceinline__ void diff_combine(CArgs ap, int l, int vcu, int G) {
    ap = launder(ap); const int tid_ = tid_now(), lane = tid_ & 63, wave = __builtin_amdgcn_readfirstlane(tid_ >> 6);
    unsigned char* ws = ap->ws; struct { const float* in[14]; } a; a.in[13] = ap->in[13];
    const bf16_t* O1 = (const bf16_t*)(ws + WS_OD); const bf16_t* O2 = O1 + (size_t)M * 512; bf16_t* OB = (bf16_t*)(ws + WS_OB);
    const float lam = ((const float*)(ws + WS_LAM))[l]; const float post = 1.0f - lam_init_of(l);
    const float* g = a.in[13] + (size_t)l * 128 + (8 * lane) % 128;
    float gv[8];
#pragma unroll
    for (int i = 0; i < 8; ++i) gv[i] = g[i] * post;
    const int gw = vcu * NWAVES + wave, NGW = G * NWAVES;
    for (int m = gw; m < M; m += NGW) {
        const u32x4 p = *(const u32x4*)(O1 + (size_t)m * 512 + 8 * lane), q = *(const u32x4*)(O2 + (size_t)m * 512 + 8 * lane);
        float o[8];
        o[0] = bf_lo(p.x) - lam * bf_lo(q.x); o[1] = bf_hi(p.x) - lam * bf_hi(q.x); o[2] = bf_lo(p.y) - lam * bf_lo(q.y); o[3] = bf_hi(p.y) - lam * bf_hi(q.y);
        o[4] = bf_lo(p.z) - lam * bf_lo(q.z); o[5] = bf_hi(p.z) - lam * bf_hi(q.z); o[6] = bf_lo(p.w) - lam * bf_lo(q.w); o[7] = bf_hi(p.w) - lam * bf_hi(q.w);
        float ss = 0.f;
#pragma unroll
        for (int i = 0; i < 8; ++i) ss += o[i] * o[i];
        ss += shfl_xor_l(ss, 1, lane); ss += shfl_xor_l(ss, 2, lane); ss += shfl_xor_l(ss, 4, lane); ss += shfl_xor_l(ss, 8, lane);
        const float r = 1.0f / sqrtf(ss * (1.0f / 128.0f) + SUBLN_EPS);
        u32x4 w; w.x = cvt_pk_bf16(o[0] * r * gv[0], o[1] * r * gv[1]); w.y = cvt_pk_bf16(o[2] * r * gv[2], o[3] * r * gv[3]);
        w.z = cvt_pk_bf16(o[4] * r * gv[4], o[5] * r * gv[5]); w.w = cvt_pk_bf16(o[6] * r * gv[6], o[7] * r * gv[7]);
        *(u32x4*)(OB + (size_t)m * 512 + 8 * lane) = w;
    }
}

__device__ __forceinline__ void topk_lists(CArgs ap, int l, int G, volatile LAS unsigned* LW) {
    ap = launder(ap);
    unsigned char* ws = ap->ws;
    const float* LOG = (const float*)(ws + WS_LOG); int* LIST = (int*)(ws + WS_LIST); float* WSLOT = (float*)(ws + WS_WSLOT);
    unsigned* CNT = (unsigned*)(ws + WS_CTL) + CW_CNT + l * NE;
    int tid = threadIdx.x; asm volatile("" : "+v"(tid)); const int TPW = (M + G - 1) / G;
    for (int base = blockIdx.x * TPW, done = 0; done < TPW; done += 512) {
        if (tid < NE) LW[LW_LCNT + tid] = 0u;
        __syncthreads();
        const int m = base + done + tid; const bool act = (done + tid < TPW) && (m < M);
        int ek[TOPK]; float wk[TOPK]; unsigned lp[TOPK];
        if (act) {
            float v[NE];
#pragma unroll
            for (int q = 0; q < NE / 4; ++q) { const f32x4 t = *(const f32x4*)(LOG + (size_t)m * NE + 4 * q); v[4 * q] = t.x; v[4 * q + 1] = t.y; v[4 * q + 2] = t.z; v[4 * q + 3] = t.w; }
            unsigned taken = 0u;
#pragma unroll
            for (int k = 0; k < TOPK; ++k) { float best = -INFINITY; int bi = 0;
#pragma unroll
                for (int e = 0; e < NE; ++e) { const bool ok = !((taken >> e) & 1u) && (v[e] > best); best = ok ? v[e] : best; bi = ok ? e : bi; }
                taken |= 1u << bi; ek[k] = bi; wk[k] = best; }
            float s = 0.f; const float mx = wk[0];
#pragma unroll
            for (int k = 0; k < TOPK; ++k) { wk[k] = expf(wk[k] - mx > -80.f ? wk[k] - mx : -80.f); s += wk[k]; }
#pragma unroll
            for (int k = 0; k < TOPK; ++k) { wk[k] = wk[k] / s; lp[k] = __hip_atomic_fetch_add((LAS unsigned*)&LW[LW_LCNT + ek[k]], 1u, __ATOMIC_RELAXED, __HIP_MEMORY_SCOPE_WORKGROUP); }
        }
        __syncthreads();
        if (tid < NE) { const unsigned c = LW[LW_LCNT + tid]; LW[LW_LBASE + tid] = c ? __hip_atomic_fetch_add(CNT + tid, c, RLX_AGENT) : 0u; }
        __syncthreads();
        if (act) {
#pragma unroll
            for (int k = 0; k < TOPK; ++k) { const unsigned pos = LW[LW_LBASE + ek[k]] + lp[k]; __hip_atomic_store(LIST + (size_t)ek[k] * CAP + pos, m * TOPK + k, RLX_AGENT);
                __hip_atomic_store((float*)(ws + WS_LISTW) + (size_t)ek[k] * CAP + pos, wk[k], RLX_AGENT);
                ((unsigned*)(ws + WS_SPOS))[(size_t)m * TOPK + k] = ((unsigned)ek[k] << 16) | pos; }
        }
        __syncthreads();
    }
}

__device__ __forceinline__ void p0_prologue(CArgs ap, LAS unsigned char* lds, int vcu, int G) {
    ap = launder(ap); const Args a = load_args(ap);
    unsigned char* ws = a.ws; const int tid = tid_now(), lane = tid & 63, wave = __builtin_amdgcn_readfirstlane(tid >> 6);
    LAS float* ca = (LAS float*)(lds + RING_OFF); LAS float* red = (LAS float*)(lds + RING_OFF + 8192);
    for (int i = tid; i < BATCH * D; i += NWAVES * 64) { const float v = a.in[1][i]; ca[i] = v / (1.0f + expf(-v)); }
    __syncthreads();
    float* mod = (float*)(ws + WS_MOD);
    for (int it = blockIdx.x; it < DEPTH * (6 * D / 32); it += G) {
        const int l = it / (6 * D / 32), cg = it % (6 * D / 32), c = tid & 31, kc = tid >> 5;
        const float* w = a.in[3] + (size_t)l * D * 6 * D + cg * 32 + c;
        float s0 = 0.f, s1 = 0.f;
#pragma unroll 8
        for (int k = kc * 64; k < kc * 64 + 64; ++k) { const float wv = w[(size_t)k * 6 * D]; s0 += ca[k] * wv; s1 += ca[D + k] * wv; }
        red[(kc * 32 + c) * 2] = s0; red[(kc * 32 + c) * 2 + 1] = s1;
        __syncthreads();
        if (tid < 64) { const int cc = tid & 31, b = tid >> 5; float s = 0.f;
#pragma unroll
            for (int k = 0; k < 16; ++k) s += red[(k * 32 + cc) * 2 + b];
            mod[(size_t)(l * BATCH + b) * 6 * D + cg * 32 + cc] = s + a.in[4][(size_t)l * 6 * D + cg * 32 + cc]; }
        __syncthreads();
    }
    if (blockIdx.x == 0 && wave == 0) {
        for (int l = 0; l < DEPTH; ++l) { const float* lp = a.in[12] + (size_t)l * 256;
            const float s01 = wave_sum(lp[lane] * lp[64 + lane], lane), s23 = wave_sum(lp[128 + lane] * lp[192 + lane], lane);
            if (lane == 0) ((float*)(ws + WS_LAM))[l] = expf(s01) - expf(s23) + lam_init_of(l); }
    }
    { u32x4* z = (u32x4*)(ws + WS_WR); const u32x4 zero = {0u, 0u, 0u, 0u};
      for (int l = 0; l < DEPTH; ++l) for (int i = blockIdx.x * NWAVES * 64 + tid; i < 224 * D * 2 / 16; i += G * NWAVES * 64) z[(size_t)l * (256 * D * 2 / 16) + 32 * D * 2 / 16 + i] = zero; }
    LAS float* scr = (LAS float*)(lds + RING_OFF + wave * 16384); LAS unsigned* scru = (LAS unsigned*)scr;
    const int gw = vcu * NWAVES + wave, NGW = G * NWAVES;
    constexpr int I_IN = 16 * (INW / 64), I_O = 8 * (D / 64), I_R = 16, I_GU1 = 16 * (2 * FF / 64), I_GU = NE * I_GU1, I_D1 = 16 * (D / 64), I_DN = NE * I_D1;
    constexpr int I_LAYER = I_IN + 2 * I_O + I_R + I_GU + I_DN;
    for (int it = gw; it < DEPTH * I_LAYER; it += NGW) {
        const int l = it / I_LAYER; int r = it - l * I_LAYER;
        if (r < I_IN) { const int nblk = INW / 64, kb = r / nblk, nb = r % nblk, n0 = 64 * nb;
            const float sc = (n0 < C_KA || (n0 >= C_QB && n0 < C_KB)) ? QSCALE : 1.0f;
            if (n0 < C_GZA) p0_transpose64(a.in[9] + (size_t)l * D * INW, D, INW, (bf16_t*)(ws + WS_WIN) + (size_t)l * C_GZA * D, n0, sc, scru, kb, nb, lane);
            else p0_transpose64_f8(a.in[9] + (size_t)l * D * INW, D, INW, ws + WS_WIN8 + (size_t)l * (INW - C_GZA) * D, n0 - C_GZA, F8_SW, scru, kb, nb, lane);
            continue; }
        r -= I_IN;
        if (r < 2 * I_O) { const int half = r / I_O; r -= half * I_O; const int nblk = D / 64, kb = r / nblk, nb = r % nblk;
            p0_transpose64(a.in[10] + (size_t)l * D * D + (size_t)half * 512 * D, 512, D, (bf16_t*)(ws + (half ? WS_WOB : WS_WOA)) + (size_t)l * D * 512, 64 * nb, 1.0f, scru, kb, nb, lane); continue; }
        r -= 2 * I_O;
        if (r < I_R) { p0_transpose_item(a.in[14] + (size_t)l * D * NE, D, NE, (bf16_t*)(ws + WS_WR) + (size_t)l * 256 * D, 0, 1.0f, scr, r, 0, lane); continue; }
    }
}

__device__ __forceinline__ void expert_convert(CArgs ap, int l, LAS unsigned char* lds, int c, int G) {
    ap = launder(ap); const Args a = load_args(ap);
    unsigned char* ws = a.ws; const int tid = tid_now(), lane = tid & 63, wave = __builtin_amdgcn_readfirstlane(tid >> 6);
    LAS unsigned* scru = (LAS unsigned*)(lds + RING_OFF + wave * 4608);
    constexpr int I_GU1 = 16 * (2 * FF / 64), I_GU = NE * I_GU1, I_D1 = 16 * (D / 64), I_DN = NE * I_D1;
    const int gw = c * NWAVES + wave, NGW = G * NWAVES;
#pragma unroll 1
    for (int it = gw; it < I_GU + I_DN; it += NGW) { int r = it;
        if (r < I_GU) { const int e = r / I_GU1; r -= e * I_GU1; const int nblk = 2 * FF / 64, kb = r / nblk, nb = r % nblk, n0 = 64 * nb;
            const int j = n0 % FF, drow = (j / 128) * 256 + (n0 >= FF ? 128 : 0) + (j % 128);
            p0_transpose64_f8<true>(a.in[16] + ((size_t)l * NE + e) * D * 2 * FF, D, 2 * FF, ws + WS_WGU + ((size_t)l * NE + e) * 2 * FF * D, drow, F8_SW, scru, kb, nb, lane); continue; }
        r -= I_GU;
        { const int e = r / I_D1; r -= e * I_D1; const int nblk = D / 64, kb = r / nblk, nb = r % nblk;
            p0_transpose64_f8<true>(a.in[18] + ((size_t)l * NE + e) * FF * D, FF, D, ws + WS_WD + ((size_t)l * NE + e) * D * FF, 64 * nb, F8_SW, scru, kb, nb, lane); }
    }
    __syncthreads();
}

__device__ __forceinline__ void attn_fill_tab(const float* rel, int col, bool swa, LAS float* tab) {
    for (int j = tid_now(); j < attn_body::TAB_N; j += NWAVES * 64) {
        const int dist = j - 255; float v;
        if (dist < 0) v = -INFINITY;
        else if (swa) v = dist >= 128 ? -INFINITY : rel[t5_bucket(dist) * NBH + col] * LOG2E;
        else v = (rel[t5_bucket(dist < 127 ? dist : 127) * NBH + col] - rel[31 * NBH + col]) * LOG2E;
        tab[j] = v;
    }
}
#ifndef MK_ADBG
#define MK_ADBG 0
#endif
__device__ __forceinline__ void attn_phase(CArgs ap, int l, char* lds, int vcu, int G, int rep = 0) {
    ap = launder(ap);
    unsigned char* ws = ap->ws; struct { const float* in[14]; } a; a.in[2] = ap->in[2]; a.in[11] = ap->in[11]; a.in[13] = ap->in[13];
    const int dbg = rep ? MK_ADBG : 0;
    const bf16_t* P = (const bf16_t*)(ws + WS_P); bf16_t* OA = (bf16_t*)(ws + (rep ? WS_YA : WS_OA)); bf16_t* OD = (bf16_t*)(ws + (rep ? WS_YA + 32 * MiB : WS_OD)); bf16_t* OBo = (bf16_t*)(ws + (rep ? WS_Y : WS_OB));
    LAS float* tab = (LAS float*)((LAS char*)lds + attn_body::LDS_TAB);
    const float* rel = a.in[2];
    for (int v = vcu; v < 256; v += G) {
        const int u = v & 31, h = (v >> 5) & 3, b = v >> 7;
        attn_fill_tab(rel, HA + h, false, tab);
        const float lam = ((const float*)(ws + WS_LAM))[l], post = 1.0f - lam_init_of(l);
        const float* gsub = a.in[13] + (size_t)l * 128;
#pragma unroll 1
        for (int i = 0; i < 4; ++i) {
            const int mp = i & 1, qb = (i >> 1) ? u : 63 - u;
            const size_t row0 = (size_t)b * SEQ + (size_t)qb * 256;
            const bf16_t* Kp = P + (size_t)b * SEQ * PITCH + C_KB + h * 128 + mp * 64;
            const bf16_t* Vp = P + (size_t)b * SEQ * PITCH + C_VB + h * 128;
            bf16_t* O1 = OD + row0 * 512 + h * 128;
            attn_body::attn_unit<8, PITCH, 512, 2>(P + row0 * PITCH + C_QB + h * 128 + mp * 64, Kp, Vp, mp ? OBo + row0 * 512 + h * 128 : O1,
                                                   (dbg & 64) ? 4 : 4 * (qb + 1), -30.0f, -INFINITY, lds, dbg, mp ? O1 : nullptr, lam, gsub, post);
            if (!rep && i == XC_SLOT(blockIdx.x)) expert_convert(ap, l, (LAS unsigned char*)((LAS char*)lds - RING_OFF), blockIdx.x, G);
        }
        if (G == 256) {
            unsigned* Q = (unsigned*)(ws + WS_CTL) + CW_Q + (l * 2 + (rep ? 1 : 0)) * 8;
            volatile LAS unsigned* LWq = (volatile LAS unsigned*)((LAS char*)lds + LDSCTL_OFF - RING_OFF) + LW_QK;
            int qx = blockIdx.x & 7, tries = 0, cur_ha = -1, k0 = 0, kn = 0;
#pragma unroll 1
            for (;;) {
                if (k0 >= kn) {
                    if (tries >= 8) break;
                    const unsigned take = tries == 0 ? 2u : 1u;
                    if (tid_now() == 0) LWq[0] = __hip_atomic_fetch_add(Q + qx, take, RLX_AGENT);
                    __syncthreads(); k0 = (int)LWq[0]; __syncthreads();
                    kn = k0 + (int)take; kn = kn > 128 ? 128 : kn;
                    if (k0 >= 128) { qx = (qx + 1) & 7; ++tries; k0 = kn = 0; continue; }
                }
                const int id = qx * 128 + k0; ++k0;
                const int qb = id & 63, ha = (id >> 6) & 7, bb = id >> 9;
                if (ha != cur_ha) { attn_fill_tab(rel, ha, true, tab); cur_ha = ha; }
                const size_t row0 = (size_t)bb * SEQ + (size_t)qb * 256, krow = row0 - (qb ? 128 : 0);
                const float sink2 = a.in[11][l * HA + ha] * LOG2E;
                attn_body::attn_unit<8, PITCH, 512, 1>(P + row0 * PITCH + C_QA + ha * 64, P + krow * PITCH + C_KA + (ha >> 2) * 64, P + krow * PITCH + C_VA + (ha >> 2) * 64,
                                                       OA + row0 * 512 + ha * 64, qb ? 6 : 4, sink2, sink2, lds, dbg);
            }
        } else {
#pragma unroll 1
        for (int i = 0; i < 4; ++i) {
            const int id = v * 4 + i, qb = id & 63, ha = (id >> 6) & 7, bb = id >> 9;
            if (i == 0) attn_fill_tab(rel, ha, true, tab);
            const size_t row0 = (size_t)bb * SEQ + (size_t)qb * 256, krow = row0 - (qb ? 128 : 0);
            const float sink2 = a.in[11][l * HA + ha] * LOG2E;
            attn_body::attn_unit<8, PITCH, 512, 1>(P + row0 * PITCH + C_QA + ha * 64, P + krow * PITCH + C_KA + (ha >> 2) * 64, P + krow * PITCH + C_VA + (ha >> 2) * 64,
                                                   OA + row0 * 512 + ha * 64, qb ? 6 : 4, sink2, sink2, lds, dbg);
        } }
    }
}

#ifndef MK_PROBE
#define MK_PROBE 0
#endif
#ifndef MK_PFA
#define MK_PFA 0
#endif
constexpr bool PFA_ON = MK_PFA != 0;
#ifndef MK_DUP
#define MK_DUP 0
#endif
constexpr int CW_DIG = 12288;
__device__ __forceinline__ void probe_rows(CArgs ap, const bf16_t* base, int nrows_total, bool by_tile, const LAS int* toff, const LAS int* cl, int vcu, int G) {
    unsigned* DIG = (unsigned*)(launder(ap)->ws + WS_CTL) + CW_DIG;
    const int tid = tid_now(), lane = tid & 63, wave = tid >> 6;
    if (by_tile) {
        const int ntile = toff[NE];
        for (int gt = vcu; gt < ntile; gt += G) {
            int e = 0;
            for (int k = 16; k >= 1; k >>= 1) if (toff[e + k] <= gt) e += k;
            const int rt = gt - toff[e]; int nv = cl[e] - rt * 256; nv = nv > 256 ? 256 : nv;
            unsigned s = 0u;
            for (int r = wave; r < nv; r += NWAVES) { const u32x4* p = (const u32x4*)(base + ((size_t)gt * 256 + r) * 1024 + lane * 16); const u32x4 a = p[0], b = p[1];
                s += (a.x & 0xffffu) + (a.x >> 16) + (a.y & 0xffffu) + (a.y >> 16) + (a.z & 0xffffu) + (a.z >> 16) + (a.w & 0xffffu) + (a.w >> 16);
                s += (b.x & 0xffffu) + (b.x >> 16) + (b.y & 0xffffu) + (b.y >> 16) + (b.z & 0xffffu) + (b.z >> 16) + (b.w & 0xffffu) + (b.w >> 16); }
            __hip_atomic_fetch_add(DIG + e, s, RLX_AGENT);
        }
    } else {
        for (int r = vcu * NWAVES + wave; r < nrows_total; r += G * NWAVES) { const u32x4* p = (const u32x4*)(base + (size_t)r * 1024 + lane * 16); const u32x4 a = p[0], b = p[1];
            unsigned s = (a.x & 0xffffu) + (a.x >> 16) + (a.y & 0xffffu) + (a.y >> 16) + (a.z & 0xffffu) + (a.z >> 16) + (a.w & 0xffffu) + (a.w >> 16);
            s += (b.x & 0xffffu) + (b.x >> 16) + (b.y & 0xffffu) + (b.y >> 16) + (b.z & 0xffffu) + (b.z >> 16) + (b.w & 0xffffu) + (b.w >> 16);
            __hip_atomic_fetch_add(DIG + (r & 31), s, RLX_AGENT); }
    }
}
__device__ __forceinline__ void probe_lists(CArgs ap, int l, int vcu, int G) {
    unsigned char* ws = launder(ap)->ws; unsigned* DIG = (unsigned*)(ws + WS_CTL) + CW_DIG; const int* LIST = (const int*)(ws + WS_LIST);
    const int tid = tid_now();
    for (int e = vcu; e < NE; e += G) { const int cnt = (int)__hip_atomic_load((unsigned*)(ws + WS_CTL) + CW_CNT + l * NE + e, RLX_AGENT);
        unsigned s1 = 0u, s2 = 0u;
        for (int i = tid; i < cnt; i += NWAVES * 64) { const unsigned v = (unsigned)LIST[(size_t)e * CAP + i]; s1 += v; s2 += (v * 2654435761u) >> 9; }
        __hip_atomic_fetch_add(DIG + e, s1, RLX_AGENT); __hip_atomic_fetch_add(DIG + 32 + e, s2 + (unsigned)cnt * 7919u, RLX_AGENT); }
}
__device__ __forceinline__ void probe_dump(CArgs ap) {
    const CArgs aq = launder(ap); const unsigned* DIG = (const unsigned*)(aq->ws + WS_CTL) + CW_DIG; float* out = aq->out; const int tid = tid_now();
    if (blockIdx.x == 0 && tid < 64) out[tid] = (float)(__hip_atomic_load((unsigned*)DIG + tid, RLX_AGENT) & 0x7fffffu) * (1.0f / 65536.0f);
}

__device__ __forceinline__ void probe_region(CArgs ap, size_t off, size_t nwords, int G) {
    unsigned char* ws = launder(ap)->ws; unsigned* DIG = (unsigned*)(ws + WS_CTL) + CW_DIG; const unsigned* src = (const unsigned*)(ws + off);
    const int t = tid_now(); unsigned sacc = 0u;
    for (size_t i = (size_t)blockIdx.x * NWAVES * 64 + t; i < nwords; i += (size_t)G * NWAVES * 64) { const unsigned v = src[i]; sacc += (v & 0xffffu) + (v >> 16); }
    __hip_atomic_fetch_add(DIG + (t & 63), sacc, RLX_AGENT);
}
#define PROBE_AT(id, off, nwords) do { if (MK_PROBE == (id)) { probe_region(ap, off, nwords, G); GRID_BAR(); probe_dump(ap); return; } } while (0)

__global__ void __launch_bounds__(NWAVES * 64, 2) mk_fwd(Args a) {
    extern __shared__ __attribute__((aligned(16))) unsigned char lds_raw[];
    LAS unsigned char* lds = (LAS unsigned char*)lds_raw;
    volatile LAS unsigned* LW = (volatile LAS unsigned*)(lds + LDSCTL_OFF);
    const int tid = tid_now();
    const int G = gridDim.x; const int bx = blockIdx.x; const int vcu = (G % 8 == 0) ? (bx % 8) * (G / 8) + bx / 8 : bx;
    const CArgs ap = (CArgs)__builtin_amdgcn_kernarg_segment_ptr();
    for (int u = tid; u < (LDS_BYTES - LDSCTL_OFF) / 4; u += NWAVES * 64) ((LAS unsigned*)(lds + LDSCTL_OFF))[u] = 0u;
    __syncthreads();
    XcdBarrier bar = xcd_barrier_post((unsigned*)(ap->ws + WS_CTL) + CW_BAR, LW + 8);
#define GRID_BAR() xcd_barrier(bar)

#ifndef PH_MASK
#define PH_MASK 0xFFFF
#endif
#define PH(k) ((PH_MASK >> (k)) & 1)
#pragma unroll 1
    for (int rep = 0; rep < ((MK_DUP & 1) ? 2 : 1); ++rep) {
    if (PH(0)) p0_prologue(ap, lds, vcu, G);
    GRID_BAR(); }
    PROBE_AT(10, WS_MOD, (size_t)DEPTH * BATCH * 6 * D);
    PROBE_AT(11, WS_WIN, (size_t)DEPTH * INW * D / 2);
    PROBE_AT(12, WS_WOA, (size_t)4 * MiB / 4);
    if (PH(0)) row_pass<0>(ap, 0, vcu, G);
    GRID_BAR();
    PROBE_AT(13, WS_H, (size_t)M * D / 2);

#pragma unroll 1
    for (int l = 0; l < DEPTH; ++l) {
#pragma unroll 1
        for (int rep = 0; rep < ((MK_DUP & 2) ? 2 : 1); ++rep) {
        if (PH(1)) { unsigned char* ws = launder(ap)->ws; bf16_t* H = (bf16_t*)(ws + WS_H); bf16_t* P = (bf16_t*)(ws + WS_P);
          { pg8::Gemm g{H, (const bf16_t*)(ws + WS_WIN) + (size_t)l * C_GZA * D, D, 0, nullptr}; pg8::StaticOrder S; S.init(M, C_GZA, G, bx);
            pg8::EpiBf16 E{P, PITCH, 1.0f};
            pg8::gemm_phase<pg8::EpiBf16, pg8::StaticOrder, false, true>(lds + RING_OFF, g, S, E); }
          { pg8::Gemm g{(const bf16_t*)(ws + WS_H8M), (const bf16_t*)(ws + WS_WIN8 + (size_t)l * (INW - C_GZA) * D), D / 2, 0, nullptr}; pg8::StaticOrder S; S.init(M, INW - C_GZA, G, bx, 1);
            pg8::EpiBf16 E{P + C_GZA, PITCH, 1.0f / (F8_SH * F8_SW)};
            pg8::gemm_phase<pg8::EpiBf16, pg8::StaticOrder, false, true, true>(lds + RING_OFF, g, S, E); } }
        GRID_BAR(); }
        PROBE_AT(14, WS_P, (size_t)M * INW / 2);
#pragma unroll 1
        for (int rep = 0; rep < ((MK_DUP & 4) ? 2 : 1); ++rep) {
        if (PH(2)) attn_phase(ap, l, (char*)lds_raw + RING_OFF, vcu, G, rep);
        GRID_BAR(); }
        PROBE_AT(15, WS_OA, (size_t)M * 512 / 2);
        PROBE_AT(16, WS_OD, (size_t)M * 512);
        PROBE_AT(17, WS_OB, (size_t)M * 512 / 2);
        if (PH(4)) { unsigned char* ws = launder(ap)->ws; bf16_t* P = (bf16_t*)(ws + WS_P); pg8::Gemm g{(const bf16_t*)(ws + WS_OA), (const bf16_t*)(ws + WS_WOA) + (size_t)l * D * 512, 512, 0, nullptr}; pg8::StaticOrder S; S.init(M, D, G, bx);
          pg8::EpiGate<true> E{(bf16_t*)(ws + WS_YA), nullptr, P, C_GZA};
          pg8::gemm_phase<pg8::EpiGate<true>, pg8::StaticOrder, false, true>(lds + RING_OFF, g, S, E); }
        GRID_BAR();
        PROBE_AT(18, WS_YA, (size_t)M * D / 2);
        if (PH(5)) { unsigned char* ws = launder(ap)->ws; bf16_t* P = (bf16_t*)(ws + WS_P); pg8::Gemm g{(const bf16_t*)(ws + WS_OB), (const bf16_t*)(ws + WS_WOB) + (size_t)l * D * 512, 512, 0, nullptr}; pg8::StaticOrder S; S.init(M, D, G, bx);
          pg8::EpiGate<false> E{(bf16_t*)(ws + WS_Y), (const bf16_t*)(ws + WS_YA), P, C_GZB};
          pg8::gemm_phase<pg8::EpiGate<false>, pg8::StaticOrder, false, true>(lds + RING_OFF, g, S, E); }
        GRID_BAR();
        PROBE_AT(19, WS_Y, (size_t)M * D / 2);
        if (PH(6)) row_pass<1>(ap, l, vcu, G);
        if (MK_STOP == 1 || (MK_STOP == 3 && l == 1)) return;
        GRID_BAR();
        if (PH(7)) { const CArgs aq = launder(ap); unsigned char* ws = aq->ws; bf16_t* H = (bf16_t*)(ws + WS_H); pg8::Gemm g{H, (const bf16_t*)(ws + WS_WR) + (size_t)l * 256 * D, D, 0, nullptr}; pg8::StaticOrder S; S.init(M, 256, G, bx);
          pg8::EpiRouter E{(float*)(ws + WS_LOG), aq->in[15] + (size_t)l * NE};
          pg8::gemm_phase<pg8::EpiRouter, pg8::StaticOrder, false, true>(lds + RING_OFF, g, S, E); }
        GRID_BAR();
        if (MK_PROBE == 4 || MK_PROBE == 5) { unsigned char* ws = launder(ap)->ws; unsigned* DIG = (unsigned*)(ws + WS_CTL) + CW_DIG; const unsigned* src = (const unsigned*)(ws + (MK_PROBE == 4 ? WS_LOG : WS_H));
            const int n = MK_PROBE == 4 ? M * NE : M * D / 2; const int t = tid_now(); unsigned sacc = 0u;
            for (int i = blockIdx.x * NWAVES * 64 + t; i < n; i += G * NWAVES * 64) { const unsigned v = src[i]; sacc += (v & 0xffffu) + (v >> 16); }
            __hip_atomic_fetch_add(DIG + (t & 63), sacc, RLX_AGENT); GRID_BAR(); probe_dump(ap); return; }
        if (PH(8)) topk_lists(ap, l, G, LW);
        GRID_BAR();
        if (MK_PROBE == 1) { probe_lists(ap, l, vcu, G); GRID_BAR(); probe_dump(ap); return; }
        { unsigned char* ws = launder(ap)->ws; const int tid = tid_now(); if (tid < NE) LW[LW_CL + tid] = __hip_atomic_load((unsigned*)(ws + WS_CTL) + CW_CNT + l * NE + tid, RLX_AGENT);
          __syncthreads();
          if (tid == 0) { unsigned acc = 0u; for (int e = 0; e < NE; ++e) { LW[LW_TOFF + e] = acc; acc += (LW[LW_CL + e] + 255u) >> 8; } LW[LW_TOFF + NE] = acc; }
          __syncthreads(); }
#pragma unroll 1
        for (int rep = 0; rep < ((MK_DUP & 32) ? 2 : 1); ++rep) {
        if (PH(9)) { const CArgs aq = launder(ap); unsigned char* ws = aq->ws; bf16_t* H = (bf16_t*)(ws + WS_H); pg8::Gemm g{(const bf16_t*)(ws + WS_H8), (const bf16_t*)(ws + WS_WGU + (size_t)l * NE * 2 * FF * D), D / 2, (size_t)2 * FF * D / 2, (const int*)(ws + WS_LIST)};
          pg8::MoeOrder S{(const LAS int*)(lds + LDSCTL_OFF) + LW_TOFF, (const LAS int*)(lds + LDSCTL_OFF) + LW_CL, 2 * FF / 256, G, bx};
          pg8::EpiSwiglu8 E{ws + WS_ACT, aq->in[17] + (size_t)l * NE * 2 * FF};
          pg8::gemm_phase<pg8::EpiSwiglu8, pg8::MoeOrder, true, true, true, PFA_ON>(lds + RING_OFF, g, S, E); }
        GRID_BAR(); }
        if (MK_PROBE == 2) { probe_rows(ap, (const bf16_t*)(launder(ap)->ws + WS_ACT), 0, true, (const LAS int*)(lds + LDSCTL_OFF) + LW_TOFF, (const LAS int*)(lds + LDSCTL_OFF) + LW_CL, vcu, G); GRID_BAR(); probe_dump(ap); return; }
#pragma unroll 1
        for (int rep = 0; rep < ((MK_DUP & 64) ? 2 : 1); ++rep) {
        if (PH(10)) { const CArgs aq = launder(ap); unsigned char* ws = aq->ws; pg8::Gemm g{(const bf16_t*)(ws + WS_ACT), (const bf16_t*)(ws + WS_WD + (size_t)l * NE * D * FF), FF / 2, (size_t)D * FF / 2, nullptr};
          pg8::MoeOrder S{(const LAS int*)(lds + LDSCTL_OFF) + LW_TOFF, (const LAS int*)(lds + LDSCTL_OFF) + LW_CL, D / 256, G, bx};
          pg8::EpiDown8 E{ws + WS_YS, aq->in[19] + (size_t)l * NE * D, (const float*)(ws + WS_LISTW), 1.0f / (F8_SACT * F8_SW)};
#if defined(MK_EPIX)
          if (rep == 0 && (MK_DUP & 64)) { pg8::EpiDownX<MK_EPIX> EX{(bf16_t*)(ws + WS_YS), aq->in[19] + (size_t)l * NE * D, (const float*)(ws + WS_LISTW), 1.0f / (F8_SACT * F8_SW)}; pg8::gemm_phase<pg8::EpiDownX<MK_EPIX>, pg8::MoeOrder, false, true, true>(lds + RING_OFF, g, S, EX); } else
#elif defined(MK_NULLEPI)
          if (rep) { pg8::EpiNull EN; pg8::gemm_phase<pg8::EpiNull, pg8::MoeOrder, false, true, true>(lds + RING_OFF, g, S, EN); } else
#endif
          pg8::gemm_phase<pg8::EpiDown8, pg8::MoeOrder, false, true, true, PFA_ON>(lds + RING_OFF, g, S, E); }
        GRID_BAR(); }
        if (MK_PROBE == 3) { probe_rows(ap, (const bf16_t*)(launder(ap)->ws + WS_YS), M * TOPK, false, nullptr, nullptr, vcu, G); GRID_BAR(); probe_dump(ap); return; }
        if (PH(11)) row_pass<2>(ap, l, vcu, G, (const LAS int*)(lds + LDSCTL_OFF) + LW_TOFF);
        if (MK_STOP == 2) return;
        if (l + 1 < DEPTH) GRID_BAR();
    }
#if MK_TIM
    GRID_BAR();
    { const CArgs aq = launder(ap); const float* x = aq->in[0]; float* out = aq->out; const int t = tid_now();
      const unsigned long long s_ = __hip_atomic_load(&attn_body::g_tim[0], RLX_AGENT), c_ = __hip_atomic_load(&attn_body::g_tim[1], RLX_AGENT);
      float sc = (float)((double)s_ / (double)(c_ ? c_ : 1ull)) * (1.0f / MK_TIM);
#ifdef MK_TIM_Q
      sc = MK_TIM_Q * floorf(sc / MK_TIM_Q + 0.5f);
#endif
      for (size_t i = (size_t)blockIdx.x * NWAVES * 64 + t; i < (size_t)M * D; i += (size_t)G * NWAVES * 64) out[i] = x[i] * sc; }
#endif
}

extern "C" void kernel_launch(void* const* d_in, const int* in_sizes, int n_in, void* d_out, int out_size, void* d_ws, size_t ws_size, hipStream_t stream) {
    static int grid = 0;
    if (grid == 0) {
        if (n_in != 20 || in_sizes[0] != M * D || out_size != M * D || ws_size < WS_END) { fprintf(stderr, "kernel_launch: unexpected shapes (n_in %d, in0 %d, out %d, ws %zu < %zu); nothing launched\n", n_in, n_in > 0 ? in_sizes[0] : -1, out_size, ws_size, (size_t)WS_END); grid = -1; return; }
        int dev = 0, cus = 0, per_cu = 0;
        if (hipGetDevice(&dev) != hipSuccess || hipDeviceGetAttribute(&cus, hipDeviceAttributeMultiprocessorCount, dev) != hipSuccess) { grid = -1; return; }
        if (hipFuncSetAttribute((const void*)mk_fwd, hipFuncAttributeMaxDynamicSharedMemorySize, LDS_BYTES) != hipSuccess) { fprintf(stderr, "kernel_launch: hipFuncSetAttribute failed\n"); grid = -1; return; }
        if (hipOccupancyMaxActiveBlocksPerMultiprocessor(&per_cu, (const void*)mk_fwd, NWAVES * 64, LDS_BYTES) != hipSuccess || per_cu < 1)
            fprintf(stderr, "kernel_launch: note: occupancy query reports %d workgroups per CU\n", per_cu);
        (void)hipGetLastError();
        grid = cus > 256 ? 256 : cus;
    }
    if (grid < 0) return;
    if (hipMemsetAsync((char*)d_ws + WS_CTL, 0, CTL_ZERO_BYTES, stream) != hipSuccess) return;
    Args a{};
    for (int i = 0; i < 20; ++i) a.in[i] = (const float*)d_in[i];
    a.out = (float*)d_out; a.ws = (unsigned char*)d_ws;
    hipLaunchKernelGGL(mk_fwd, dim3(grid), dim3(NWAVES * 64), LDS_BYTES, stream, a);
}
```

```cpp
#include <hip/hip_runtime.h>
#include <cstdio>
#include <cstdint>
#include <cmath>

#ifndef MK_STOP
#define MK_STOP 0
#endif

constexpr int BATCH = 2, SEQ = 16384, D = 1024, M = BATCH * SEQ, DEPTH = 2;
constexpr int INW = 4352, PITCH = INW;
constexpr int C_QA = 0, C_KA = 512, C_VA = 640, C_QB = 768, C_KB = 1280, C_VB = 1792, C_GZA = 2304, C_GZB = 3328;
constexpr int NE = 32, TOPK = 4, FF = 1024, CAP = M;
constexpr int NBH = 12, HA = 8;
constexpr float LOG2E = 1.4426950408889634f, QSCALE = 0.125f * LOG2E;
constexpr float NORM_EPS = 1e-6f, SUBLN_EPS = 1e-5f;
constexpr int ACT_ROWS = M * TOPK + NE * 256;

#define LAS __attribute__((address_space(3)))
#define GAS __attribute__((address_space(1)))
typedef unsigned short bf16_t;
typedef short bf16x8 __attribute__((ext_vector_type(8)));
typedef float f32x4 __attribute__((ext_vector_type(4)));
typedef float f32x2 __attribute__((ext_vector_type(2)));
typedef unsigned u32x4 __attribute__((ext_vector_type(4)));
typedef unsigned u32x2 __attribute__((ext_vector_type(2)));
typedef int v4i_t __attribute__((ext_vector_type(4)));
typedef int v8i_t __attribute__((ext_vector_type(8)));
constexpr float F8_SW = 128.0f, F8_SH = 16.0f, F8_SACT = 4.0f, F8_SY = 32.0f, F8_MAX = 448.0f;
__device__ __forceinline__ float f8clamp(float v) { return fminf(fmaxf(v, -F8_MAX), F8_MAX); }
__device__ __forceinline__ unsigned pk4_fp8(float a, float b, float c, float d) { unsigned w = 0u; w = __builtin_amdgcn_cvt_pk_fp8_f32(f8clamp(a), f8clamp(b), w, false); w = __builtin_amdgcn_cvt_pk_fp8_f32(f8clamp(c), f8clamp(d), w, true); return w; }

__device__ __forceinline__ unsigned cvt_pk_bf16(float lo, float hi) { unsigned r; asm volatile("v_cvt_pk_bf16_f32 %0, %1, %2" : "=v"(r) : "v"(lo), "v"(hi)); return r; }
__device__ __forceinline__ float bf_lo(unsigned w) { return __uint_as_float(w << 16); }
__device__ __forceinline__ float bf_hi(unsigned w) { return __uint_as_float(w & 0xffff0000u); }
__device__ __forceinline__ float sigmoidf_(float v) { return __builtin_amdgcn_rcpf(1.0f + __builtin_amdgcn_exp2f(-v * LOG2E)); }

namespace pg8 {
constexpr int BM = 256, BK = 64, HALF = 128, HTB = HALF * BK * 2, STAGE_BYTES = 8 * HTB, NXCD = 8, WGM = 8;
__host__ __device__ __forceinline__ int lds_byte(int r, int c) { const int st = (r >> 4) * 2 + (c >> 5), rr = r & 15, cc = c & 31, ob = rr * 64 + cc * 2; return st * 1024 + (ob ^ (((ob >> 9) & 1) << 5)); }
__host__ __device__ __forceinline__ void stage_rc(int b, int& R, int& C) { const int st = b / 1024, sb = b % 1024, swz = sb ^ (((sb >> 9) & 1) << 5); R = (st >> 1) * 16 + swz / 64; C = (st & 1) * 32 + (swz % 64) / 2; }
__host__ __device__ __forceinline__ int perm32(int rho) { const int n = rho >> 4, i = rho & 15; return 8 * (i >> 2) + 4 * n + (i & 3); }

template <class E, class = void> struct Perm16 { static constexpr bool v = false; };
template <class E> struct Perm16<E, decltype((void)E::PERM16)> { static constexpr bool v = E::PERM16; };
__host__ __device__ __forceinline__ int perm16x(int R) { return 64 * (R >> 5) + 16 * ((R >> 2) & 3) + 4 * ((R >> 4) & 1) + (R & 3); }
struct Unit { int pm, pn, e, lrow, nvalid; };
struct Gemm { const bf16_t* A; const bf16_t* Bt; int K; size_t estride; const int* rows; };

struct StaticOrder {
    int nM, nN, nwg, G, c, skew;
    __device__ void init(int Mr, int N, int G_, int c_, int skew_ = 0) { nM = Mr / BM; nN = N / BM; nwg = nM * nN; G = G_; c = c_; skew = (skew_ && G_ == 256 && nwg == 1024) ? 1 : 0; }
    __device__ bool next(int i, Unit& u) const {
        long L = (long)i * G + c;
        if (skew) { if (c >= 128) { if (i >= 5) return false; L = (c - 128) + 128 * i; } else { if (i >= 3) return false; L = 640 + c + 128 * i; } }
        if (L >= nwg) return false;
        int wgid = (int)L; { const int q = nwg / NXCD, r = nwg % NXCD, xcd = wgid % NXCD, off = wgid / NXCD; wgid = (xcd < r ? xcd * (q + 1) : r * (q + 1) + (xcd - r) * q) + off; }
        const int nig = WGM * nN, gid = wgid / nig, fm = gid * WGM, gsz = (nM - fm) < WGM ? (nM - fm) : WGM;
        u.pm = fm + ((wgid % nig) % gsz); u.pn = (wgid % nig) / gsz; u.e = 0; u.lrow = 0; u.nvalid = 256; return true;
    }
};
struct MoeOrder {
    const LAS int* toff; const LAS int* cl; int nN, G, c;
    __device__ bool next(int i, Unit& u) const {
        const int ntile = toff[NE]; int gt, pn;
        if ((G & 7) == 0) { const int x = c & 7, s = c >> 3, per = G >> 3, t0 = (ntile * x) >> 3, t1 = (ntile * (x + 1)) >> 3, Lx = i * per + s;
            if (Lx >= (t1 - t0) * nN) return false;
            const int q = Lx / nN; gt = t0 + q; pn = Lx - q * nN; }
        else { const int L = i * G + c; if (L >= ntile * nN) return false; gt = L / nN; pn = L - gt * nN; }
        int e = 0;
#pragma unroll
        for (int k = 16; k >= 1; k >>= 1) if (toff[e + k] <= gt) e += k;
        const int rt = gt - toff[e]; int nv = cl[e] - rt * 256; nv = nv > 256 ? 256 : nv;
        u.pm = __builtin_amdgcn_readfirstlane(gt); u.pn = __builtin_amdgcn_readfirstlane(pn); u.e = __builtin_amdgcn_readfirstlane(e);
        u.lrow = __builtin_amdgcn_readfirstlane(e * CAP + rt * 256); u.nvalid = __builtin_amdgcn_readfirstlane(nv); return true;
    }
};

#ifndef MK_NT
#define MK_NT 1
#endif
#if MK_NT
#define NT_STORE(v, p) __builtin_nontemporal_store(v, p)
#else
#define NT_STORE(v, p) (*(p) = (v))
#endif
struct EpiBf16 {
    static constexpr bool PERM = true;
    bf16_t* O; int ldc; float sc;
    __device__ __forceinline__ void operator()(const f32x4 (&acc)[2][2][4][2], const Unit& u, int wr, int wc, int fr, int fq) const {
        const int row0 = u.pm * BM + wr * 64 + fr, col0 = u.pn * BM + wc * 32 + 8 * fq;
#pragma unroll
        for (int ai = 0; ai < 2; ++ai)
#pragma unroll
            for (int m = 0; m < 4; ++m) { bf16_t* rowp = O + (size_t)(row0 + ai * HALF + m * 16) * ldc + col0;
#pragma unroll
                for (int bj = 0; bj < 2; ++bj) { const f32x4 v0 = acc[ai][bj][m][0] * sc, v1 = acc[ai][bj][m][1] * sc;
                    u32x4 w; w.x = cvt_pk_bf16(v0[0], v0[1]); w.y = cvt_pk_bf16(v0[2], v0[3]); w.z = cvt_pk_bf16(v1[0], v1[1]); w.w = cvt_pk_bf16(v1[2], v1[3]);
                    NT_STORE(w, (u32x4*)(rowp + bj * HALF)); } }
    }
};
template <bool FIRST> struct EpiGate {
    static constexpr bool PERM = true;
    bf16_t* O; const bf16_t* prev; const bf16_t* P; int gcol;
    __device__ __forceinline__ void operator()(const f32x4 (&acc)[2][2][4][2], const Unit& u, int wr, int wc, int fr, int fq) const {
        const int row0 = u.pm * BM + wr * 64 + fr, col0 = u.pn * BM + wc * 32 + 8 * fq;
#pragma unroll
        for (int ai = 0; ai < 2; ++ai)
#pragma unroll
            for (int m = 0; m < 4; ++m) { const size_t row = (size_t)(row0 + ai * HALF + m * 16);
#pragma unroll
                for (int bj = 0; bj < 2; ++bj) { const int col = col0 + bj * HALF;
                    const u32x4 gz = *(const u32x4*)(P + row * PITCH + gcol + col);
                    const f32x4 v0 = acc[ai][bj][m][0], v1 = acc[ai][bj][m][1];
                    float o[8];
                    o[0] = v0[0] * sigmoidf_(bf_lo(gz.x)); o[1] = v0[1] * sigmoidf_(bf_hi(gz.x)); o[2] = v0[2] * sigmoidf_(bf_lo(gz.y)); o[3] = v0[3] * sigmoidf_(bf_hi(gz.y));
                    o[4] = v1[0] * sigmoidf_(bf_lo(gz.z)); o[5] = v1[1] * sigmoidf_(bf_hi(gz.z)); o[6] = v1[2] * sigmoidf_(bf_lo(gz.w)); o[7] = v1[3] * sigmoidf_(bf_hi(gz.w));
                    if (!FIRST) { const u32x4 pv = *(const u32x4*)(prev + row * D + col);
                        o[0] += bf_lo(pv.x); o[1] += bf_hi(pv.x); o[2] += bf_lo(pv.y); o[3] += bf_hi(pv.y); o[4] += bf_lo(pv.z); o[5] += bf_hi(pv.z); o[6] += bf_lo(pv.w); o[7] += bf_hi(pv.w); }
                    u32x4 w; w.x = cvt_pk_bf16(o[0], o[1]); w.y = cvt_pk_bf16(o[2], o[3]); w.z = cvt_pk_bf16(o[4], o[5]); w.w = cvt_pk_bf16(o[6], o[7]);
                    *(u32x4*)(O + row * D + col) = w; } }
    }
};
struct EpiRouter {
    static constexpr bool PERM = false;
    float* L; const float* bias;
    __device__ __forceinline__ void operator()(const f32x4 (&acc)[2][2][4][2], const Unit& u, int wr, int wc, int fr, int fq) const {
        if (wc != 0) return;
        const int row0 = u.pm * BM + wr * 64 + fr, col0 = 4 * fq;
        const f32x4 b0 = *(const f32x4*)(bias + col0), b1 = *(const f32x4*)(bias + col0 + 16);
#pragma unroll
        for (int ai = 0; ai < 2; ++ai)
#pragma unroll
            for (int m = 0; m < 4; ++m) { float* rowp = L + (size_t)(row0 + ai * HALF + m * 16) * NE + col0;
                *(f32x4*)(rowp) = acc[ai][0][m][0] + b0; *(f32x4*)(rowp + 16) = acc[ai][0][m][1] + b1; }
    }
};
struct EpiSwiglu {
    static constexpr bool PERM = true;
    bf16_t* ACT; const float* bgu;
    __device__ __forceinline__ void operator()(const f32x4 (&acc)[2][2][4][2], const Unit& u, int wr, int wc, int fr, int fq) const {
        const int row0 = u.pm * BM + wr * 64 + fr, j0 = u.pn * HALF + wc * 32 + 8 * fq;
        const float* bg = bgu + (size_t)u.e * 2 * FF + j0;
        float g_b[8], u_b[8];
        { const f32x4 a = *(const f32x4*)bg, b = *(const f32x4*)(bg + 4), c = *(const f32x4*)(bg + FF), d = *(const f32x4*)(bg + FF + 4);
#pragma unroll
          for (int i = 0; i < 4; ++i) { g_b[i] = a[i]; g_b[4 + i] = b[i]; u_b[i] = c[i]; u_b[4 + i] = d[i]; } }
#pragma unroll
        for (int ai = 0; ai < 2; ++ai)
#pragma unroll
            for (int m = 0; m < 4; ++m) { bf16_t* rowp = ACT + (size_t)(row0 + ai * HALF + m * 16) * FF + j0;
                float o[8];
#pragma unroll
                for (int n = 0; n < 2; ++n)
#pragma unroll
                    for (int i = 0; i < 4; ++i) { float gt = acc[ai][0][m][n][i] + g_b[4 * n + i], up = acc[ai][1][m][n][i] + u_b[4 * n + i];
                        gt = fminf(gt, 7.0f); up = fminf(fmaxf(up, -7.0f), 7.0f);
                        o[4 * n + i] = gt * __builtin_amdgcn_rcpf(1.0f + __builtin_amdgcn_exp2f(-1.702f * LOG2E * gt)) * (up + 1.0f); }
                u32x4 w; w.x = cvt_pk_bf16(o[0], o[1]); w.y = cvt_pk_bf16(o[2], o[3]); w.z = cvt_pk_bf16(o[4], o[5]); w.w = cvt_pk_bf16(o[6], o[7]);
                *(u32x4*)rowp = w; }
    }
};
struct EpiSwiglu8 {
    static constexpr bool PERM = true;
    unsigned char* ACT; const float* bgu;
    struct Pre { f32x4 a, b, c, d; };
    __device__ __forceinline__ Pre pre(const Unit& u, int wr, int wc, int fr, int fq) const {
        const float* bg = bgu + (size_t)u.e * 2 * FF + u.pn * HALF + wc * 32 + 8 * fq;
        Pre q; q.a = *(const f32x4*)bg; q.b = *(const f32x4*)(bg + 4); q.c = *(const f32x4*)(bg + FF); q.d = *(const f32x4*)(bg + FF + 4); return q; }
    __device__ __forceinline__ void post(const f32x4 (&acc)[2][2][4][2], const Pre& q, const Unit& u, int wr, int wc, int fr, int fq) const {
        constexpr float DS = 1.0f / (F8_SH * F8_SW);
        const int row0 = u.pm * BM + wr * 64 + fr, j0 = u.pn * HALF + wc * 32 + 8 * fq;
        float g_b[8], u_b[8];
#pragma unroll
        for (int i = 0; i < 4; ++i) { g_b[i] = q.a[i]; g_b[4 + i] = q.b[i]; u_b[i] = q.c[i]; u_b[4 + i] = q.d[i]; }
#pragma unroll
        for (int ai = 0; ai < 2; ++ai)
#pragma unroll
            for (int m = 0; m < 4; ++m) { unsigned char* rowp = ACT + (size_t)(row0 + ai * HALF + m * 16) * FF + j0;
                float o[8];
#pragma unroll
                for (int n = 0; n < 2; ++n)
#pragma unroll
                    for (int i = 0; i < 4; ++i) { float gt = acc[ai][0][m][n][i] * DS + g_b[4 * n + i], up = acc[ai][1][m][n][i] * DS + u_b[4 * n + i];
                        gt = fminf(gt, 7.0f); up = fminf(fmaxf(up, -7.0f), 7.0f);
                        o[4 * n + i] = gt * __builtin_amdgcn_rcpf(1.0f + __builtin_amdgcn_exp2f(-1.702f * LOG2E * gt)) * (up + 1.0f) * F8_SACT; }
                u32x2 w; w.x = pk4_fp8(o[0], o[1], o[2], o[3]); w.y = pk4_fp8(o[4], o[5], o[6], o[7]);
                NT_STORE(w, (u32x2*)rowp); }
    }
    __device__ __forceinline__ void operator()(const f32x4 (&acc)[2][2][4][2], const Unit& u, int wr, int wc, int fr, int fq) const { const Pre q = pre(u, wr, wc, fr, fq); post(acc, q, u, wr, wc, fr, fq); }
};
struct EpiDown {
    static constexpr bool PERM = true;
    bf16_t* YS; const float* bd; const float* listw; float ds;
    struct Pre { float ws[8]; f32x4 bv[2][2]; };
    __device__ __forceinline__ Pre pre(const Unit& u, int wr, int wc, int fr, int fq) const {
        const int r0 = wr * 64 + fr, col0 = u.pn * BM + wc * 32 + 8 * fq;
        const float* bp = bd + (size_t)u.e * D + col0;
        Pre q;
#pragma unroll
        for (int g = 0; g < 8; ++g) { const int r = r0 + (g >> 2) * HALF + (g & 3) * 16; q.ws[g] = (r < u.nvalid) ? listw[u.lrow + r] : 0.f; }
#pragma unroll
        for (int bj = 0; bj < 2; ++bj) { q.bv[bj][0] = *(const f32x4*)(bp + bj * HALF); q.bv[bj][1] = *(const f32x4*)(bp + bj * HALF + 4); }
        return q; }
    __device__ __forceinline__ void post(const f32x4 (&acc)[2][2][4][2], const Pre& q, const Unit& u, int wr, int wc, int fr, int fq) const {
        const int r0 = wr * 64 + fr, col0 = u.pn * BM + wc * 32 + 8 * fq;
#pragma unroll
        for (int ai = 0; ai < 2; ++ai)
#pragma unroll
            for (int m = 0; m < 4; ++m) { const float w_ = q.ws[ai * 4 + m]; bf16_t* rowp = YS + (size_t)(u.pm * BM + r0 + ai * HALF + m * 16) * D + col0;
#pragma unroll
                for (int bj = 0; bj < 2; ++bj) { const f32x4 v0 = (acc[ai][bj][m][0] * ds + q.bv[bj][0]) * w_, v1 = (acc[ai][bj][m][1] * ds + q.bv[bj][1]) * w_;
                    u32x4 w; w.x = cvt_pk_bf16(v0[0], v0[1]); w.y = cvt_pk_bf16(v0[2], v0[3]); w.z = cvt_pk_bf16(v1[0], v1[1]); w.w = cvt_pk_bf16(v1[2], v1[3]);
                    NT_STORE(w, (u32x4*)(rowp + bj * HALF)); } }
    }
    __device__ __forceinline__ void operator()(const f32x4 (&acc)[2][2][4][2], const Unit& u, int wr, int wc, int fr, int fq) const { const Pre q = pre(u, wr, wc, fr, fq); post(acc, q, u, wr, wc, fr, fq); }
};

struct EpiDown8 {
    static constexpr bool PERM = true; static constexpr bool PERM16 = true;
    unsigned char* YS; const float* bd; const float* listw; float ds;
    struct Pre { float ws[8]; f32x4 bv[4]; };
    __device__ __forceinline__ Pre pre(const Unit& u, int wr, int wc, int fr, int fq) const {
        const int r0 = wr * 64 + fr, col0 = u.pn * BM + wc * 64 + 16 * fq;
        const float* bp = bd + (size_t)u.e * D + col0;
        Pre q;
#pragma unroll
        for (int g = 0; g < 8; ++g) { const int r = r0 + (g >> 2) * HALF + (g & 3) * 16; q.ws[g] = (r < u.nvalid) ? listw[u.lrow + r] * F8_SY : 0.f; }
#pragma unroll
        for (int j = 0; j < 4; ++j) q.bv[j] = *(const f32x4*)(bp + 4 * j);
        return q; }
    __device__ __forceinline__ void post(const f32x4 (&acc)[2][2][4][2], const Pre& q, const Unit& u, int wr, int wc, int fr, int fq) const {
        const int r0 = wr * 64 + fr, col0 = u.pn * BM + wc * 64 + 16 * fq;
#pragma unroll
        for (int ai = 0; ai < 2; ++ai)
#pragma unroll
            for (int m = 0; m < 4; ++m) { const float w_ = q.ws[ai * 4 + m]; unsigned char* rowp = YS + (size_t)(u.pm * BM + r0 + ai * HALF + m * 16) * D + col0;
                u32x4 w;
#pragma unroll
                for (int bj = 0; bj < 2; ++bj)
#pragma unroll
                    for (int n = 0; n < 2; ++n) { const f32x4 v = (acc[ai][bj][m][n] * ds + q.bv[2 * bj + n]) * w_; w[2 * bj + n] = pk4_fp8(v[0], v[1], v[2], v[3]); }
                NT_STORE(w, (u32x4*)rowp); }
    }
    __device__ __forceinline__ void operator()(const f32x4 (&acc)[2][2][4][2], const Unit& u, int wr, int wc, int fr, int fq) const { const Pre q = pre(u, wr, wc, fr, fq); post(acc, q, u, wr, wc, fr, fq); }
};
#ifdef MK_EPIX
template <int MODE> struct EpiDownX {
    static constexpr bool PERM = true;
    bf16_t* YS; const float* bd; const float* listw; float ds;
    __device__ __forceinline__ void operator()(const f32x4 (&acc)[2][2][4][2], const Unit& u, int wr, int wc, int fr, int fq) const {
        const int r0 = wr * 64 + fr, col0 = u.pn * BM + wc * 32 + 8 * fq;
        const float* bp = bd + (size_t)u.e * D + col0;
        float ws[8]; f32x4 bv[2][2];
        if (MODE != 2) {
#pragma unroll
        for (int g = 0; g < 8; ++g) { const int r = r0 + (g >> 2) * HALF + (g & 3) * 16; ws[g] = (r < u.nvalid) ? listw[u.lrow + r] : 0.f; }
#pragma unroll
        for (int bj = 0; bj < 2; ++bj) { bv[bj][0] = *(const f32x4*)(bp + bj * HALF); bv[bj][1] = *(const f32x4*)(bp + bj * HALF + 4); }
        } else {
#pragma unroll
        for (int g = 0; g < 8; ++g) ws[g] = ds;
#pragma unroll
        for (int bj = 0; bj < 2; ++bj) { bv[bj][0] = (f32x4){ds, ds, ds, ds}; bv[bj][1] = bv[bj][0]; } }
#pragma unroll
        for (int ai = 0; ai < 2; ++ai)
#pragma unroll
            for (int m = 0; m < 4; ++m) { const float w_ = ws[ai * 4 + m]; bf16_t* rowp = YS + (size_t)(u.pm * BM + r0 + ai * HALF + m * 16) * D + col0;
#pragma unroll
                for (int bj = 0; bj < 2; ++bj) { const f32x4 v0 = (acc[ai][bj][m][0] * ds + bv[bj][0]) * w_, v1 = (acc[ai][bj][m][1] * ds + bv[bj][1]) * w_;
                    u32x4 w; w.x = cvt_pk_bf16(v0[0], v0[1]); w.y = cvt_pk_bf16(v0[2], v0[3]); w.z = cvt_pk_bf16(v1[0], v1[1]); w.w = cvt_pk_bf16(v1[2], v1[3]);
                    if (MODE != 1) *(u32x4*)(rowp + bj * HALF) = w; else asm volatile("" :: "v"(w)); } }
    }
};
#endif
struct EpiNull {
    static constexpr bool PERM = true;
    __device__ __forceinline__ void operator()(const f32x4 (&acc)[2][2][4][2], const Unit& u, int wr, int wc, int fr, int fq) const {
#pragma unroll
        for (int ai = 0; ai < 2; ++ai)
#pragma unroll
            for (int bj = 0; bj < 2; ++bj)
#pragma unroll
                for (int m = 0; m < 4; ++m) asm volatile("" :: "v"(acc[ai][bj][m][0]), "v"(acc[ai][bj][m][1]));
    }
};
template <class Epi, class Sched, bool GATHER, bool ALIGN_EPI, bool F8 = false, bool PFA = false>
__device__ __forceinline__ void gemm_phase(LAS unsigned char* lds, const Gemm g, const Sched& S, const Epi& E) {
    int tid = threadIdx.x; asm volatile("" : "+v"(tid));
    const int wid = __builtin_amdgcn_readfirstlane(tid >> 6), lane = tid & 63, wr = wid >> 2, wc = wid & 3, fr = lane & 15, fq = lane >> 4;
    const int K = g.K, nt = K / BK;
    unsigned voffA[2], voffB[2]; int Rg[2], Cg[2];
#pragma unroll
    for (int i = 0; i < 2; ++i) { int R, C; stage_rc(tid * 16 + i * 8192, R, C); const int Rb = Perm16<Epi>::v ? perm16x(R) : Epi::PERM ? ((R & ~31) + perm32(R & 31)) : R;
        voffA[i] = (unsigned)(R * K + C) * 2u; voffB[i] = (unsigned)(Rb * K + C) * 2u; Rg[i] = R; Cg[i] = C; }
    const size_t kstep = (size_t)(BK * 2);
    const size_t hstep = (size_t)HALF * K * 2;
    const size_t tstep = 2 * hstep;
    const unsigned ldsw = (unsigned)wid * 1024u;
    const int aoff = lds_byte(wr * 64 + fr, fq * 8), boff = lds_byte(wc * 32 + fr, fq * 8);
    unsigned vAc[2][2], vAn[2][2];
#define PG8_SA(b, h) (((b) * 2 + (h)) * HTB)
#define PG8_SB(b, h) ((4 + (b) * 2 + (h)) * HTB)
#define PG8_STAGE2(bufoff, gbase, v0, v1) do { \
        __builtin_amdgcn_global_load_lds((const unsigned*)((const char*)(gbase) + (v0)), (LAS unsigned*)(lds + (bufoff) + ldsw), 16, 0, 0); \
        __builtin_amdgcn_global_load_lds((const unsigned*)((const char*)(gbase) + (v1)), (LAS unsigned*)(lds + (bufoff) + ldsw + 8192), 16, 0, 0); } while (0)
#define PG8_STA(bufoff, ap, h, usen) do { if constexpr (GATHER) { const unsigned o0_ = (usen) ? vAn[h][0] : vAc[h][0], o1_ = (usen) ? vAn[h][1] : vAc[h][1]; PG8_STAGE2(bufoff, ap, o0_, o1_); } \
        else { PG8_STAGE2(bufoff, (ap) + (h) * hstep, voffA[0], voffA[1]); } } while (0)
#define PG8_STB(bufoff, bp, h) PG8_STAGE2(bufoff, (bp) + (h) * (Perm16<Epi>::v ? (size_t)8 * K * 2 : hstep), voffB[0], voffB[1])
#define PG8_ROWS(u, v) do { _Pragma("unroll") for (int h_ = 0; h_ < 2; ++h_) _Pragma("unroll") for (int i_ = 0; i_ < 2; ++i_) { const int rr_ = h_ * HALF + Rg[i_]; \
        const int idx_ = (rr_ < (u).nvalid) ? g.rows[(u).lrow + rr_] : 0; v[h_][i_] = (unsigned)((idx_ >> 2) * K + Cg[i_]) * 2u; } \
        asm volatile("" : "+v"(v[0][0]), "+v"(v[0][1]), "+v"(v[1][0]), "+v"(v[1][1])); } while (0)
#define PG8_LDA(dst, b, h) do { _Pragma("unroll") for (int m = 0; m < 4; ++m) _Pragma("unroll") for (int k = 0; k < 2; ++k) dst[m][k] = *(const LAS bf16x8*)(lds + PG8_SA(b, h) + aoff + m * 2048 + k * 1024); } while (0)
#define PG8_LDB(dst, b, h) do { _Pragma("unroll") for (int n = 0; n < 2; ++n) _Pragma("unroll") for (int k = 0; k < 2; ++k) dst[n][k] = *(const LAS bf16x8*)(lds + PG8_SB(b, h) + boff + n * 2048 + k * 1024); } while (0)
#define PG8_CAT(x, y) __builtin_shufflevector(__builtin_bit_cast(v4i_t, x), __builtin_bit_cast(v4i_t, y), 0, 1, 2, 3, 4, 5, 6, 7)
#define PG8_MMA(ai, bj, At, Bt) do { __builtin_amdgcn_s_setprio(1); if constexpr (F8) { \
        _Pragma("unroll") for (int m = 0; m < 4; ++m) _Pragma("unroll") for (int n = 0; n < 2; ++n) \
            { const v8i_t b8_ = PG8_CAT(Bt[n][0], Bt[n][1]), a8_ = PG8_CAT(At[m][0], At[m][1]);     \
              asm volatile("v_mfma_scale_f32_16x16x128_f8f6f4 %0, %1, %2, %0, %3, %3 op_sel_hi:[0,0,0]" : "+v"(acc[ai][bj][m][n]) : "v"(b8_), "v"(a8_), "v"(f8one)); } \
        } else { _Pragma("unroll") for (int m = 0; m < 4; ++m) _Pragma("unroll") for (int n = 0; n < 2; ++n) _Pragma("unroll") for (int k = 0; k < 2; ++k) \
        acc[ai][bj][m][n] = __builtin_amdgcn_mfma_f32_16x16x32_bf16(Bt[n][k], At[m][k], acc[ai][bj][m][n], 0, 0, 0); } __builtin_amdgcn_s_setprio(0); } while (0)
#define PG8_WAIT_V(n) asm volatile("s_waitcnt vmcnt(" #n ")" ::: "memory")
#define PG8_WAIT_L(n) asm volatile("s_waitcnt lgkmcnt(" #n ")" ::: "memory")
#define PG8_BAR __builtin_amdgcn_s_barrier()
#define PG8_SCHED __builtin_amdgcn_sched_barrier(0)
    Unit cur, nxt; int ui = 0;
    if (!S.next(0, cur)) return;
    f32x4 acc[2][2][4][2];
#pragma unroll
    for (int a = 0; a < 2; ++a)
#pragma unroll
        for (int b = 0; b < 2; ++b)
#pragma unroll
            for (int m = 0; m < 4; ++m)
#pragma unroll
                for (int n = 0; n < 2; ++n) acc[a][b][m][n] = (f32x4){0.f, 0.f, 0.f, 0.f};
    bf16x8 At[4][2], B0[2][2], B1[2][2];
    const int f8one = 0x7f7f7f7f;
    const char* cA = GATHER ? (const char*)g.A : (const char*)g.A + (size_t)cur.pm * tstep;
    const char* cB = (const char*)g.Bt + ((size_t)cur.e * g.estride) * 2 + (size_t)cur.pn * tstep;
    if constexpr (GATHER) { PG8_ROWS(cur, vAc); }
    PG8_STB(PG8_SB(0, 0), cB, 0); PG8_STB(PG8_SB(0, 1), cB, 1); PG8_STA(PG8_SA(0, 0), cA, 0, false); PG8_STA(PG8_SA(0, 1), cA, 1, false);
    if (wr == 1) PG8_BAR;
    PG8_WAIT_V(2); PG8_BAR;
    PG8_STB(PG8_SB(1, 0), cB + kstep, 0); PG8_STA(PG8_SA(1, 0), cA + kstep, 0, false); PG8_STB(PG8_SB(1, 1), cB + kstep, 1);
    PG8_WAIT_V(6); PG8_BAR;
    for (;;) {
        const bool has_next = S.next(ui + 1, nxt);
        const char* nA = GATHER ? (const char*)g.A : (has_next ? (const char*)g.A + (size_t)nxt.pm * tstep : cA);
        const char* nB = has_next ? (const char*)g.Bt + ((size_t)nxt.e * g.estride) * 2 + (size_t)nxt.pn * tstep : cB;
        if constexpr (GATHER) { if (has_next) { PG8_ROWS(nxt, vAn); } else {
#pragma unroll
            for (int h = 0; h < 2; ++h) { vAn[h][0] = vAc[h][0]; vAn[h][1] = vAc[h][1]; } } }
        for (int t = 0; t < nt; t += 2) {
            const bool last = (t == nt - 2);
            const char* a1 = cA + (size_t)(t + 1) * kstep;
            const char* a2 = last ? nA : cA + (size_t)(t + 2) * kstep; const char* b2 = last ? nB : cB + (size_t)(t + 2) * kstep;
            const char* a3 = a2 + kstep; const char* b3 = b2 + kstep;
            PG8_LDB(B0, 0, 0); PG8_LDB(B1, 0, 1); PG8_SCHED; PG8_LDA(At, 0, 0); PG8_STA(PG8_SA(1, 1), a1, 1, false);
            PG8_WAIT_V(8); PG8_WAIT_L(0); PG8_BAR; PG8_MMA(0, 0, At, B0); PG8_MMA(0, 1, At, B1); PG8_BAR; PG8_SCHED;
            PG8_LDA(At, 0, 1); PG8_STB(PG8_SB(0, 0), b2, 0); PG8_STB(PG8_SB(0, 1), b2, 1); PG8_STA(PG8_SA(0, 0), a2, 0, last);
            PG8_WAIT_V(8); PG8_WAIT_L(0); PG8_BAR; PG8_MMA(1, 0, At, B0); PG8_MMA(1, 1, At, B1); PG8_BAR; PG8_SCHED;
            PG8_LDB(B0, 1, 0); PG8_LDB(B1, 1, 1); PG8_SCHED; PG8_LDA(At, 1, 0); PG8_STA(PG8_SA(0, 1), a2, 1, last);
            PG8_WAIT_V(8); PG8_WAIT_L(0); PG8_BAR; PG8_MMA(0, 0, At, B0); PG8_MMA(0, 1, At, B1); PG8_BAR; PG8_SCHED;
            PG8_LDA(At, 1, 1); PG8_STB(PG8_SB(1, 0), b3, 0); PG8_STB(PG8_SB(1, 1), b3, 1); PG8_STA(PG8_SA(1, 0), a3, 0, last);
            PG8_WAIT_V(8); PG8_WAIT_L(0); PG8_BAR; PG8_MMA(1, 0, At, B0); PG8_MMA(1, 1, At, B1); PG8_BAR; PG8_SCHED;
        }
        if constexpr (ALIGN_EPI) { if (wr == 0) PG8_BAR; }
        if constexpr (F8) asm volatile("s_nop 15\n\ts_nop 15" ::: "memory");
        if constexpr (PFA) {
            const auto q_ = E.pre(cur, wr, wc, fr, fq);
            PG8_SCHED;
            if (has_next) { LAS unsigned* dump_ = (LAS unsigned*)(lds + STAGE_BYTES + 8192 + ldsw / 4);
                for (int kb = 0; kb < nt * 128; kb += 1024) if (kb > 0 || Cg[0] >= 16) {
#pragma unroll
                    for (int h = 0; h < 2; ++h)
#pragma unroll
                        for (int i = 0; i < 2; ++i) { const char* pa_ = GATHER ? nA + vAn[h][i] : nA + h * hstep + voffA[i];
                            __builtin_amdgcn_global_load_lds((const unsigned*)(pa_ + Cg[i] * 14 + kb), dump_, 4, 0, 0); } } }
            PG8_SCHED;
            E.post(acc, q_, cur, wr, wc, fr, fq);
        } else E(acc, cur, wr, wc, fr, fq);
        if (!has_next) break;
#pragma unroll
        for (int a = 0; a < 2; ++a)
#pragma unroll
            for (int b = 0; b < 2; ++b)
#pragma unroll
                for (int m = 0; m < 4; ++m)
#pragma unroll
                    for (int n = 0; n < 2; ++n) acc[a][b][m][n] = (f32x4){0.f, 0.f, 0.f, 0.f};
        cur = nxt; cA = nA; cB = nB; ++ui;
        if constexpr (GATHER) {
#pragma unroll
            for (int h = 0; h < 2; ++h) { vAc[h][0] = vAn[h][0]; vAc[h][1] = vAn[h][1]; } }
        if constexpr (ALIGN_EPI) { if (wr == 1) PG8_BAR; }
    }
    PG8_WAIT_V(0);
    if constexpr (!ALIGN_EPI) { if (wr == 0) PG8_BAR; }
    PG8_BAR;
#undef PG8_SA
#undef PG8_SB
#undef PG8_STAGE2
#undef PG8_STA
#undef PG8_STB
#undef PG8_ROWS
#undef PG8_LDA
#undef PG8_LDB
#undef PG8_MMA
#undef PG8_CAT
#undef PG8_WAIT_V
#undef PG8_WAIT_L
#undef PG8_BAR
#undef PG8_SCHED
}
}
namespace attn_body {
using bf16x8 = __attribute__((ext_vector_type(8))) short;
using s16x4 = __attribute__((ext_vector_type(4))) short;
using f32x16 = __attribute__((ext_vector_type(16))) float;
constexpr int NW = 8, QBLK = 32, QB = QBLK * NW, KVBLK = 64;
__device__ __forceinline__ int crow(int r, int hi) { return (r & 3) + 8 * (r >> 2) + 4 * hi; }
#define SBAR() __builtin_amdgcn_sched_barrier(0)
constexpr int NSLOT = 4, SLOTK = 8192, SLOTV = 16384;
constexpr int LDS_K = 0, LDS_V = NSLOT * SLOTK, LDS_WS = LDS_V + NSLOT * SLOTV, LDS_TAB = LDS_WS + NW * 64 * 4, TAB_N = 640, LDS_BYTES = LDS_TAB + TAB_N * 4;
__device__ __forceinline__ void glds16(const void* gsrc, unsigned lds_dst) { unsigned keep;
  asm volatile("s_mov_b32 %0, m0\n\ts_mov_b32 m0, %2\n\ts_nop 0\n\tglobal_load_lds_dwordx4 %1, off\n\ts_mov_b32 m0, %0" : "=&s"(keep) : "v"(gsrc), "s"(lds_dst) : "memory"); }
typedef float f32x2_t __attribute__((ext_vector_type(2))); typedef __bf16 bf16x2_t __attribute__((ext_vector_type(2)));
__device__ __forceinline__ unsigned cvtpk_s(float lo, float hi) { f32x2_t v = {lo, hi}; bf16x2_t b = __builtin_convertvector(v, bf16x2_t); return __builtin_bit_cast(unsigned, b); }
#define WAIT_BAR(N) asm volatile("s_waitcnt vmcnt(" #N ") lgkmcnt(0)\n\ts_barrier" ::: "memory")

__device__ __forceinline__ void kload8(bf16x8* kf, const LAS char* Kslot, int r32, int hi);
__device__ __forceinline__ void qkt_r(f32x16& p0, f32x16& p1, const bf16x8* kf, const bf16x8* qr, const f32x16& negm);
__device__ __forceinline__ void qkt(f32x16& p0, f32x16& p1, const LAS char* Kslot, const bf16x8* qr, const f32x16& negm, int r32, int hi) { bf16x8 kf[8]; kload8(kf, Kslot, r32, hi); qkt_r(p0, p1, kf, qr, negm); }
__device__ __forceinline__ float fadd_s(float a, float b) { float r; asm("v_add_f32_e32 %0, %1, %2" : "=v"(r) : "v"(a), "v"(b)); return r; }
__device__ __forceinline__ void kload8(bf16x8* kf, const LAS char* Kslot, int r32, int hi) {
  const unsigned a0 = (unsigned)(uintptr_t)Kslot + r32 * 128 + ((hi ^ ((r32 >> 1) & 7)) << 4);
  #pragma unroll
  for (int d0 = 0; d0 < 4; ++d0) { const LAS char* kb = (const LAS char*)(uintptr_t)(a0 ^ (d0 << 5)); kf[2 * d0] = *(const LAS bf16x8*)(kb); kf[2 * d0 + 1] = *(const LAS bf16x8*)(kb + 4096); }
}
__device__ __forceinline__ void qkt_r(f32x16& p0, f32x16& p1, const bf16x8* kf, const bf16x8* qr, const f32x16& negm) {
  asm volatile("v_mfma_f32_32x32x16_bf16 %0, %1, %2, %3" : "=&v"(p0) : "v"(kf[0]), "v"(qr[0]), "v"(negm));
  asm volatile("v_mfma_f32_32x32x16_bf16 %0, %1, %2, %3" : "=&v"(p1) : "v"(kf[1]), "v"(qr[0]), "v"(negm));
  #pragma unroll
  for (int d0 = 1; d0 < 4; ++d0) {
    asm volatile("v_mfma_f32_32x32x16_bf16 %0, %1, %2, %0" : "+v"(p0) : "v"(kf[2 * d0]), "v"(qr[d0]));
    asm volatile("v_mfma_f32_32x32x16_bf16 %0, %1, %2, %0" : "+v"(p1) : "v"(kf[2 * d0 + 1]), "v"(qr[d0])); }
}
#define MX3(a, b, c) __builtin_fmaxf(__builtin_fmaxf((a), (b)), (c))
__device__ __forceinline__ float rowmax(const f32x16& p0, const f32x16& p1) {
  float a = MX3(p0[0], p0[1], p1[0]), b = MX3(p0[2], p0[3], p1[1]); a = MX3(a, p1[2], p1[3]);
  #pragma unroll
  for (int r = 4; r < 16; r += 4) { a = MX3(a, p0[r], p0[r + 1]); b = MX3(b, p0[r + 2], p0[r + 3]); a = MX3(a, p1[r], p1[r + 1]); b = MX3(b, p1[r + 2], p1[r + 3]); }
  float rm = __builtin_fmaxf(a, b);
  auto rr = __builtin_amdgcn_permlane32_swap(__float_as_uint(rm), __float_as_uint(rm), false, false);
  return __builtin_fmaxf(__uint_as_float(rr[0]), __uint_as_float(rr[1]));
}
__device__ __forceinline__ void bmask(f32x16& p0, f32x16& p1, int jb, int qrel, int hi, const LAS float* tab) {
  const unsigned ta = (unsigned)(uintptr_t)(tab + (255 + qrel - 64 * jb - 4 * hi - 59));
  #pragma unroll
  for (int g = 0; g < 4; ++g) {
    float a0, a1, a2, a3, b0, b1, b2, b3;
    asm volatile("ds_read_b32 %0, %8 offset:%c9\n\tds_read_b32 %1, %8 offset:%c10\n\tds_read_b32 %2, %8 offset:%c11\n\tds_read_b32 %3, %8 offset:%c12\n\t"
                 "ds_read_b32 %4, %8 offset:%c13\n\tds_read_b32 %5, %8 offset:%c14\n\tds_read_b32 %6, %8 offset:%c15\n\tds_read_b32 %7, %8 offset:%c16\n\ts_waitcnt lgkmcnt(0)"
                 : "=&v"(a0), "=&v"(a1), "=&v"(a2), "=&v"(a3), "=&v"(b0), "=&v"(b1), "=&v"(b2), "=&v"(b3)
                 : "v"(ta), "i"(4 * (59 - 8 * g)), "i"(4 * (59 - 8 * g - 1)), "i"(4 * (59 - 8 * g - 2)), "i"(4 * (59 - 8 * g - 3)),
                   "i"(4 * (59 - 8 * g - 32)), "i"(4 * (59 - 8 * g - 33)), "i"(4 * (59 - 8 * g - 34)), "i"(4 * (59 - 8 * g - 35)) : "memory");
    p0[4 * g] += a0; p0[4 * g + 1] += a1; p0[4 * g + 2] += a2; p0[4 * g + 3] += a3;
    p1[4 * g] += b0; p1[4 * g + 1] += b1; p1[4 * g + 2] += b2; p1[4 * g + 3] += b3;
  }
}
template <int ND>
__device__ __forceinline__ void pv(f32x16* o, int vb, bf16x8 pa0, bf16x8 pa1, bf16x8 pa2, bf16x8 pa3) {
  #pragma unroll
  for (int d0 = 0; d0 < ND; d0 += 2) { s16x4 lo[2][4], hi[2][4];
    #pragma unroll
    for (int e = 0; e < 2; ++e)
      #pragma unroll
      for (int ks = 0; ks < 4; ++ks) {
        asm volatile("ds_read_b64_tr_b16 %0,%1 offset:%c2" : "=&v"(lo[e][ks]) : "v"(vb), "i"((d0 + e) * 4096 + ks * 1024) : "memory");
        asm volatile("ds_read_b64_tr_b16 %0,%1 offset:%c2" : "=&v"(hi[e][ks]) : "v"(vb), "i"((d0 + e) * 4096 + ks * 1024 + 512) : "memory"); }
    asm volatile("s_waitcnt lgkmcnt(0)" ::: "memory"); SBAR();
    #define PK(e, k) (bf16x8){lo[e][k][0], lo[e][k][1], lo[e][k][2], lo[e][k][3], hi[e][k][0], hi[e][k][1], hi[e][k][2], hi[e][k][3]}
    o[d0]     = __builtin_amdgcn_mfma_f32_32x32x16_bf16(pa0, PK(0, 0), o[d0], 0, 0, 0);
    o[d0 + 1] = __builtin_amdgcn_mfma_f32_32x32x16_bf16(pa0, PK(1, 0), o[d0 + 1], 0, 0, 0);
    o[d0]     = __builtin_amdgcn_mfma_f32_32x32x16_bf16(pa1, PK(0, 1), o[d0], 0, 0, 0);
    o[d0 + 1] = __builtin_amdgcn_mfma_f32_32x32x16_bf16(pa1, PK(1, 1), o[d0 + 1], 0, 0, 0);
    o[d0]     = __builtin_amdgcn_mfma_f32_32x32x16_bf16(pa2, PK(0, 2), o[d0], 0, 0, 0);
    o[d0 + 1] = __builtin_amdgcn_mfma_f32_32x32x16_bf16(pa2, PK(1, 2), o[d0 + 1], 0, 0, 0);
    o[d0]     = __builtin_amdgcn_mfma_f32_32x32x16_bf16(pa3, PK(0, 3), o[d0], 0, 0, 0);
    o[d0 + 1] = __builtin_amdgcn_mfma_f32_32x32x16_bf16(pa3, PK(1, 3), o[d0 + 1], 0, 0, 0);
    #undef PK
    SBAR();
  }
}

#ifndef MK_TIM
#define MK_TIM 0
#endif
#if MK_TIM
__device__ unsigned long long g_tim[2];
#endif
template <int THRL, int PQ, int PO, int NV>
__device__ __forceinline__ void attn_unit(const bf16_t* Qp, const bf16_t* __restrict__ Kp, const bf16_t* __restrict__ Vp, bf16_t* Op, const int NT, const float mfloor, const float sink2, char* shm, const int dbg = 0,
                                          const bf16_t* O1p = nullptr, const float lam = 0.f, const float* gsub = nullptr, const float post = 0.f) {
  constexpr int ND = 2 * NV;
  int tid = threadIdx.x; asm volatile("" : "+v"(tid));
  const int lane = tid & 63, r32 = lane & 31, hi = lane >> 5; const int wid = __builtin_amdgcn_readfirstlane(tid >> 6);
  const unsigned lds0 = (unsigned)(uintptr_t)shm;
  const LAS char* shm3 = (const LAS char*)shm;
  LAS float* wsf = (LAS float*)((LAS char*)shm + LDS_WS) + wid * 64;
  const LAS float* tab = (const LAS float*)((LAS char*)shm + LDS_TAB);
  const bf16_t* Qw = Qp + (long)(wid * QBLK) * PQ;
  bf16x8 qr[4];
  #pragma unroll
  for (int d0 = 0; d0 < 4; ++d0) qr[d0] = *reinterpret_cast<const bf16x8*>(&Qw[(long)r32 * PQ + d0 * 16 + hi * 8]);
  const bf16_t* ksrc = Kp + (long)(8 * wid + (lane >> 3)) * PQ + (((lane & 7) ^ ((4 * wid + (lane >> 4)) & 7)) * 8);
  const bf16_t* vsrc = Vp + (long)(8 * wid + (lane >> 3)) * PQ + ((((lane >> 2) ^ (lane >> 4)) & 1) * 32) + (lane & 3) * 8;
  const unsigned kdst = lds0 + LDS_K + wid * 1024, vdst = lds0 + LDS_V + wid * 1024;
  #define DMA_K(t, sl) glds16(ksrc + (long)(t) * KVBLK * PQ, (unsigned)__builtin_amdgcn_readfirstlane(kdst + (sl) * SLOTK))
#ifndef MK_DMAX
#define MK_DMAX 0
#endif
  #define DMA_V(t, sl) do { if (MK_DMAX == 1) break; if (MK_DMAX == 2) { const long go_ = (long)(t) * KVBLK * PQ; asm volatile("global_load_lds_dwordx4 %0, off\n\tglobal_load_lds_dwordx4 %1, off" :: "v"(vsrc + go_), "v"(vsrc + go_ + 64) : "memory"); break; } \
      if (MK_DMAX == 3) { const long go_ = (long)(t) * KVBLK * PQ; asm volatile("s_mov_b32 m0, %1\n\ts_nop 0\n\tglobal_load_lds_dwordx4 %0, off" :: "v"(vsrc + go_), "s"((unsigned)__builtin_amdgcn_readfirstlane(vdst + (sl) * SLOTV)) : "memory"); \
        asm volatile("s_mov_b32 m0, %1\n\ts_nop 0\n\tglobal_load_lds_dwordx4 %0, off" :: "v"(vsrc + go_ + 64), "s"((unsigned)__builtin_amdgcn_readfirstlane(vdst + (sl) * SLOTV + 8192)) : "memory"); break; } \
      DMA_V_(t, sl); } while (0)
  #define DMA_V_(t, sl) do { const long go_ = (long)(t) * KVBLK * PQ; glds16(vsrc + go_, (unsigned)__builtin_amdgcn_readfirstlane(vdst + (sl) * SLOTV)); \
      if (NV == 2) glds16(vsrc + go_ + 64, (unsigned)__builtin_amdgcn_readfirstlane(vdst + (sl) * SLOTV + 8192)); } while (0)
  const int vb0 = (int)(lds0 + LDS_V) + (4 * hi + ((lane & 15) >> 2)) * 128 + ((lane >> 3) & 1) * 64 + ((lane >> 4) & 1) * 32 + (lane & 3) * 8;
  float mhat = mfloor, l_reg = 0.f; f32x16 o[ND], negm;
  { float zf = 0.f; asm volatile("" : "+v"(zf));
    _Pragma("unroll") for (int r = 0; r < 16; ++r) { _Pragma("unroll") for (int d = 0; d < ND; ++d) o[d][r] = zf; negm[r] = -mhat; } }
  const int qrel = wid * QBLK + r32;
  DMA_K(0, 0); DMA_V(0, 3); DMA_K(1, 1); DMA_V(0, 0); DMA_K(2, 2); DMA_V(1, 1);
  asm volatile("" :: "v"(qr[0]), "v"(qr[1]), "v"(qr[2]), "v"(qr[3]));
  const int grp = wid >> 2;
  u32x4 pw0, pw1, pw2, pw3; pw0 = pw1 = pw2 = pw3 = (u32x4){0u, 0u, 0u, 0u};
  bool resc = false;
  f32x16 c0, c1;
#ifndef ATT_STAGGER
#define ATT_STAGGER 0
#endif
  if (ATT_STAGGER && grp == 1) { if (NV == 2) WAIT_BAR(6); else WAIT_BAR(4); }
  bf16x8 kf[8];
#ifndef ATT_QKAHEAD
#define ATT_QKAHEAD 0
#endif
  if (!ATT_STAGGER) { if (NV == 2) WAIT_BAR(8); else WAIT_BAR(5); kload8(kf, shm3 + LDS_K, r32, hi); if (ATT_QKAHEAD) { qkt_r(c0, c1, kf, qr, negm); SBAR(); } }
#if MK_TIM
  unsigned long long tim_a = 0ull; unsigned tim_sum = 0u, tim_cnt = 0u; bool tim_have = false;
  #define TIM_AT(k) do { if (NV == 2 && ((k) == MK_TIM_A || (k) == MK_TIM_B)) { unsigned long long tn_; asm volatile("s_memtime %0\n\ts_waitcnt lgkmcnt(0)" : "=s"(tn_) :: "memory"); \
      if ((k) == MK_TIM_B && tim_have) { tim_sum += (unsigned)(tn_ - tim_a); ++tim_cnt; } \
      if ((k) == MK_TIM_A) { tim_a = tn_; tim_have = true; } } } while (0)
#else
  #define TIM_AT(k) do { } while (0)
#endif
#ifndef ATT_SPREAD
#define ATT_SPREAD 0
#endif
#ifndef ATT_DMAPT
#define ATT_DMAPT 1
#endif
  #define DMA_PT(k) do { if ((NV == 2 && ATT_SPREAD) ? (wid == (k)) : ((k) == ATT_DMAPT)) { const int tk_ = t + 3 < NT ? t + 3 : NT - 1, tv_ = t + 2 < NT ? t + 2 : NT - 1; DMA_K(tk_, (t + 3) & 3); DMA_V(tv_, (t + 2) & 3); } } while (0)
  #pragma unroll 1
  for (int t = 0; t <= NT; ++t) {
    TIM_AT(0);
    if (dbg & 32) { } else if (ATT_STAGGER) { if (NV == 2) WAIT_BAR(6); else WAIT_BAR(4); } else { if (NV == 2) WAIT_BAR(5); else WAIT_BAR(3); }
    TIM_AT(1);
    DMA_PT(0);
    TIM_AT(2);
    if (ATT_QKAHEAD) { kload8(kf, shm3 + LDS_K + ((t + 1) & 3) * SLOTK, r32, hi); SBAR(); TIM_AT(3); DMA_PT(1); }
    else { qkt_r(c0, c1, kf, qr, negm); SBAR(); TIM_AT(3); kload8(kf, shm3 + LDS_K + ((t + 1) & 3) * SLOTK, r32, hi); SBAR(); DMA_PT(1); }
    SBAR();
    const int jb = t - (NT - 4);
    if (jb >= -2 && jb <= 3) bmask(c0, c1, jb, qrel, hi, tab);
    const float rm = rowmax(c0, c1);
    if (t < NT && __any(rm > (float)THRL)) {
      const float dl = __builtin_fmaxf(rm, 0.f);
      mhat += dl;
      #pragma unroll
      for (int r = 0; r < 16; ++r) { c0[r] -= dl; c1[r] -= dl; negm[r] = -mhat; }
      const float f = __builtin_amdgcn_exp2f(-dl); l_reg *= f;
      if (hi == 0) wsf[r32] = f;
      resc = true;
    }
    if ((dbg & 32) || !ATT_STAGGER) { } else if (NV == 2) WAIT_BAR(5); else WAIT_BAR(3);
    if (ATT_STAGGER) { const int tk = t + 3 < NT ? t + 3 : NT - 1, tv = t + 2 < NT ? t + 2 : NT - 1;
      if (!(dbg & 4)) { DMA_K(tk, (t + 3) & 3); DMA_V(tv, (t + 2) & 3); } }
    { const int vb = vb0 + ((t + 3) & 3) * SLOTV, vbo = vb ^ 64;
      s16x4 lo[2][4], hi_[2][4];
      #define RD(b, d0) do { _Pragma("unroll") for (int ks = 0; ks < 4; ++ks) { \
          asm volatile("ds_read_b64_tr_b16 %0,%1 offset:%c2" : "=v"(lo[b][ks]) : "v"(((d0) & 1) ? vbo : vb), "i"(((d0) >> 1) * 8192 + ks * 2048) : "memory"); \
          asm volatile("ds_read_b64_tr_b16 %0,%1 offset:%c2" : "=v"(hi_[b][ks]) : "v"(((d0) & 1) ? vbo : vb), "i"(((d0) >> 1) * 8192 + ks * 2048 + 1024) : "memory"); } } while (0)
      #define WT(b) asm volatile("s_waitcnt lgkmcnt(0)" : "+v"(lo[b][0]), "+v"(lo[b][1]), "+v"(lo[b][2]), "+v"(lo[b][3]), "+v"(hi_[b][0]), "+v"(hi_[b][1]), "+v"(hi_[b][2]), "+v"(hi_[b][3]) :: "memory")
      #define PK(b, k) (bf16x8){lo[b][k][0], lo[b][k][1], lo[b][k][2], lo[b][k][3], hi_[b][k][0], hi_[b][k][1], hi_[b][k][2], hi_[b][k][3]}
      #define EXQ(e) do { if (dbg & 1) { if ((e) < 16) c0[(e)] = 0.25f; else c1[(e) - 16] = 0.25f; } else if ((e) < 16) { c0[(e)] = __builtin_amdgcn_exp2f(c0[(e)]); } else { c1[(e) - 16] = __builtin_amdgcn_exp2f(c1[(e) - 16]); } } while (0)
      #define CE(e) ((e) < 16 ? c0[(e) & 15] : c1[(e) & 15])
      #define SUMQ(e) do { if ((e) >= 0) { if ((e) & 1) so_ = fadd_s(so_, CE(e)); else se_ = fadd_s(se_, CE(e)); } } while (0)
      constexpr int EPM = 32 / (4 * ND);
      #define MM(b, d0) do { _Pragma("unroll") for (int k = 0; k < 4; ++k) { \
          const bf16x8 pa_ = __builtin_bit_cast(bf16x8, k == 0 ? pw0 : k == 1 ? pw1 : k == 2 ? pw2 : pw3); \
          if (!(dbg & 2)) o[d0] = __builtin_amdgcn_mfma_f32_32x32x16_bf16(pa_, PK(b, k), o[d0], 0, 0, 0); \
          _Pragma("unroll") for (int x = 0; x < EPM; ++x) EXQ(((d0) * 4 + k) * EPM + x); \
          _Pragma("unroll") for (int x = 0; x < EPM; ++x) SUMQ(((d0) * 4 + k) * EPM + x - EPM); \
          asm volatile("" : "+v"(c0), "+v"(c1)); SBAR(); } } while (0)
      DMA_PT(2);
      float se_ = 0.f, so_ = 0.f;
      if (!(dbg & 16)) { RD(0, 0); WT(0); } else { _Pragma("unroll") for (int b_ = 0; b_ < 2; ++b_) _Pragma("unroll") for (int k_ = 0; k_ < 4; ++k_) { lo[b_][k_] = (s16x4){0, 0, 0, 0}; hi_[b_][k_] = (s16x4){0, 0, 0, 0}; } }
      #pragma unroll
      for (int d0 = 0; d0 < ND; ++d0) {
        if (d0 + 1 < ND && !(dbg & 16)) { if ((d0 & 1) == 0) RD(1, d0 + 1); else RD(0, d0 + 1); }
        SBAR();
        if (ND == 4) DMA_PT(3 + d0);
        if ((d0 & 1) == 0) MM(0, d0); else MM(1, d0);
        if (d0 + 1 < ND && !(dbg & 16)) { if ((d0 & 1) == 0) WT(1); else WT(0); }
      }
      _Pragma("unroll") for (int x = 0; x < EPM; ++x) SUMQ(32 - EPM + x);
      if (t < NT) l_reg += se_ + so_;
      DMA_PT(7);
      #undef RD
      #undef WT
      #undef PK
      #undef EXQ
      #undef MM
      #undef SUMQ
      #undef CE
    }
    TIM_AT(5);
    if (resc) { resc = false;
      asm volatile("s_waitcnt lgkmcnt(0)" ::: "memory");
      #pragma unroll
      for (int c8 = 0; c8 < 2; ++c8) { float fr_[8];
        #pragma unroll
        for (int r = 0; r < 8; ++r) fr_[r] = wsf[crow(8 * c8 + r, hi)];
        asm volatile("s_waitcnt lgkmcnt(0)" ::: "memory");
        #pragma unroll
        for (int r = 0; r < 8; ++r)
          #pragma unroll
          for (int d = 0; d < ND; ++d) o[d][8 * c8 + r] *= fr_[r]; } }
    if (t < NT) {
      #define PKW(P, B) cvtpk_s(P[B], P[B + 1])
      pw0 = (u32x4){PKW(c0, 0), PKW(c0, 2), PKW(c0, 4), PKW(c0, 6)}; pw1 = (u32x4){PKW(c0, 8), PKW(c0, 10), PKW(c0, 12), PKW(c0, 14)};
      pw2 = (u32x4){PKW(c1, 0), PKW(c1, 2), PKW(c1, 4), PKW(c1, 6)}; pw3 = (u32x4){PKW(c1, 8), PKW(c1, 10), PKW(c1, 12), PKW(c1, 14)};
      #undef PKW
      if (ATT_QKAHEAD) { SBAR(); qkt_r(c0, c1, kf, qr, negm); SBAR(); }
    }
  }
  if (ATT_STAGGER && grp == 0) asm volatile("s_barrier" ::: "memory");
#if MK_TIM
  if (NV == 2 && lane == 0 && tim_cnt) { atomicAdd(&g_tim[0], (unsigned long long)tim_sum); atomicAdd(&g_tim[1], (unsigned long long)tim_cnt); }
#endif
  { auto rr = __builtin_amdgcn_permlane32_swap(__float_as_uint(l_reg), __float_as_uint(l_reg), false, false); l_reg = __uint_as_float(rr[0]) + __uint_as_float(rr[1]); }
  l_reg += __builtin_amdgcn_exp2f(sink2 - mhat);
  if (hi == 0) wsf[32 + r32] = l_reg;
  asm volatile("s_waitcnt vmcnt(0) lgkmcnt(0)\n\ts_barrier" ::: "memory");
  float rli[16];
  #pragma unroll
  for (int c8 = 0; c8 < 2; ++c8) {
    #pragma unroll
    for (int r = 0; r < 8; ++r) rli[8 * c8 + r] = wsf[32 + crow(8 * c8 + r, hi)];
    asm volatile("s_waitcnt lgkmcnt(0)" ::: "memory"); }
  #pragma unroll
  for (int r = 0; r < 16; ++r) rli[r] = __builtin_amdgcn_rcpf(rli[r]);
  bf16_t* Ow = Op + (long)(wid * QBLK) * PO;
  { LAS bf16_t* stg = (LAS bf16_t*)((LAS char*)shm) + wid * (32 * 64 * NV);
    #pragma unroll
    for (int r = 0; r < 16; ++r) { const int orow = crow(r, hi);
      #pragma unroll
      for (int d0 = 0; d0 < ND; ++d0) stg[orow * (64 * NV) + d0 * 32 + r32] = (bf16_t)(cvtpk_s(o[d0][r] * rli[r], 0.f) & 0xffffu); }
    asm volatile("s_waitcnt lgkmcnt(0)" ::: "memory");
    constexpr int CPR = 8 * NV, RPI = 64 / CPR;
    if (NV == 2 && O1p != nullptr) {
      const bf16_t* O1w = O1p + (long)(wid * QBLK) * PO; const int ch = lane % CPR;
      float gv[8];
      { const f32x4 ga = *(const f32x4*)(gsub + ch * 8), gb = *(const f32x4*)(gsub + ch * 8 + 4);
        gv[0] = ga[0] * post; gv[1] = ga[1] * post; gv[2] = ga[2] * post; gv[3] = ga[3] * post; gv[4] = gb[0] * post; gv[5] = gb[1] * post; gv[6] = gb[2] * post; gv[7] = gb[3] * post; }
      #pragma unroll
      for (int i = 0; i < 32 / RPI; ++i) { const int row = i * RPI + lane / CPR;
        const u32x4 q = *(const LAS u32x4*)(stg + row * (64 * NV) + ch * 8); const u32x4 p = *(const u32x4*)(O1w + (long)row * PO + ch * 8);
        float x[8];
        x[0] = bf_lo(p.x) - lam * bf_lo(q.x); x[1] = bf_hi(p.x) - lam * bf_hi(q.x); x[2] = bf_lo(p.y) - lam * bf_lo(q.y); x[3] = bf_hi(p.y) - lam * bf_hi(q.y);
        x[4] = bf_lo(p.z) - lam * bf_lo(q.z); x[5] = bf_hi(p.z) - lam * bf_hi(q.z); x[6] = bf_lo(p.w) - lam * bf_lo(q.w); x[7] = bf_hi(p.w) - lam * bf_hi(q.w);
        float ss = 0.f;
        #pragma unroll
        for (int k = 0; k < 8; ++k) ss += x[k] * x[k];
        #pragma unroll
        for (int sh = 1; sh < 16; sh <<= 1) ss += __int_as_float(__builtin_amdgcn_ds_bpermute((lane ^ sh) << 2, __float_as_int(ss)));
        const float rn = 1.0f / sqrtf(ss * (1.0f / 128.0f) + SUBLN_EPS);
        u32x4 w; w.x = cvtpk_s(x[0] * rn * gv[0], x[1] * rn * gv[1]); w.y = cvtpk_s(x[2] * rn * gv[2], x[3] * rn * gv[3]);
        w.z = cvtpk_s(x[4] * rn * gv[4], x[5] * rn * gv[5]); w.w = cvtpk_s(x[6] * rn * gv[6], x[7] * rn * gv[7]);
        *(u32x4*)(Ow + (long)row * PO + ch * 8) = w; }
    } else {
    #pragma unroll
    for (int i = 0; i < 32 / RPI; ++i) { const int row = i * RPI + lane / CPR, ch = lane % CPR; const u32x4 v = *(const LAS u32x4*)(stg + row * (64 * NV) + ch * 8); *(u32x4*)(Ow + (long)row * PO + ch * 8) = v; } } }
  asm volatile("s_waitcnt lgkmcnt(0)\n\ts_barrier" ::: "memory");
  #undef DMA_K
  #undef DMA_V
}
#undef SBAR
#undef WAIT_BAR
#undef MX3
}
#ifndef XC_SLOT
#define XC_SLOT(b) (2)
#endif
constexpr size_t MiB = 1u << 20;
constexpr size_t WS_CTL = 0, CTL_ZERO_BYTES = 1 * MiB;
constexpr size_t WS_MOD = 1 * MiB;
constexpr size_t WS_LAM = WS_MOD + 512 * 1024;
constexpr size_t WS_WIN = 2 * MiB;
constexpr size_t WS_WOA = 20 * MiB, WS_WOB = 22 * MiB;
constexpr size_t WS_WR = 24 * MiB;
constexpr size_t WS_WGU = 32 * MiB;
constexpr size_t WS_WD = 288 * MiB;
constexpr size_t WS_H = 416 * MiB;
constexpr size_t WS_P = 480 * MiB;
constexpr size_t WS_OA = 752 * MiB, WS_OD = 784 * MiB, WS_OB = 848 * MiB;
constexpr size_t WS_YA = 880 * MiB, WS_Y = 944 * MiB;
constexpr size_t WS_LOG = 1008 * MiB;
constexpr size_t WS_LIST = 1012 * MiB;
constexpr size_t WS_WSLOT = 1016 * MiB;
constexpr size_t WS_LISTW = 1017 * MiB;
constexpr size_t WS_ACT = 1024 * MiB;
constexpr size_t WS_YS = 1296 * MiB;
constexpr size_t WS_SPOS = 1021 * MiB;
constexpr size_t WS_H8 = 1568 * MiB;
constexpr size_t WS_H8M = 1600 * MiB;
constexpr size_t WS_WIN8 = 14 * MiB;
constexpr size_t WS_END = 1632 * MiB;
static_assert((size_t)ACT_ROWS * D * 2 <= WS_H8 - WS_YS && (size_t)ACT_ROWS * FF * 2 <= WS_YS - WS_ACT && (size_t)M * INW * 2 <= WS_OA - WS_P, "ws map");
constexpr int CW_BAR = 4096;
constexpr int CW_CNT = 8192;
constexpr int CW_Q = 16384;

constexpr int RING_OFF = 0, RING_BYTES = 131072;
constexpr int LDSCTL_OFF = RING_BYTES;
constexpr int LW_TOFF = 64, LW_CL = 128, LW_LCNT = 192, LW_LBASE = 256, LW_QK = 320;
constexpr int LDS_BYTES = 147456;
static_assert(attn_body::LDS_BYTES <= RING_BYTES && pg8::STAGE_BYTES <= RING_BYTES, "ring");

#define RLX_AGENT __ATOMIC_RELAXED, __HIP_MEMORY_SCOPE_AGENT
#define LDS_WAIT() asm volatile("s_waitcnt lgkmcnt(0)" ::: "memory")
__device__ __forceinline__ unsigned f2bf(float f) { unsigned u = __builtin_bit_cast(unsigned, f); return (u + 0x7fffu + ((u >> 16) & 1u)) >> 16; }
__device__ __forceinline__ unsigned pk2(float lo, float hi) { return f2bf(lo) | (f2bf(hi) << 16); }

#define XB_TMO      128
#define XB_XCNT(j)  (256  + 64 * (j))
#define XB_XSUB(j)  (1280 + 64 * (j))
#define XB_XGEN(j)  (2304 + 64 * (j))
#define XB_TOP      3328
#define XB_TOPGEN   3392
#define XCD_BAR_WORDS 3456
#define XB_SPIN_CAP (1u << 18)
__device__ __forceinline__ unsigned xb_ld(unsigned* p)              { return __hip_atomic_load(p, __ATOMIC_RELAXED, __HIP_MEMORY_SCOPE_AGENT); }
__device__ __forceinline__ unsigned xb_add(unsigned* p, unsigned v) { return __hip_atomic_fetch_add(p, v, __ATOMIC_RELAXED, __HIP_MEMORY_SCOPE_AGENT); }
__device__ __forceinline__ unsigned xb_xcc_id() { return (unsigned)__builtin_amdgcn_s_getreg((3 << 11) | 20) & 0xFu; }
#define XB_SPIN(cond, bar) do { unsigned _sp = 0; while (cond) { __builtin_amdgcn_s_sleep(1); \
    if ((++_sp & 255u) == 0u) { if (xb_ld(&(bar)[XB_TMO])) break; if (_sp > XB_SPIN_CAP) { atomicAdd(&(bar)[XB_TMO], 1u); break; } } } } while (0)
struct XcdBarrier { unsigned* bar; unsigned x; volatile LAS unsigned* st; };
__device__ __forceinline__ XcdBarrier xcd_barrier_post(unsigned* bar, volatile LAS unsigned* st) {
    XcdBarrier b; b.bar = bar; b.x = xb_xcc_id(); b.st = st;
    if (threadIdx.x == 0) (void)xb_add(&bar[XB_XCNT(b.x)], 1u);
    return b;
}
__device__ __forceinline__ void xcd_barrier_complete(unsigned* bar, unsigned x, unsigned& nloc, unsigned& nx) {
    const unsigned G = gridDim.x * gridDim.y * gridDim.z;
    unsigned sum, cnt, mine, sp = 0u;
    for (;;) {
        sum = 0u; cnt = 0u; mine = 0u;
#pragma unroll
        for (unsigned j = 0; j < 16; ++j) { const unsigned c = xb_ld(&bar[XB_XCNT(j)]); sum += c; cnt += (c > 0u) ? 1u : 0u; mine = (j == x) ? c : mine; }
        if (sum == G) break;
        __builtin_amdgcn_s_sleep(1);
        if ((++sp & 255u) == 0u) { if (xb_ld(&bar[XB_TMO])) break; if (sp > XB_SPIN_CAP) { atomicAdd(&bar[XB_TMO], 1u); break; } }
    }
    nloc = mine > 0u ? mine : 1u; nx = cnt > 0u ? cnt : 1u;
}
__device__ __forceinline__ void xcd_barrier(const XcdBarrier& b) {
    asm volatile("s_waitcnt vmcnt(0)" ::: "memory");
    __syncthreads();
    if (threadIdx.x == 0) {
        unsigned* bar = b.bar; unsigned bx_ = b.x;
        asm volatile("" : "+s"(bar), "+s"(bx_));
        __builtin_amdgcn_s_waitcnt(0);
        unsigned nloc = b.st[0], nx = b.st[1];
        if (nloc == 0u) { xcd_barrier_complete(bar, bx_, nloc, nx); b.st[0] = nloc; b.st[1] = nx; }
        const unsigned old = xb_add(&bar[XB_XSUB(bx_)], 1u);
        const unsigned gen = old / nloc;
        if (old + 1u == (gen + 1u) * nloc) {
            __builtin_amdgcn_fence(__ATOMIC_RELEASE, "agent");
            asm volatile("s_waitcnt vmcnt(0)" ::: "memory");
            const unsigned og = xb_add(&bar[XB_TOP], 1u);
            const unsigned tg = og / nx;
            if (og + 1u == (tg + 1u) * nx) xb_add(&bar[XB_TOPGEN], 1u);
            else XB_SPIN(xb_ld(&bar[XB_TOPGEN]) == tg, bar);
            __builtin_amdgcn_fence(__ATOMIC_ACQUIRE, "agent");
            xb_add(&bar[XB_XGEN(bx_)], 1u);
            asm volatile("s_waitcnt vmcnt(0)" ::: "memory");
        } else {
            XB_SPIN(xb_ld(&bar[XB_XGEN(bx_)]) == gen, bar);
            __builtin_amdgcn_fence(__ATOMIC_ACQUIRE, "agent");
            asm volatile("s_waitcnt vmcnt(0)" ::: "memory");
        }
    }
    __syncthreads();
}

struct Args { const float* in[20]; float* out; unsigned char* ws; };
typedef const __attribute__((address_space(4))) Args* CArgs;
__device__ __forceinline__ CArgs launder(CArgs p) { asm volatile("" : "+s"(p)); return p; }
__device__ __forceinline__ Args load_args(CArgs p) { Args a;
#pragma unroll
    for (int i = 0; i < 20; ++i) a.in[i] = p->in[i];
    a.out = p->out; a.ws = p->ws; return a; }
constexpr int NWAVES = 8;
__device__ __forceinline__ int tid_now() { int t = threadIdx.x; asm volatile("" : "+v"(t)); return t; }
__device__ __forceinline__ float shfl_xor_l(float v, int o, int lane) { return __int_as_float(__builtin_amdgcn_ds_bpermute((lane ^ o) << 2, __float_as_int(v))); }
__device__ __forceinline__ float wave_sum(float v, int lane) {
#pragma unroll
    for (int o = 1; o < 64; o <<= 1) v += shfl_xor_l(v, o, lane);
    return v;
}
__device__ __forceinline__ float lam_init_of(int l) { return 0.8f - 0.6f * expf(-0.3f * (float)l); }
__device__ __forceinline__ int t5_bucket(int n) {
    if (n < 16) return n;
    const float v = logf((float)n / 16.0f) / 2.0794415416798357f * 16.0f;
    const int lg = 16 + (int)v; return lg < 31 ? lg : 31;
}
__device__ __forceinline__ void p0_transpose_item(const float* W, int K, int N, bf16_t* WT, int drow0, float scale, LAS float* scr, int kb, int nb, int lane) {
    const int k0 = 64 * kb, n0 = 32 * nb;
#pragma unroll 8
    for (int i = 0; i < 32; ++i) { const int kk = 2 * i + (lane >> 5); scr[kk * 33 + (lane & 31)] = W[(size_t)(k0 + kk) * N + n0 + (lane & 31)] * scale; }
    LDS_WAIT(); asm volatile("" ::: "memory");
    const int c = lane & 7;
#pragma unroll
    for (int j = 0; j < 4; ++j) { const int n = (lane >> 3) + 8 * j; const LAS float* s = scr + (8 * c) * 33 + n;
        u32x4 o; o.x = pk2(s[0 * 33], s[1 * 33]); o.y = pk2(s[2 * 33], s[3 * 33]); o.z = pk2(s[4 * 33], s[5 * 33]); o.w = pk2(s[6 * 33], s[7 * 33]);
        *(u32x4*)(WT + (size_t)(drow0 + n) * K + k0 + 8 * c) = o; }
    LDS_WAIT(); asm volatile("" ::: "memory");
}

__device__ __forceinline__ void p0_transpose64(const float* W, int K, int N, bf16_t* WT, int drow0, float scale, LAS unsigned* scr, int kb, int nb, int lane) {
    const int k0 = 64 * kb, n0 = 64 * nb, q = lane & 15, kk = lane >> 4;
    f32x4 v[16];
#pragma unroll
    for (int t = 0; t < 16; ++t) { const int k = 8 * (t >> 1) + 2 * kk + (t & 1); v[t] = *(const f32x4*)(W + (size_t)(k0 + k) * N + n0 + 4 * q); }
#pragma unroll
    for (int u = 0; u < 8; ++u)
#pragma unroll
        for (int i = 0; i < 4; ++i) scr[(4 * q + i) * 33 + 4 * u + kk] = cvt_pk_bf16(v[2 * u][i] * scale, v[2 * u + 1][i] * scale);
    LDS_WAIT(); asm volatile("" ::: "memory");
    const int nr = lane >> 3, c = lane & 7;
#pragma unroll
    for (int p = 0; p < 8; ++p) { const int n = 8 * p + nr; const LAS unsigned* s_ = scr + n * 33 + 4 * c;
        u32x4 o; o.x = s_[0]; o.y = s_[1]; o.z = s_[2]; o.w = s_[3];
        *(u32x4*)(WT + (size_t)(drow0 + n) * K + k0 + 8 * c) = o; }
    LDS_WAIT(); asm volatile("" ::: "memory");
}

template <bool NTL>
__device__ __forceinline__ void t64f8_load(f32x4 (&v)[16], const float* W, int N, int kb, int nb, int lane) {
    const int k0 = 64 * kb, n0 = 64 * nb, q = lane & 15, kk = lane >> 4;
#pragma unroll
    for (int t = 0; t < 16; ++t) { const int k = 16 * (t >> 2) + 4 * kk + (t & 3); const f32x4* p_ = (const f32x4*)(W + (size_t)(k0 + k) * N + n0 + 4 * q); v[t] = NTL ? __builtin_nontemporal_load(p_) : *p_; }
}
__device__ __forceinline__ void t64f8_proc(const f32x4 (&v)[16], int K, unsigned char* WT, int drow0, float scale, LAS unsigned* scr, int kb, int lane) {
    const int k0 = 64 * kb, q = lane & 15, kk = lane >> 4;
#pragma unroll
    for (int u = 0; u < 4; ++u)
#pragma unroll
        for (int i = 0; i < 4; ++i) scr[(4 * q + i) * 17 + 4 * u + kk] = pk4_fp8(v[4 * u][i] * scale, v[4 * u + 1][i] * scale, v[4 * u + 2][i] * scale, v[4 * u + 3][i] * scale);
    LDS_WAIT(); asm volatile("" ::: "memory");
    const int nr = lane >> 2, c = lane & 3;
#pragma unroll
    for (int p = 0; p < 4; ++p) { const int n = 16 * p + nr; const LAS unsigned* s_ = scr + n * 17 + 4 * c;
        u32x4 o; o.x = s_[0]; o.y = s_[1]; o.z = s_[2]; o.w = s_[3];
        *(u32x4*)(WT + (size_t)(drow0 + n) * K + k0 + 16 * c) = o; }
    LDS_WAIT(); asm volatile("" ::: "memory");
}
template <bool NTL = false>
__device__ __forceinline__ void p0_transpose64_f8(const float* W, int K, int N, unsigned char* WT, int drow0, float scale, LAS unsigned* scr, int kb, int nb, int lane) {
    f32x4 v[16]; t64f8_load<NTL>(v, W, N, kb, nb, lane); t64f8_proc(v, K, WT, drow0, scale, scr, kb, lane);
}

template <int MODE>
__device__ __forceinline__ void row_pass(CArgs ap, int l, int vcu, int G, const LAS int* toffl = nullptr) {
    ap = launder(ap); const int tid_ = tid_now(), lane = tid_ & 63, wave = __builtin_amdgcn_readfirstlane(tid_ >> 6); const Args a = load_args(ap);
    unsigned char* ws = a.ws;
    const float* mod = (const float*)(ws + WS_MOD);
    const bf16_t* Y = (const bf16_t*)(ws + WS_Y); const bf16_t* YS = (const bf16_t*)(ws + WS_YS); bf16_t* H = (bf16_t*)(ws + WS_H);
    const float* xin = (MODE == 0 || (MODE == 1 && l == 0)) ? a.in[0] : a.out;
    const bool need_h = (MODE != 2) || (l + 1 < DEPTH);
    const int lh = (MODE == 2) ? l + 1 : l;
    const float* gpre = (MODE == 1) ? a.in[7] + (size_t)l * D : a.in[5] + (size_t)(lh < DEPTH ? lh : 0) * D;
    const float* gpost = (MODE == 1) ? a.in[6] + (size_t)l * D : a.in[8] + (size_t)l * D;
    const int gw = vcu * NWAVES + wave, NGW = G * NWAVES, RPW = (M + NGW - 1) / NGW;
    int m0 = gw * RPW, m1 = m0 + RPW; if (m1 > M) m1 = M;
    f32x4 a_r[4], a_h[4], s_h[4]; int curb = -1;
#ifndef ROWS_PER_STEP
#define ROWS_PER_STEP 2
#endif
    constexpr int RR = ROWS_PER_STEP;
    for (int mb_ = m0; mb_ < m1; mb_ += RR) {
        const int b = mb_ / SEQ;
        if (b != curb) { curb = b;
            const float* mb = mod + (size_t)((l * BATCH + b) * 6) * D; const float* mh = mod + (size_t)(((lh < DEPTH ? lh : 0) * BATCH + b) * 6) * D;
#pragma unroll
            for (int j = 0; j < 4; ++j) { const int c = 4 * lane + 256 * j;
                if (MODE == 1) { a_r[j] = *(const f32x4*)(mb + 2 * D + c) * *(const f32x4*)(gpost + c); a_h[j] = *(const f32x4*)(gpre + c) * (*(const f32x4*)(mb + 4 * D + c) + 1.0f); s_h[j] = *(const f32x4*)(mb + 3 * D + c); }
                else { if (MODE == 2) a_r[j] = *(const f32x4*)(mb + 5 * D + c) * *(const f32x4*)(gpost + c);
                       a_h[j] = *(const f32x4*)(gpre + c) * (*(const f32x4*)(mh + 1 * D + c) + 1.0f); s_h[j] = *(const f32x4*)(mh + 0 * D + c); } } }
        f32x4 xv[RR][4], yv[RR][4]; int mrow[RR];
#pragma unroll
        for (int r = 0; r < RR; ++r) { mrow[r] = (mb_ + r < m1) ? mb_ + r : m1 - 1;
#pragma unroll
            for (int j = 0; j < 4; ++j) xv[r][j] = *(const f32x4*)(xin + (size_t)mrow[r] * D + 4 * lane + 256 * j); }
        if (MODE != 0) {
            if (MODE == 1) {
#pragma unroll
                for (int r = 0; r < RR; ++r)
#pragma unroll
                    for (int j = 0; j < 4; ++j) { const u32x2 w = *(const u32x2*)(Y + (size_t)mrow[r] * D + 4 * lane + 256 * j); yv[r][j] = (f32x4){bf_lo(w.x), bf_hi(w.x), bf_lo(w.y), bf_hi(w.y)}; }
            } else {
                u32x4 sp[RR];
#pragma unroll
                for (int r = 0; r < RR; ++r) sp[r] = *(const u32x4*)(ws + WS_SPOS + (size_t)mrow[r] * TOPK * 4);
                unsigned w8[RR][TOPK][4];
#pragma unroll
                for (int r = 0; r < RR; ++r) { int srow[TOPK];
                    srow[0] = toffl[sp[r].x >> 16] * 256 + (int)(sp[r].x & 0xffffu); srow[1] = toffl[sp[r].y >> 16] * 256 + (int)(sp[r].y & 0xffffu);
                    srow[2] = toffl[sp[r].z >> 16] * 256 + (int)(sp[r].z & 0xffffu); srow[3] = toffl[sp[r].w >> 16] * 256 + (int)(sp[r].w & 0xffffu);
#pragma unroll
                    for (int k = 0; k < TOPK; ++k)
#pragma unroll
                        for (int j = 0; j < 4; ++j) w8[r][k][j] = *(const unsigned*)((const unsigned char*)YS + (size_t)srow[k] * D + 4 * lane + 256 * j); }
#pragma unroll
                for (int r = 0; r < RR; ++r)
#pragma unroll
                    for (int j = 0; j < 4; ++j) { yv[r][j] = (f32x4){0.f, 0.f, 0.f, 0.f};
#pragma unroll
                        for (int k = 0; k < TOPK; ++k) { const auto lo2 = __builtin_amdgcn_cvt_pk_f32_fp8(w8[r][k][j], false), hi2 = __builtin_amdgcn_cvt_pk_f32_fp8(w8[r][k][j], true); yv[r][j] += (f32x4){lo2[0], lo2[1], hi2[0], hi2[1]}; }
                        yv[r][j] = yv[r][j] * (1.0f / F8_SY); }
            }
            float ss[RR];
#pragma unroll
            for (int r = 0; r < RR; ++r) { ss[r] = 0.f;
#pragma unroll
                for (int j = 0; j < 4; ++j) ss[r] += (yv[r][j].x * yv[r][j].x + yv[r][j].y * yv[r][j].y) + (yv[r][j].z * yv[r][j].z + yv[r][j].w * yv[r][j].w); }
#pragma unroll
            for (int r = 0; r < RR; ++r) { const float rn = 1.0f / sqrtf(wave_sum(ss[r], lane) * (1.0f / D) + NORM_EPS);
#pragma unroll
                for (int j = 0; j < 4; ++j) { xv[r][j] = xv[r][j] + a_r[j] * (yv[r][j] * rn); *(f32x4*)(a.out + (size_t)mrow[r] * D + 4 * lane + 256 * j) = xv[r][j]; } }
        }
        if (need_h) {
            float ss[RR];
#pragma unroll
            for (int r = 0; r < RR; ++r) { ss[r] = 0.f;
#pragma unroll
                for (int j = 0; j < 4; ++j) ss[r] += (xv[r][j].x * xv[r][j].x + xv[r][j].y * xv[r][j].y) + (xv[r][j].z * xv[r][j].z + xv[r][j].w * xv[r][j].w); }
#pragma unroll
            for (int r = 0; r < RR; ++r) { const float rn = 1.0f / sqrtf(wave_sum(ss[r], lane) * (1.0f / D) + NORM_EPS);
#pragma unroll
                for (int j = 0; j < 4; ++j) { const f32x4 h = (xv[r][j] * rn) * a_h[j] + s_h[j]; u32x2 w; w.x = cvt_pk_bf16(h.x, h.y); w.y = cvt_pk_bf16(h.z, h.w);
                    *(u32x2*)(H + (size_t)mrow[r] * D + 4 * lane + 256 * j) = w;
                    *(unsigned*)(ws + (MODE == 1 ? WS_H8 : WS_H8M) + (size_t)mrow[r] * D + 4 * lane + 256 * j) = pk4_fp8(h.x * F8_SH, h.y * F8_SH, h.z * F8_SH, h.w * F8_SH); } }
        }
    }
}

__device__ __forceinline__ void diff_combine(CArgs ap, int l, int vcu, int G) {
    ap = launder(ap); const int tid_ = tid_now(), lane = tid_ & 63, wave = __builtin_amdgcn_readfirstlane(tid_ >> 6);
    unsigned char* ws = ap->ws; struct { const float* in[14]; } a; a.in[13] = ap->in[13];
    const bf16_t* O1 = (const bf16_t*)(ws + WS_OD); const bf16_t* O2 = O1 + (size_t)M * 512; bf16_t* OB = (bf16_t*)(ws + WS_OB);
    const float lam = ((const float*)(ws + WS_LAM))[l]; const float post = 1.0f - lam_init_of(l);
    const float* g = a.in[13] + (size_t)l * 128 + (8 * lane) % 128;
    float gv[8];
#pragma unroll
    for (int i = 0; i < 8; ++i) gv[i] = g[i] * post;
    const int gw = vcu * NWAVES + wave, NGW = G * NWAVES;
    for (int m = gw; m < M; m += NGW) {
        const u32x4 p = *(const u32x4*)(O1 + (size_t)m * 512 + 8 * lane), q = *(const u32x4*)(O2 + (size_t)m * 512 + 8 * lane);
        float o[8];
        o[0] = bf_lo(p.x) - lam * bf_lo(q.x); o[1] = bf_hi(p.x) - lam * bf_hi(q.x); o[2] = bf_lo(p.y) - lam * bf_lo(q.y); o[3] = bf_hi(p.y) - lam * bf_hi(q.y);
        o[4] = bf_lo(p.z) - lam * bf_lo(q.z); o[5] = bf_hi(p.z) - lam * bf_hi(q.z); o[6] = bf_lo(p.w) - lam * bf_lo(q.w); o[7] = bf_hi(p.w) - lam * bf_hi(q.w);
        float ss = 0.f;
#pragma unroll
        for (int i = 0; i < 8; ++i) ss += o[i] * o[i];
        ss += shfl_xor_l(ss, 1, lane); ss += shfl_xor_l(ss, 2, lane); ss += shfl_xor_l(ss, 4, lane); ss += shfl_xor_l(ss, 8, lane);
        const float r = 1.0f / sqrtf(ss * (1.0f / 128.0f) + SUBLN_EPS);
        u32x4 w; w.x = cvt_pk_bf16(o[0] * r * gv[0], o[1] * r * gv[1]); w.y = cvt_pk_bf16(o[2] * r * gv[2], o[3] * r * gv[3]);
        w.z = cvt_pk_bf16(o[4] * r * gv[4], o[5] * r * gv[5]); w.w = cvt_pk_bf16(o[6] * r * gv[6], o[7] * r * gv[7]);
        *(u32x4*)(OB + (size_t)m * 512 + 8 * lane) = w;
    }
}

__device__ __forceinline__ void topk_lists(CArgs ap, int l, int G, volatile LAS unsigned* LW) {
    ap = launder(ap);
    unsigned char* ws = ap->ws;
    const float* LOG = (const float*)(ws + WS_LOG); int* LIST = (int*)(ws + WS_LIST); float* WSLOT = (float*)(ws + WS_WSLOT);
    unsigned* CNT = (unsigned*)(ws + WS_CTL) + CW_CNT + l * NE;
    int tid = threadIdx.x; asm volatile("" : "+v"(tid)); const int TPW = (M + G - 1) / G;
    for (int base = blockIdx.x * TPW, done = 0; done < TPW; done += 512) {
        if (tid < NE) LW[LW_LCNT + tid] = 0u;
        __syncthreads();
        const int m = base + done + tid; const bool act = (done + tid < TPW) && (m < M);
        int ek[TOPK]; float wk[TOPK]; unsigned lp[TOPK];
        if (act) {
            float v[NE];
#pragma unroll
            for (int q = 0; q < NE / 4; ++q) { const f32x4 t = *(const f32x4*)(LOG + (size_t)m * NE + 4 * q); v[4 * q] = t.x; v[4 * q + 1] = t.y; v[4 * q + 2] = t.z; v[4 * q + 3] = t.w; }
            unsigned taken = 0u;
#pragma unroll
            for (int k = 0; k < TOPK; ++k) { float best = -INFINITY; int bi = 0;
#pragma unroll
                for (int e = 0; e < NE; ++e) { const bool ok = !((taken >> e) & 1u) && (v[e] > best); best = ok ? v[e] : best; bi = ok ? e : bi; }
                taken |= 1u << bi; ek[k] = bi; wk[k] = best; }
            float s = 0.f; const float mx = wk[0];
#pragma unroll
            for (int k = 0; k < TOPK; ++k) { wk[k] = expf(wk[k] - mx > -80.f ? wk[k] - mx : -80.f); s += wk[k]; }
#pragma unroll
            for (int k = 0; k < TOPK; ++k) { wk[k] = wk[k] / s; lp[k] = __hip_atomic_fetch_add((LAS unsigned*)&LW[LW_LCNT + ek[k]], 1u, __ATOMIC_RELAXED, __HIP_MEMORY_SCOPE_WORKGROUP); }
        }
        __syncthreads();
        if (tid < NE) { const unsigned c = LW[LW_LCNT + tid]; LW[LW_LBASE + tid] = c ? __hip_atomic_fetch_add(CNT + tid, c, RLX_AGENT) : 0u; }
        __syncthreads();
        if (act) {
#pragma unroll
            for (int k = 0; k < TOPK; ++k) { const unsigned pos = LW[LW_LBASE + ek[k]] + lp[k]; __hip_atomic_store(LIST + (size_t)ek[k] * CAP + pos, m * TOPK + k, RLX_AGENT);
                __hip_atomic_store((float*)(ws + WS_LISTW) + (size_t)ek[k] * CAP + pos, wk[k], RLX_AGENT);
                ((unsigned*)(ws + WS_SPOS))[(size_t)m * TOPK + k] = ((unsigned)ek[k] << 16) | pos; }
        }
        __syncthreads();
    }
}

__device__ __forceinline__ void p0_prologue(CArgs ap, LAS unsigned char* lds, int vcu, int G) {
    ap = launder(ap); const Args a = load_args(ap);
    unsigned char* ws = a.ws; const int tid = tid_now(), lane = tid & 63, wave = __builtin_amdgcn_readfirstlane(tid >> 6);
    LAS float* ca = (LAS float*)(lds + RING_OFF); LAS float* red = (LAS float*)(lds + RING_OFF + 8192);
    for (int i = tid; i < BATCH * D; i += NWAVES * 64) { const float v = a.in[1][i]; ca[i] = v / (1.0f + expf(-v)); }
    __syncthreads();
    float* mod = (float*)(ws + WS_MOD);
    for (int it = blockIdx.x; it < DEPTH * (6 * D / 32); it += G) {
        const int l = it / (6 * D / 32), cg = it % (6 * D / 32), c = tid & 31, kc = tid >> 5;
        const float* w = a.in[3] + (size_t)l * D * 6 * D + cg * 32 + c;
        float s0 = 0.f, s1 = 0.f;
#pragma unroll 8
        for (int k = kc * 64; k < kc * 64 + 64; ++k) { const float wv = w[(size_t)k * 6 * D]; s0 += ca[k] * wv; s1 += ca[D + k] * wv; }
        red[(kc * 32 + c) * 2] = s0; red[(kc * 32 + c) * 2 + 1] = s1;
        __syncthreads();
        if (tid < 64) { const int cc = tid & 31, b = tid >> 5; float s = 0.f;
#pragma unroll
            for (int k = 0; k < 16; ++k) s += red[(k * 32 + cc) * 2 + b];
            mod[(size_t)(l * BATCH + b) * 6 * D + cg * 32 + cc] = s + a.in[4][(size_t)l * 6 * D + cg * 32 + cc]; }
        __syncthreads();
    }
    if (blockIdx.x == 0 && wave == 0) {
        for (int l = 0; l < DEPTH; ++l) { const float* lp = a.in[12] + (size_t)l * 256;
            const float s01 = wave_sum(lp[lane] * lp[64 + lane], lane), s23 = wave_sum(lp[128 + lane] * lp[192 + lane], lane);
            if (lane == 0) ((float*)(ws + WS_LAM))[l] = expf(s01) - expf(s23) + lam_init_of(l); }
    }
    { u32x4* z = (u32x4*)(ws + WS_WR); const u32x4 zero = {0u, 0u, 0u, 0u};
      for (int l = 0; l < DEPTH; ++l) for (int i = blockIdx.x * NWAVES * 64 + tid; i < 224 * D * 2 / 16; i += G * NWAVES * 64) z[(size_t)l * (256 * D * 2 / 16) + 32 * D * 2 / 16 + i] = zero; }
    LAS float* scr = (LAS float*)(lds + RING_OFF + wave * 16384); LAS unsigned* scru = (LAS unsigned*)scr;
    const int gw = vcu * NWAVES + wave, NGW = G * NWAVES;
    constexpr int I_IN = 16 * (INW / 64), I_O = 8 * (D / 64), I_R = 16, I_GU1 = 16 * (2 * FF / 64), I_GU = NE * I_GU1, I_D1 = 16 * (D / 64), I_DN = NE * I_D1;
    constexpr int I_LAYER = I_IN + 2 * I_O + I_R + I_GU + I_DN;
    for (int it = gw; it < DEPTH * I_LAYER; it += NGW) {
        const int l = it / I_LAYER; int r = it - l * I_LAYER;
        if (r < I_IN) { const int nblk = INW / 64, kb = r / nblk, nb = r % nblk, n0 = 64 * nb;
            const float sc = (n0 < C_KA || (n0 >= C_QB && n0 < C_KB)) ? QSCALE : 1.0f;
            if (n0 < C_GZA) p0_transpose64(a.in[9] + (size_t)l * D * INW, D, INW, (bf16_t*)(ws + WS_WIN) + (size_t)l * C_GZA * D, n0, sc, scru, kb, nb, lane);
            else p0_transpose64_f8(a.in[9] + (size_t)l * D * INW, D, INW, ws + WS_WIN8 + (size_t)l * (INW - C_GZA) * D, n0 - C_GZA, F8_SW, scru, kb, nb, lane);
            continue; }
        r -= I_IN;
        if (r < 2 * I_O) { const int half = r / I_O; r -= half * I_O; const int nblk = D / 64, kb = r / nblk, nb = r % nblk;
            p0_transpose64(a.in[10] + (size_t)l * D * D + (size_t)half * 512 * D, 512, D, (bf16_t*)(ws + (half ? WS_WOB : WS_WOA)) + (size_t)l * D * 512, 64 * nb, 1.0f, scru, kb, nb, lane); continue; }
        r -= 2 * I_O;
        if (r < I_R) { p0_transpose_item(a.in[14] + (size_t)l * D * NE, D, NE, (bf16_t*)(ws + WS_WR) + (size_t)l * 256 * D, 0, 1.0f, scr, r, 0, lane); continue; }
    }
}

__device__ __forceinline__ void expert_convert(CArgs ap, int l, LAS unsigned char* lds, int c, int G) {
    ap = launder(ap); const Args a = load_args(ap);
    unsigned char* ws = a.ws; const int tid = tid_now(), lane = tid & 63, wave = __builtin_amdgcn_readfirstlane(tid >> 6);
    LAS unsigned* scru = (LAS unsigned*)(lds + RING_OFF + wave * 4608);
    constexpr int I_GU1 = 16 * (2 * FF / 64), I_GU = NE * I_GU1, I_D1 = 16 * (D / 64), I_DN = NE * I_D1;
    const int gw = c * NWAVES + wave, NGW = G * NWAVES;
    struct Dsc { const float* W; unsigned char* WT; int K, N, drow0, kb, nb; };
    auto dsc = [&](int it) { int r = it; Dsc d;
        if (r < I_GU) { const int e = r / I_GU1; r -= e * I_GU1; const int nblk = 2 * FF / 64, kb = r / nblk, nb = r % nblk, n0 = 64 * nb; const int j = n0 % FF;
            d.W = a.in[16] + ((size_t)l * NE + e) * D * 2 * FF; d.WT = ws + WS_WGU + ((size_t)l * NE + e) * 2 * FF * D; d.K = D; d.N = 2 * FF; d.drow0 = (j / 128) * 256 + (n0 >= FF ? 128 : 0) + (j % 128); d.kb = kb; d.nb = nb; }
        else { r -= I_GU; const int e = r / I_D1; r -= e * I_D1; const int nblk = D / 64, kb = r / nblk, nb = r % nblk;
            d.W = a.in[18] + ((size_t)l * NE + e) * FF * D; d.WT = ws + WS_WD + ((size_t)l * NE + e) * D * FF; d.K = FF; d.N = D; d.drow0 = 64 * nb; d.kb = kb; d.nb = nb; }
        return d; };
    constexpr int NIT = I_GU + I_DN;
    int i0 = gw;
    if (i0 < NIT) { f32x4 va[16], vb[16]; Dsc d0 = dsc(i0); t64f8_load<true>(va, d0.W, d0.N, d0.kb, d0.nb, lane);
#pragma unroll 1
        for (;;) {
            const int i1 = i0 + NGW; Dsc d1 = d0;
            if (i1 < NIT) { d1 = dsc(i1); t64f8_load<true>(vb, d1.W, d1.N, d1.kb, d1.nb, lane); }
            t64f8_proc(va, d0.K, d0.WT, d0.drow0, F8_SW, scru, d0.kb, lane);
            if (i1 >= NIT) break;
            i0 = i1 + NGW;
            if (i0 < NIT) { d0 = dsc(i0); t64f8_load<true>(va, d0.W, d0.N, d0.kb, d0.nb, lane); }
            t64f8_proc(vb, d1.K, d1.WT, d1.drow0, F8_SW, scru, d1.kb, lane);
            if (i0 >= NIT) break;
        } }
    __syncthreads();
}

__device__ __forceinline__ void attn_fill_tab(const float* rel, int col, bool swa, LAS float* tab) {
    for (int j = tid_now(); j < attn_body::TAB_N; j += NWAVES * 64) {
        const int dist = j - 255; float v;
        if (dist < 0) v = -INFINITY;
        else if (swa) v = dist >= 128 ? -INFINITY : rel[t5_bucket(dist) * NBH + col] * LOG2E;
        else v = (rel[t5_bucket(dist < 127 ? dist : 127) * NBH + col] - rel[31 * NBH + col]) * LOG2E;
        tab[j] = v;
    }
}
#ifndef MK_ADBG
#define MK_ADBG 0
#endif
__device__ __forceinline__ void attn_phase(CArgs ap, int l, char* lds, int vcu, int G, int rep = 0) {
    ap = launder(ap);
    unsigned char* ws = ap->ws; struct { const float* in[14]; } a; a.in[2] = ap->in[2]; a.in[11] = ap->in[11]; a.in[13] = ap->in[13];
    const int dbg = rep ? MK_ADBG : 0;
    const bf16_t* P = (const bf16_t*)(ws + WS_P); bf16_t* OA = (bf16_t*)(ws + (rep ? WS_YA : WS_OA)); bf16_t* OD = (bf16_t*)(ws + (rep ? WS_YA + 32 * MiB : WS_OD)); bf16_t* OBo = (bf16_t*)(ws + (rep ? WS_Y : WS_OB));
    LAS float* tab = (LAS float*)((LAS char*)lds + attn_body::LDS_TAB);
    const float* rel = a.in[2];
    for (int v = vcu; v < 256; v += G) {
        const int u = v & 31, h = (v >> 5) & 3, b = v >> 7;
        attn_fill_tab(rel, HA + h, false, tab);
        const float lam = ((const float*)(ws + WS_LAM))[l], post = 1.0f - lam_init_of(l);
        const float* gsub = a.in[13] + (size_t)l * 128;
#pragma unroll 1
        for (int i = 0; i < 4; ++i) {
            const int mp = i & 1, qb = (i >> 1) ? u : 63 - u;
            const size_t row0 = (size_t)b * SEQ + (size_t)qb * 256;
            const bf16_t* Kp = P + (size_t)b * SEQ * PITCH + C_KB + h * 128 + mp * 64;
            const bf16_t* Vp = P + (size_t)b * SEQ * PITCH + C_VB + h * 128;
            bf16_t* O1 = OD + row0 * 512 + h * 128;
            attn_body::attn_unit<8, PITCH, 512, 2>(P + row0 * PITCH + C_QB + h * 128 + mp * 64, Kp, Vp, mp ? OBo + row0 * 512 + h * 128 : O1,
                                                   (dbg & 64) ? 4 : 4 * (qb + 1), -30.0f, -INFINITY, lds, dbg, mp ? O1 : nullptr, lam, gsub, post);
            if (!rep && i == XC_SLOT(blockIdx.x)) expert_convert(ap, l, (LAS unsigned char*)((LAS char*)lds - RING_OFF), blockIdx.x, G);
        }
        if (G == 256) {
            unsigned* Q = (unsigned*)(ws + WS_CTL) + CW_Q + (l * 2 + (rep ? 1 : 0)) * 8;
            volatile LAS unsigned* LWq = (volatile LAS unsigned*)((LAS char*)lds + LDSCTL_OFF - RING_OFF) + LW_QK;
            int qx = blockIdx.x & 7, tries = 0, cur_ha = -1, k0 = 0, kn = 0;
#pragma unroll 1
            for (;;) {
                if (k0 >= kn) {
                    if (tries >= 8) break;
                    const unsigned take = tries == 0 ? 2u : 1u;
                    if (tid_now() == 0) LWq[0] = __hip_atomic_fetch_add(Q + qx, take, RLX_AGENT);
                    __syncthreads(); k0 = (int)LWq[0]; __syncthreads();
                    kn = k0 + (int)take; kn = kn > 128 ? 128 : kn;
                    if (k0 >= 128) { qx = (qx + 1) & 7; ++tries; k0 = kn = 0; continue; }
                }
                const int id = qx * 128 + k0; ++k0;
                const int qb = id & 63, ha = (id >> 6) & 7, bb = id >> 9;
                if (ha != cur_ha) { attn_fill_tab(rel, ha, true, tab); cur_ha = ha; }
                const size_t row0 = (size_t)bb * SEQ + (size_t)qb * 256, krow = row0 - (qb ? 128 : 0);
                const float sink2 = a.in[11][l * HA + ha] * LOG2E;
                attn_body::attn_unit<8, PITCH, 512, 1>(P + row0 * PITCH + C_QA + ha * 64, P + krow * PITCH + C_KA + (ha >> 2) * 64, P + krow * PITCH + C_VA + (ha >> 2) * 64,
                                                       OA + row0 * 512 + ha * 64, qb ? 6 : 4, sink2, sink2, lds, dbg);
            }
        } else {
#pragma unroll 1
        for (int i = 0; i < 4; ++i) {
            const int id = v * 4 + i, qb = id & 63, ha = (id >> 6) & 7, bb = id >> 9;
            if (i == 0) attn_fill_tab(rel, ha, true, tab);
            const size_t row0 = (size_t)bb * SEQ + (size_t)qb * 256, krow = row0 - (qb ? 128 : 0);
            const float sink2 = a.in[11][l * HA + ha] * LOG2E;
            attn_body::attn_unit<8, PITCH, 512, 1>(P + row0 * PITCH + C_QA + ha * 64, P + krow * PITCH + C_KA + (ha >> 2) * 64, P + krow * PITCH + C_VA + (ha >> 2) * 64,
                                                   OA + row0 * 512 + ha * 64, qb ? 6 : 4, sink2, sink2, lds, dbg);
        } }
    }
}

#ifndef MK_PROBE
#define MK_PROBE 0
#endif
#ifndef MK_PFA
#define MK_PFA 0
#endif
constexpr bool PFA_ON = MK_PFA != 0;
#ifndef MK_DUP
#define MK_DUP 0
#endif
constexpr int CW_DIG = 12288;
__device__ __forceinline__ void probe_rows(CArgs ap, const bf16_t* base, int nrows_total, bool by_tile, const LAS int* toff, const LAS int* cl, int vcu, int G) {
    unsigned* DIG = (unsigned*)(launder(ap)->ws + WS_CTL) + CW_DIG;
    const int tid = tid_now(), lane = tid & 63, wave = tid >> 6;
    if (by_tile) {
        const int ntile = toff[NE];
        for (int gt = vcu; gt < ntile; gt += G) {
            int e = 0;
            for (int k = 16; k >= 1; k >>= 1) if (toff[e + k] <= gt) e += k;
            const int rt = gt - toff[e]; int nv = cl[e] - rt * 256; nv = nv > 256 ? 256 : nv;
            unsigned s = 0u;
            for (int r = wave; r < nv; r += NWAVES) { const u32x4* p = (const u32x4*)(base + ((size_t)gt * 256 + r) * 1024 + lane * 16); const u32x4 a = p[0], b = p[1];
                s += (a.x & 0xffffu) + (a.x >> 16) + (a.y & 0xffffu) + (a.y >> 16) + (a.z & 0xffffu) + (a.z >> 16) + (a.w & 0xffffu) + (a.w >> 16);
                s += (b.x & 0xffffu) + (b.x >> 16) + (b.y & 0xffffu) + (b.y >> 16) + (b.z & 0xffffu) + (b.z >> 16) + (b.w & 0xffffu) + (b.w >> 16); }
            __hip_atomic_fetch_add(DIG + e, s, RLX_AGENT);
        }
    } else {
        for (int r = vcu * NWAVES + wave; r < nrows_total; r += G * NWAVES) { const u32x4* p = (const u32x4*)(base + (size_t)r * 1024 + lane * 16); const u32x4 a = p[0], b = p[1];
            unsigned s = (a.x & 0xffffu) + (a.x >> 16) + (a.y & 0xffffu) + (a.y >> 16) + (a.z & 0xffffu) + (a.z >> 16) + (a.w & 0xffffu) + (a.w >> 16);
            s += (b.x & 0xffffu) + (b.x >> 16) + (b.y & 0xffffu) + (b.y >> 16) + (b.z & 0xffffu) + (b.z >> 16) + (b.w & 0xffffu) + (b.w >> 16);
            __hip_atomic_fetch_add(DIG + (r & 31), s, RLX_AGENT); }
    }
}
__device__ __forceinline__ void probe_lists(CArgs ap, int l, int vcu, int G) {
    unsigned char* ws = launder(ap)->ws; unsigned* DIG = (unsigned*)(ws + WS_CTL) + CW_DIG; const int* LIST = (const int*)(ws + WS_LIST);
    const int tid = tid_now();
    for (int e = vcu; e < NE; e += G) { const int cnt = (int)__hip_atomic_load((unsigned*)(ws + WS_CTL) + CW_CNT + l * NE + e, RLX_AGENT);
        unsigned s1 = 0u, s2 = 0u;
        for (int i = tid; i < cnt; i += NWAVES * 64) { const unsigned v = (unsigned)LIST[(size_t)e * CAP + i]; s1 += v; s2 += (v * 2654435761u) >> 9; }
        __hip_atomic_fetch_add(DIG + e, s1, RLX_AGENT); __hip_atomic_fetch_add(DIG + 32 + e, s2 + (unsigned)cnt * 7919u, RLX_AGENT); }
}
__device__ __forceinline__ void probe_dump(CArgs ap) {
    const CArgs aq = launder(ap); const unsigned* DIG = (const unsigned*)(aq->ws + WS_CTL) + CW_DIG; float* out = aq->out; const int tid = tid_now();
    if (blockIdx.x == 0 && tid < 64) out[tid] = (float)(__hip_atomic_load((unsigned*)DIG + tid, RLX_AGENT) & 0x7fffffu) * (1.0f / 65536.0f);
}

__device__ __forceinline__ void probe_region(CArgs ap, size_t off, size_t nwords, int G) {
    unsigned char* ws = launder(ap)->ws; unsigned* DIG = (unsigned*)(ws + WS_CTL) + CW_DIG; const unsigned* src = (const unsigned*)(ws + off);
    const int t = tid_now(); unsigned sacc = 0u;
    for (size_t i = (size_t)blockIdx.x * NWAVES * 64 + t; i < nwords; i += (size_t)G * NWAVES * 64) { const unsigned v = src[i]; sacc += (v & 0xffffu) + (v >> 16); }
    __hip_atomic_fetch_add(DIG + (t & 63), sacc, RLX_AGENT);
}
#define PROBE_AT(id, off, nwords) do { if (MK_PROBE == (id)) { probe_region(ap, off, nwords, G); GRID_BAR(); probe_dump(ap); return; } } while (0)

__global__ void __launch_bounds__(NWAVES * 64, 2) mk_fwd(Args a) {
    extern __shared__ __attribute__((aligned(16))) unsigned char lds_raw[];
    LAS unsigned char* lds = (LAS unsigned char*)lds_raw;
    volatile LAS unsigned* LW = (volatile LAS unsigned*)(lds + LDSCTL_OFF);
    const int tid = tid_now();
    const int G = gridDim.x; const int bx = blockIdx.x; const int vcu = (G % 8 == 0) ? (bx % 8) * (G / 8) + bx / 8 : bx;
    const CArgs ap = (CArgs)__builtin_amdgcn_kernarg_segment_ptr();
    for (int u = tid; u < (LDS_BYTES - LDSCTL_OFF) / 4; u += NWAVES * 64) ((LAS unsigned*)(lds + LDSCTL_OFF))[u] = 0u;
    __syncthreads();
    XcdBarrier bar = xcd_barrier_post((unsigned*)(ap->ws + WS_CTL) + CW_BAR, LW + 8);
#define GRID_BAR() xcd_barrier(bar)

#ifndef PH_MASK
#define PH_MASK 0xFFFF
#endif
#define PH(k) ((PH_MASK >> (k)) & 1)
#pragma unroll 1
    for (int rep = 0; rep < ((MK_DUP & 1) ? 2 : 1); ++rep) {
    if (PH(0)) p0_prologue(ap, lds, vcu, G);
    GRID_BAR(); }
    PROBE_AT(10, WS_MOD, (size_t)DEPTH * BATCH * 6 * D);
    PROBE_AT(11, WS_WIN, (size_t)DEPTH * INW * D / 2);
    PROBE_AT(12, WS_WOA, (size_t)4 * MiB / 4);
    if (PH(0)) row_pass<0>(ap, 0, vcu, G);
    GRID_BAR();
    PROBE_AT(13, WS_H, (size_t)M * D / 2);

#pragma unroll 1
    for (int l = 0; l < DEPTH; ++l) {
#pragma unroll 1
        for (int rep = 0; rep < ((MK_DUP & 2) ? 2 : 1); ++rep) {
        if (PH(1)) { unsigned char* ws = launder(ap)->ws; bf16_t* H = (bf16_t*)(ws + WS_H); bf16_t* P = (bf16_t*)(ws + WS_P);
          { pg8::Gemm g{H, (const bf16_t*)(ws + WS_WIN) + (size_t)l * C_GZA * D, D, 0, nullptr}; pg8::StaticOrder S; S.init(M, C_GZA, G, bx);
            pg8::EpiBf16 E{P, PITCH, 1.0f};
            pg8::gemm_phase<pg8::EpiBf16, pg8::StaticOrder, false, true>(lds + RING_OFF, g, S, E); }
          { pg8::Gemm g{(const bf16_t*)(ws + WS_H8M), (const bf16_t*)(ws + WS_WIN8 + (size_t)l * (INW - C_GZA) * D), D / 2, 0, nullptr}; pg8::StaticOrder S; S.init(M, INW - C_GZA, G, bx, 1);
            pg8::EpiBf16 E{P + C_GZA, PITCH, 1.0f / (F8_SH * F8_SW)};
            pg8::gemm_phase<pg8::EpiBf16, pg8::StaticOrder, false, true, true>(lds + RING_OFF, g, S, E); } }
        GRID_BAR(); }
        PROBE_AT(14, WS_P, (size_t)M * INW / 2);
#pragma unroll 1
        for (int rep = 0; rep < ((MK_DUP & 4) ? 2 : 1); ++rep) {
        if (PH(2)) attn_phase(ap, l, (char*)lds_raw + RING_OFF, vcu, G, rep);
        GRID_BAR(); }
        PROBE_AT(15, WS_OA, (size_t)M * 512 / 2);
        PROBE_AT(16, WS_OD, (size_t)M * 512);
        PROBE_AT(17, WS_OB, (size_t)M * 512 / 2);
        if (PH(4)) { unsigned char* ws = launder(ap)->ws; bf16_t* P = (bf16_t*)(ws + WS_P); pg8::Gemm g{(const bf16_t*)(ws + WS_OA), (const bf16_t*)(ws + WS_WOA) + (size_t)l * D * 512, 512, 0, nullptr}; pg8::StaticOrder S; S.init(M, D, G, bx);
          pg8::EpiGate<true> E{(bf16_t*)(ws + WS_YA), nullptr, P, C_GZA};
          pg8::gemm_phase<pg8::EpiGate<true>, pg8::StaticOrder, false, true>(lds + RING_OFF, g, S, E); }
        GRID_BAR();
        PROBE_AT(18, WS_YA, (size_t)M * D / 2);
        if (PH(5)) { unsigned char* ws = launder(ap)->ws; bf16_t* P = (bf16_t*)(ws + WS_P); pg8::Gemm g{(const bf16_t*)(ws + WS_OB), (const bf16_t*)(ws + WS_WOB) + (size_t)l * D * 512, 512, 0, nullptr}; pg8::StaticOrder S; S.init(M, D, G, bx);
          pg8::EpiGate<false> E{(bf16_t*)(ws + WS_Y), (const bf16_t*)(ws + WS_YA), P, C_GZB};
          pg8::gemm_phase<pg8::EpiGate<false>, pg8::StaticOrder, false, true>(lds + RING_OFF, g, S, E); }
        GRID_BAR();
        PROBE_AT(19, WS_Y, (size_t)M * D / 2);
        if (PH(6)) row_pass<1>(ap, l, vcu, G);
        if (MK_STOP == 1 || (MK_STOP == 3 && l == 1)) return;
        GRID_BAR();
        if (PH(7)) { const CArgs aq = launder(ap); unsigned char* ws = aq->ws; bf16_t* H = (bf16_t*)(ws + WS_H); pg8::Gemm g{H, (const bf16_t*)(ws + WS_WR) + (size_t)l * 256 * D, D, 0, nullptr}; pg8::StaticOrder S; S.init(M, 256, G, bx);
          pg8::EpiRouter E{(float*)(ws + WS_LOG), aq->in[15] + (size_t)l * NE};
          pg8::gemm_phase<pg8::EpiRouter, pg8::StaticOrder, false, true>(lds + RING_OFF, g, S, E); }
        GRID_BAR();
        if (MK_PROBE == 4 || MK_PROBE == 5) { unsigned char* ws = launder(ap)->ws; unsigned* DIG = (unsigned*)(ws + WS_CTL) + CW_DIG; const unsigned* src = (const unsigned*)(ws + (MK_PROBE == 4 ? WS_LOG : WS_H));
            const int n = MK_PROBE == 4 ? M * NE : M * D / 2; const int t = tid_now(); unsigned sacc = 0u;
            for (int i = blockIdx.x * NWAVES * 64 + t; i < n; i += G * NWAVES * 64) { const unsigned v = src[i]; sacc += (v & 0xffffu) + (v >> 16); }
            __hip_atomic_fetch_add(DIG + (t & 63), sacc, RLX_AGENT); GRID_BAR(); probe_dump(ap); return; }
        if (PH(8)) topk_lists(ap, l, G, LW);
        GRID_BAR();
        if (MK_PROBE == 1) { probe_lists(ap, l, vcu, G); GRID_BAR(); probe_dump(ap); return; }
        { unsigned char* ws = launder(ap)->ws; const int tid = tid_now(); if (tid < NE) LW[LW_CL + tid] = __hip_atomic_load((unsigned*)(ws + WS_CTL) + CW_CNT + l * NE + tid, RLX_AGENT);
          __syncthreads();
          if (tid == 0) { unsigned acc = 0u; for (int e = 0; e < NE; ++e) { LW[LW_TOFF + e] = acc; acc += (LW[LW_CL + e] + 255u) >> 8; } LW[LW_TOFF + NE] = acc; }
          __syncthreads(); }
#pragma unroll 1
        for (int rep = 0; rep < ((MK_DUP & 32) ? 2 : 1); ++rep) {
        if (PH(9)) { const CArgs aq = launder(ap); unsigned char* ws = aq->ws; bf16_t* H = (bf16_t*)(ws + WS_H); pg8::Gemm g{(const bf16_t*)(ws + WS_H8), (const bf16_t*)(ws + WS_WGU + (size_t)l * NE * 2 * FF * D), D / 2, (size_t)2 * FF * D / 2, (const int*)(ws + WS_LIST)};
          pg8::MoeOrder S{(const LAS int*)(lds + LDSCTL_OFF) + LW_TOFF, (const LAS int*)(lds + LDSCTL_OFF) + LW_CL, 2 * FF / 256, G, bx};
          pg8::EpiSwiglu8 E{ws + WS_ACT, aq->in[17] + (size_t)l * NE * 2 * FF};
          pg8::gemm_phase<pg8::EpiSwiglu8, pg8::MoeOrder, true, true, true, PFA_ON>(lds + RING_OFF, g, S, E); }
        GRID_BAR(); }
        if (MK_PROBE == 2) { probe_rows(ap, (const bf16_t*)(launder(ap)->ws + WS_ACT), 0, true, (const LAS int*)(lds + LDSCTL_OFF) + LW_TOFF, (const LAS int*)(lds + LDSCTL_OFF) + LW_CL, vcu, G); GRID_BAR(); probe_dump(ap); return; }
#pragma unroll 1
        for (int rep = 0; rep < ((MK_DUP & 64) ? 2 : 1); ++rep) {
        if (PH(10)) { const CArgs aq = launder(ap); unsigned char* ws = aq->ws; pg8::Gemm g{(const bf16_t*)(ws + WS_ACT), (const bf16_t*)(ws + WS_WD + (size_t)l * NE * D * FF), FF / 2, (size_t)D * FF / 2, nullptr};
          pg8::MoeOrder S{(const LAS int*)(lds + LDSCTL_OFF) + LW_TOFF, (const LAS int*)(lds + LDSCTL_OFF) + LW_CL, D / 256, G, bx};
          pg8::EpiDown8 E{ws + WS_YS, aq->in[19] + (size_t)l * NE * D, (const float*)(ws + WS_LISTW), 1.0f / (F8_SACT * F8_SW)};
#if defined(MK_EPIX)
          if (rep == 0 && (MK_DUP & 64)) { pg8::EpiDownX<MK_EPIX> EX{(bf16_t*)(ws + WS_YS), aq->in[19] + (size_t)l * NE * D, (const float*)(ws + WS_LISTW), 1.0f / (F8_SACT * F8_SW)}; pg8::gemm_phase<pg8::EpiDownX<MK_EPIX>, pg8::MoeOrder, false, true, true>(lds + RING_OFF, g, S, EX); } else
#elif defined(MK_NULLEPI)
          if (rep) { pg8::EpiNull EN; pg8::gemm_phase<pg8::EpiNull, pg8::MoeOrder, false, true, true>(lds + RING_OFF, g, S, EN); } else
#endif
          pg8::gemm_phase<pg8::EpiDown8, pg8::MoeOrder, false, true, true, PFA_ON>(lds + RING_OFF, g, S, E); }
        GRID_BAR(); }
        if (MK_PROBE == 3) { probe_rows(ap, (const bf16_t*)(launder(ap)->ws + WS_YS), M * TOPK, false, nullptr, nullptr, vcu, G); GRID_BAR(); probe_dump(ap); return; }
        if (PH(11)) row_pass<2>(ap, l, vcu, G, (const LAS int*)(lds + LDSCTL_OFF) + LW_TOFF);
        if (MK_STOP == 2) return;
        if (l + 1 < DEPTH) GRID_BAR();
    }
#if MK_TIM
    GRID_BAR();
    { const CArgs aq = launder(ap); const float* x = aq->in[0]; float* out = aq->out; const int t = tid_now();
      const unsigned long long s_ = __hip_atomic_load(&attn_body::g_tim[0], RLX_AGENT), c_ = __hip_atomic_load(&attn_body::g_tim[1], RLX_AGENT);
      float sc = (float)((double)s_ / (double)(c_ ? c_ : 1ull)) * (1.0f / MK_TIM);
#ifdef MK_TIM_Q
      sc = MK_TIM_Q * floorf(sc / MK_TIM_Q + 0.5f);
#endif
      for (size_t i = (size_t)blockIdx.x * NWAVES * 64 + t; i < (size_t)M * D; i += (size_t)G * NWAVES * 64) out[i] = x[i] * sc; }
#endif
}

extern "C" void kernel_launch(void* const* d_in, const int* in_sizes, int n_in, void* d_out, int out_size, void* d_ws, size_t ws_size, hipStream_t stream) {
    static int grid = 0;
    if (grid == 0) {
        if (n_in != 20 || in_sizes[0] != M * D || out_size != M * D || ws_size < WS_END) { fprintf(stderr, "kernel_launch: unexpected shapes (n_in %d, in0 %d, out %d, ws %zu < %zu); nothing launched\n", n_in, n_in > 0 ? in_sizes[0] : -1, out_size, ws_size, (size_t)WS_END); grid = -1; return; }
        int dev = 0, cus = 0, per_cu = 0;
        if (hipGetDevice(&dev) != hipSuccess || hipDeviceGetAttribute(&cus, hipDeviceAttributeMultiprocessorCount, dev) != hipSuccess) { grid = -1; return; }
        if (hipFuncSetAttribute((const void*)mk_fwd, hipFuncAttributeMaxDynamicSharedMemorySize, LDS_BYTES) != hipSuccess) { fprintf(stderr, "kernel_launch: hipFuncSetAttribute failed\n"); grid = -1; return; }
        if (hipOccupancyMaxActiveBlocksPerMultiprocessor(&per_cu, (const void*)mk_fwd, NWAVES * 64, LDS_BYTES) != hipSuccess || per_cu < 1)
            fprintf(stderr, "kernel_launch: note: occupancy query reports %d workgroups per CU\n", per_cu);
        (void)hipGetLastError();
        grid = cus > 256 ? 256 : cus;
    }
    if (grid < 0) return;
    if (hipMemsetAsync((char*)d_ws + WS_CTL, 0, CTL_ZERO_BYTES, stream) != hipSuccess) return;
    Args a{};
    for (int i = 0; i < 20; ++i) a.in[i] = (const float*)d_in[i];
    a.out = (float*)d_out; a.ws = (unsigned char*)d_ws;
    hipLaunchKernelGGL(mk_fwd, dim3(grid), dim3(NWAVES * 64), LDS_BYTES, stream, a);
}
```

```cpp
#include <hip/hip_runtime.h>
#include <cstdio>
#include <cstdint>
#include <cmath>

#ifndef MK_STOP
#define MK_STOP 0
#endif

constexpr int BATCH = 2, SEQ = 16384, D = 1024, M = BATCH * SEQ, DEPTH = 2;
constexpr int INW = 4352, PITCH = INW;
constexpr int C_QA = 0, C_KA = 512, C_VA = 640, C_QB = 768, C_KB = 1280, C_VB = 1792, C_GZA = 2304, C_GZB = 3328;
constexpr int NE = 32, TOPK = 4, FF = 1024, CAP = M;
constexpr int NBH = 12, HA = 8;
constexpr float LOG2E = 1.4426950408889634f, QSCALE = 0.125f * LOG2E;
constexpr float NORM_EPS = 1e-6f, SUBLN_EPS = 1e-5f;
constexpr int ACT_ROWS = M * TOPK + NE * 256;

#define LAS __attribute__((address_space(3)))
#define GAS __attribute__((address_space(1)))
typedef unsigned short bf16_t;
typedef short bf16x8 __attribute__((ext_vector_type(8)));
typedef float f32x4 __attribute__((ext_vector_type(4)));
typedef float f32x2 __attribute__((ext_vector_type(2)));
typedef unsigned u32x4 __attribute__((ext_vector_type(4)));
typedef unsigned u32x2 __attribute__((ext_vector_type(2)));
typedef int v4i_t __attribute__((ext_vector_type(4)));
typedef int v8i_t __attribute__((ext_vector_type(8)));
constexpr float F8_SW = 128.0f, F8_SH = 16.0f, F8_SACT = 4.0f, F8_SY = 32.0f, F8_MAX = 448.0f;
__device__ __forceinline__ float f8clamp(float v) { return fminf(fmaxf(v, -F8_MAX), F8_MAX); }
__device__ __forceinline__ unsigned pk4_fp8(float a, float b, float c, float d) { unsigned w = 0u; w = __builtin_amdgcn_cvt_pk_fp8_f32(f8clamp(a), f8clamp(b), w, false); w = __builtin_amdgcn_cvt_pk_fp8_f32(f8clamp(c), f8clamp(d), w, true); return w; }

__device__ __forceinline__ unsigned pk4_fp8_nc(float a, float b, float c, float d) { unsigned w = 0u; w = __builtin_amdgcn_cvt_pk_fp8_f32(a, b, w, false); w = __builtin_amdgcn_cvt_pk_fp8_f32(c, d, w, true); return w; }
__device__ __forceinline__ unsigned cvt_pk_bf16(float lo, float hi) { unsigned r; asm volatile("v_cvt_pk_bf16_f32 %0, %1, %2" : "=v"(r) : "v"(lo), "v"(hi)); return r; }
__device__ __forceinline__ float bf_lo(unsigned w) { return __uint_as_float(w << 16); }
__device__ __forceinline__ float bf_hi(unsigned w) { return __uint_as_float(w & 0xffff0000u); }
__device__ __forceinline__ float sigmoidf_(float v) { return __builtin_amdgcn_rcpf(1.0f + __builtin_amdgcn_exp2f(-v * LOG2E)); }

namespace pg8 {
constexpr int BM = 256, BK = 64, HALF = 128, HTB = HALF * BK * 2, STAGE_BYTES = 8 * HTB, NXCD = 8, WGM = 8;
__host__ __device__ __forceinline__ int lds_byte(int r, int c) { const int st = (r >> 4) * 2 + (c >> 5), rr = r & 15, cc = c & 31, ob = rr * 64 + cc * 2; return st * 1024 + (ob ^ (((ob >> 9) & 1) << 5)); }
__host__ __device__ __forceinline__ void stage_rc(int b, int& R, int& C) { const int st = b / 1024, sb = b % 1024, swz = sb ^ (((sb >> 9) & 1) << 5); R = (st >> 1) * 16 + swz / 64; C = (st & 1) * 32 + (swz % 64) / 2; }
__host__ __device__ __forceinline__ int perm32(int rho) { const int n = rho >> 4, i = rho & 15; return 8 * (i >> 2) + 4 * n + (i & 3); }

template <class E, class = void> struct Perm16 { static constexpr bool v = false; };
template <class E> struct Perm16<E, decltype((void)E::PERM16)> { static constexpr bool v = E::PERM16; };
__host__ __device__ __forceinline__ int perm16x(int R) { return 64 * (R >> 5) + 16 * ((R >> 2) & 3) + 4 * ((R >> 4) & 1) + (R & 3); }
struct Unit { int pm, pn, e, lrow, nvalid; };
struct Gemm { const bf16_t* A; const bf16_t* Bt; int K; size_t estride; const int* rows; };

struct StaticOrder {
    int nM, nN, nwg, G, c, skew;
    __device__ void init(int Mr, int N, int G_, int c_, int skew_ = 0) { nM = Mr / BM; nN = N / BM; nwg = nM * nN; G = G_; c = c_; skew = (skew_ && G_ == 256 && nwg == 1024) ? 1 : 0; }
    __device__ bool next(int i, Unit& u) const {
        long L = (long)i * G + c;
        if (skew) { if (c >= 128) { if (i >= 5) return false; L = (c - 128) + 128 * i; } else { if (i >= 3) return false; L = 640 + c + 128 * i; } }
        if (L >= nwg) return false;
        int wgid = (int)L; { const int q = nwg / NXCD, r = nwg % NXCD, xcd = wgid % NXCD, off = wgid / NXCD; wgid = (xcd < r ? xcd * (q + 1) : r * (q + 1) + (xcd - r) * q) + off; }
        const int nig = WGM * nN, gid = wgid / nig, fm = gid * WGM, gsz = (nM - fm) < WGM ? (nM - fm) : WGM;
        u.pm = fm + ((wgid % nig) % gsz); u.pn = (wgid % nig) / gsz; u.e = 0; u.lrow = 0; u.nvalid = 256; return true;
    }
};
struct MoeOrder {
    const LAS int* toff; const LAS int* cl; int nN, G, c;
    __device__ bool next(int i, Unit& u) const {
        const int ntile = toff[NE]; int gt, pn;
        if ((G & 7) == 0) { const int x = c & 7, s = c >> 3, per = G >> 3, t0 = (ntile * x) >> 3, t1 = (ntile * (x + 1)) >> 3, Lx = i * per + s;
            if (Lx >= (t1 - t0) * nN) return false;
            const int q = Lx / nN; gt = t0 + q; pn = Lx - q * nN; }
        else { const int L = i * G + c; if (L >= ntile * nN) return false; gt = L / nN; pn = L - gt * nN; }
        int e = 0;
#pragma unroll
        for (int k = 16; k >= 1; k >>= 1) if (toff[e + k] <= gt) e += k;
        const int rt = gt - toff[e]; int nv = cl[e] - rt * 256; nv = nv > 256 ? 256 : nv;
        u.pm = __builtin_amdgcn_readfirstlane(gt); u.pn = __builtin_amdgcn_readfirstlane(pn); u.e = __builtin_amdgcn_readfirstlane(e);
        u.lrow = __builtin_amdgcn_readfirstlane(e * CAP + rt * 256); u.nvalid = __builtin_amdgcn_readfirstlane(nv); return true;
    }
};

#ifndef MK_NT
#define MK_NT 1
#endif
#if MK_NT
#define NT_STORE(v, p) __builtin_nontemporal_store(v, p)
#else
#define NT_STORE(v, p) (*(p) = (v))
#endif
struct EpiBf16 {
    static constexpr bool PERM = true;
    bf16_t* O; int ldc; float sc;
    __device__ __forceinline__ void operator()(const f32x4 (&acc)[2][2][4][2], const Unit& u, int wr, int wc, int fr, int fq) const {
        const int row0 = u.pm * BM + wr * 64 + fr, col0 = u.pn * BM + wc * 32 + 8 * fq;
#pragma unroll
        for (int ai = 0; ai < 2; ++ai)
#pragma unroll
            for (int m = 0; m < 4; ++m) { bf16_t* rowp = O + (size_t)(row0 + ai * HALF + m * 16) * ldc + col0;
#pragma unroll
                for (int bj = 0; bj < 2; ++bj) { const f32x4 v0 = acc[ai][bj][m][0] * sc, v1 = acc[ai][bj][m][1] * sc;
                    u32x4 w; w.x = cvt_pk_bf16(v0[0], v0[1]); w.y = cvt_pk_bf16(v0[2], v0[3]); w.z = cvt_pk_bf16(v1[0], v1[1]); w.w = cvt_pk_bf16(v1[2], v1[3]);
                    NT_STORE(w, (u32x4*)(rowp + bj * HALF)); } }
    }
};
template <bool FIRST> struct EpiGate {
    static constexpr bool PERM = true;
    bf16_t* O; const bf16_t* prev; const bf16_t* P; int gcol;
    __device__ __forceinline__ void operator()(const f32x4 (&acc)[2][2][4][2], const Unit& u, int wr, int wc, int fr, int fq) const {
        const int row0 = u.pm * BM + wr * 64 + fr, col0 = u.pn * BM + wc * 32 + 8 * fq;
#pragma unroll
        for (int ai = 0; ai < 2; ++ai)
#pragma unroll
            for (int m = 0; m < 4; ++m) { const size_t row = (size_t)(row0 + ai * HALF + m * 16);
#pragma unroll
                for (int bj = 0; bj < 2; ++bj) { const int col = col0 + bj * HALF;
                    const u32x4 gz = *(const u32x4*)(P + row * PITCH + gcol + col);
                    const f32x4 v0 = acc[ai][bj][m][0], v1 = acc[ai][bj][m][1];
                    float o[8];
                    o[0] = v0[0] * sigmoidf_(bf_lo(gz.x)); o[1] = v0[1] * sigmoidf_(bf_hi(gz.x)); o[2] = v0[2] * sigmoidf_(bf_lo(gz.y)); o[3] = v0[3] * sigmoidf_(bf_hi(gz.y));
                    o[4] = v1[0] * sigmoidf_(bf_lo(gz.z)); o[5] = v1[1] * sigmoidf_(bf_hi(gz.z)); o[6] = v1[2] * sigmoidf_(bf_lo(gz.w)); o[7] = v1[3] * sigmoidf_(bf_hi(gz.w));
                    if (!FIRST) { const u32x4 pv = *(const u32x4*)(prev + row * D + col);
                        o[0] += bf_lo(pv.x); o[1] += bf_hi(pv.x); o[2] += bf_lo(pv.y); o[3] += bf_hi(pv.y); o[4] += bf_lo(pv.z); o[5] += bf_hi(pv.z); o[6] += bf_lo(pv.w); o[7] += bf_hi(pv.w); }
                    u32x4 w; w.x = cvt_pk_bf16(o[0], o[1]); w.y = cvt_pk_bf16(o[2], o[3]); w.z = cvt_pk_bf16(o[4], o[5]); w.w = cvt_pk_bf16(o[6], o[7]);
                    *(u32x4*)(O + row * D + col) = w; } }
    }
};
struct EpiRouter {
    static constexpr bool PERM = false;
    float* L; const float* bias;
    __device__ __forceinline__ void operator()(const f32x4 (&acc)[2][2][4][2], const Unit& u, int wr, int wc, int fr, int fq) const {
        if (wc != 0) return;
        const int row0 = u.pm * BM + wr * 64 + fr, col0 = 4 * fq;
        const f32x4 b0 = *(const f32x4*)(bias + col0), b1 = *(const f32x4*)(bias + col0 + 16);
#pragma unroll
        for (int ai = 0; ai < 2; ++ai)
#pragma unroll
            for (int m = 0; m < 4; ++m) { float* rowp = L + (size_t)(row0 + ai * HALF + m * 16) * NE + col0;
                *(f32x4*)(rowp) = acc[ai][0][m][0] + b0; *(f32x4*)(rowp + 16) = acc[ai][0][m][1] + b1; }
    }
};
struct EpiSwiglu {
    static constexpr bool PERM = true;
    bf16_t* ACT; const float* bgu;
    __device__ __forceinline__ void operator()(const f32x4 (&acc)[2][2][4][2], const Unit& u, int wr, int wc, int fr, int fq) const {
        const int row0 = u.pm * BM + wr * 64 + fr, j0 = u.pn * HALF + wc * 32 + 8 * fq;
        const float* bg = bgu + (size_t)u.e * 2 * FF + j0;
        float g_b[8], u_b[8];
        { const f32x4 a = *(const f32x4*)bg, b = *(const f32x4*)(bg + 4), c = *(const f32x4*)(bg + FF), d = *(const f32x4*)(bg + FF + 4);
#pragma unroll
          for (int i = 0; i < 4; ++i) { g_b[i] = a[i]; g_b[4 + i] = b[i]; u_b[i] = c[i]; u_b[4 + i] = d[i]; } }
#pragma unroll
        for (int ai = 0; ai < 2; ++ai)
#pragma unroll
            for (int m = 0; m < 4; ++m) { bf16_t* rowp = ACT + (size_t)(row0 + ai * HALF + m * 16) * FF + j0;
                float o[8];
#pragma unroll
                for (int n = 0; n < 2; ++n)
#pragma unroll
                    for (int i = 0; i < 4; ++i) { float gt = acc[ai][0][m][n][i] + g_b[4 * n + i], up = acc[ai][1][m][n][i] + u_b[4 * n + i];
                        gt = fminf(gt, 7.0f); up = fminf(fmaxf(up, -7.0f), 7.0f);
                        o[4 * n + i] = gt * __builtin_amdgcn_rcpf(1.0f + __builtin_amdgcn_exp2f(-1.702f * LOG2E * gt)) * (up + 1.0f); }
                u32x4 w; w.x = cvt_pk_bf16(o[0], o[1]); w.y = cvt_pk_bf16(o[2], o[3]); w.z = cvt_pk_bf16(o[4], o[5]); w.w = cvt_pk_bf16(o[6], o[7]);
                *(u32x4*)rowp = w; }
    }
};
struct EpiSwiglu8 {
    static constexpr bool PERM = true;
    unsigned char* ACT; const float* bgu;
    struct Pre { f32x4 a, b, c, d; };
    __device__ __forceinline__ Pre pre(const Unit& u, int wr, int wc, int fr, int fq) const {
        const float* bg = bgu + (size_t)u.e * 2 * FF + u.pn * HALF + wc * 32 + 8 * fq;
        Pre q; q.a = *(const f32x4*)bg; q.b = *(const f32x4*)(bg + 4); q.c = *(const f32x4*)(bg + FF); q.d = *(const f32x4*)(bg + FF + 4); return q; }
    __device__ __forceinline__ void post(const f32x4 (&acc)[2][2][4][2], const Pre& q, const Unit& u, int wr, int wc, int fr, int fq) const {
        constexpr float DS = 1.0f / (F8_SH * F8_SW);
        const int row0 = u.pm * BM + wr * 64 + fr, j0 = u.pn * HALF + wc * 32 + 8 * fq;
        float g_b[8], u_b[8];
#pragma unroll
        for (int i = 0; i < 4; ++i) { g_b[i] = q.a[i]; g_b[4 + i] = q.b[i]; u_b[i] = q.c[i]; u_b[4 + i] = q.d[i]; }
#pragma unroll
        for (int ai = 0; ai < 2; ++ai)
#pragma unroll
            for (int m = 0; m < 4; ++m) { unsigned char* rowp = ACT + (size_t)(row0 + ai * HALF + m * 16) * FF + j0;
                float o[8];
#pragma unroll
                for (int n = 0; n < 2; ++n)
#pragma unroll
                    for (int i = 0; i < 4; ++i) { float gt = acc[ai][0][m][n][i] * DS + g_b[4 * n + i], up = acc[ai][1][m][n][i] * DS + u_b[4 * n + i];
                        gt = fminf(gt, 7.0f); up = fminf(fmaxf(up, -7.0f), 7.0f);
                        o[4 * n + i] = gt * __builtin_amdgcn_rcpf(1.0f + __builtin_amdgcn_exp2f(-1.702f * LOG2E * gt)) * fmaf(up, F8_SACT, F8_SACT); }
                u32x2 w; w.x = pk4_fp8_nc(o[0], o[1], o[2], o[3]); w.y = pk4_fp8_nc(o[4], o[5], o[6], o[7]);
                NT_STORE(w, (u32x2*)rowp); }
    }
    __device__ __forceinline__ void operator()(const f32x4 (&acc)[2][2][4][2], const Unit& u, int wr, int wc, int fr, int fq) const { const Pre q = pre(u, wr, wc, fr, fq); post(acc, q, u, wr, wc, fr, fq); }
};
struct EpiDown {
    static constexpr bool PERM = true;
    bf16_t* YS; const float* bd; const float* listw; float ds;
    struct Pre { float ws[8]; f32x4 bv[2][2]; };
    __device__ __forceinline__ Pre pre(const Unit& u, int wr, int wc, int fr, int fq) const {
        const int r0 = wr * 64 + fr, col0 = u.pn * BM + wc * 32 + 8 * fq;
        const float* bp = bd + (size_t)u.e * D + col0;
        Pre q;
#pragma unroll
        for (int g = 0; g < 8; ++g) { const int r = r0 + (g >> 2) * HALF + (g & 3) * 16; q.ws[g] = (r < u.nvalid) ? listw[u.lrow + r] : 0.f; }
#pragma unroll
        for (int bj = 0; bj < 2; ++bj) { q.bv[bj][0] = *(const f32x4*)(bp + bj * HALF); q.bv[bj][1] = *(const f32x4*)(bp + bj * HALF + 4); }
        return q; }
    __device__ __forceinline__ void post(const f32x4 (&acc)[2][2][4][2], const Pre& q, const Unit& u, int wr, int wc, int fr, int fq) const {
        const int r0 = wr * 64 + fr, col0 = u.pn * BM + wc * 32 + 8 * fq;
#pragma unroll
        for (int ai = 0; ai < 2; ++ai)
#pragma unroll
            for (int m = 0; m < 4; ++m) { const float w_ = q.ws[ai * 4 + m]; bf16_t* rowp = YS + (size_t)(u.pm * BM + r0 + ai * HALF + m * 16) * D + col0;
#pragma unroll
                for (int bj = 0; bj < 2; ++bj) { const f32x4 v0 = (acc[ai][bj][m][0] * ds + q.bv[bj][0]) * w_, v1 = (acc[ai][bj][m][1] * ds + q.bv[bj][1]) * w_;
                    u32x4 w; w.x = cvt_pk_bf16(v0[0], v0[1]); w.y = cvt_pk_bf16(v0[2], v0[3]); w.z = cvt_pk_bf16(v1[0], v1[1]); w.w = cvt_pk_bf16(v1[2], v1[3]);
                    NT_STORE(w, (u32x4*)(rowp + bj * HALF)); } }
    }
    __device__ __forceinline__ void operator()(const f32x4 (&acc)[2][2][4][2], const Unit& u, int wr, int wc, int fr, int fq) const { const Pre q = pre(u, wr, wc, fr, fq); post(acc, q, u, wr, wc, fr, fq); }
};

struct EpiDown8 {
    static constexpr bool PERM = true; static constexpr bool PERM16 = true;
    unsigned char* YS; const float* bd; const float* listw; float ds;
    struct Pre { float ws[8]; f32x4 bv[4]; };
    __device__ __forceinline__ Pre pre(const Unit& u, int wr, int wc, int fr, int fq) const {
        const int r0 = wr * 64 + fr, col0 = u.pn * BM + wc * 64 + 16 * fq;
        const float* bp = bd + (size_t)u.e * D + col0;
        Pre q;
#pragma unroll
        for (int g = 0; g < 8; ++g) { const int r = r0 + (g >> 2) * HALF + (g & 3) * 16; q.ws[g] = (r < u.nvalid) ? listw[u.lrow + r] * F8_SY : 0.f; }
#pragma unroll
        for (int j = 0; j < 4; ++j) q.bv[j] = *(const f32x4*)(bp + 4 * j);
        return q; }
    __device__ __forceinline__ void post(const f32x4 (&acc)[2][2][4][2], const Pre& q, const Unit& u, int wr, int wc, int fr, int fq) const {
        const int r0 = wr * 64 + fr, col0 = u.pn * BM + wc * 64 + 16 * fq;
#pragma unroll
        for (int ai = 0; ai < 2; ++ai)
#pragma unroll
            for (int m = 0; m < 4; ++m) { const float w_ = q.ws[ai * 4 + m]; unsigned char* rowp = YS + (size_t)(u.pm * BM + r0 + ai * HALF + m * 16) * D + col0;
                u32x4 w;
#pragma unroll
                for (int bj = 0; bj < 2; ++bj)
#pragma unroll
                    for (int n = 0; n < 2; ++n) { const f32x4 v = (acc[ai][bj][m][n] * ds + q.bv[2 * bj + n]) * w_; w[2 * bj + n] = pk4_fp8(v[0], v[1], v[2], v[3]); }
                NT_STORE(w, (u32x4*)rowp); }
    }
    __device__ __forceinline__ void operator()(const f32x4 (&acc)[2][2][4][2], const Unit& u, int wr, int wc, int fr, int fq) const { const Pre q = pre(u, wr, wc, fr, fq); post(acc, q, u, wr, wc, fr, fq); }
};
#ifdef MK_EPIX
template <int MODE> struct EpiDownX {
    static constexpr bool PERM = true;
    bf16_t* YS; const float* bd; const float* listw; float ds;
    __device__ __forceinline__ void operator()(const f32x4 (&acc)[2][2][4][2], const Unit& u, int wr, int wc, int fr, int fq) const {
        const int r0 = wr * 64 + fr, col0 = u.pn * BM + wc * 32 + 8 * fq;
        const float* bp = bd + (size_t)u.e * D + col0;
        float ws[8]; f32x4 bv[2][2];
        if (MODE != 2) {
#pragma unroll
        for (int g = 0; g < 8; ++g) { const int r = r0 + (g >> 2) * HALF + (g & 3) * 16; ws[g] = (r < u.nvalid) ? listw[u.lrow + r] : 0.f; }
#pragma unroll
        for (int bj = 0; bj < 2; ++bj) { bv[bj][0] = *(const f32x4*)(bp + bj * HALF); bv[bj][1] = *(const f32x4*)(bp + bj * HALF + 4); }
        } else {
#pragma unroll
        for (int g = 0; g < 8; ++g) ws[g] = ds;
#pragma unroll
        for (int bj = 0; bj < 2; ++bj) { bv[bj][0] = (f32x4){ds, ds, ds, ds}; bv[bj][1] = bv[bj][0]; } }
#pragma unroll
        for (int ai = 0; ai < 2; ++ai)
#pragma unroll
            for (int m = 0; m < 4; ++m) { const float w_ = ws[ai * 4 + m]; bf16_t* rowp = YS + (size_t)(u.pm * BM + r0 + ai * HALF + m * 16) * D + col0;
#pragma unroll
                for (int bj = 0; bj < 2; ++bj) { const f32x4 v0 = (acc[ai][bj][m][0] * ds + bv[bj][0]) * w_, v1 = (acc[ai][bj][m][1] * ds + bv[bj][1]) * w_;
                    u32x4 w; w.x = cvt_pk_bf16(v0[0], v0[1]); w.y = cvt_pk_bf16(v0[2], v0[3]); w.z = cvt_pk_bf16(v1[0], v1[1]); w.w = cvt_pk_bf16(v1[2], v1[3]);
                    if (MODE != 1) *(u32x4*)(rowp + bj * HALF) = w; else asm volatile("" :: "v"(w)); } }
    }
};
#endif
struct EpiNull {
    static constexpr bool PERM = true;
    __device__ __forceinline__ void operator()(const f32x4 (&acc)[2][2][4][2], const Unit& u, int wr, int wc, int fr, int fq) const {
#pragma unroll
        for (int ai = 0; ai < 2; ++ai)
#pragma unroll
            for (int bj = 0; bj < 2; ++bj)
#pragma unroll
                for (int m = 0; m < 4; ++m) asm volatile("" :: "v"(acc[ai][bj][m][0]), "v"(acc[ai][bj][m][1]));
    }
};
template <class Epi, class Sched, bool GATHER, bool ALIGN_EPI, bool F8 = false, bool PFA = false>
__device__ __forceinline__ void gemm_phase(LAS unsigned char* lds, const Gemm g, const Sched& S, const Epi& E) {
    int tid = threadIdx.x; asm volatile("" : "+v"(tid));
    const int wid = __builtin_amdgcn_readfirstlane(tid >> 6), lane = tid & 63, wr = wid >> 2, wc = wid & 3, fr = lane & 15, fq = lane >> 4;
    const int K = g.K, nt = K / BK;
    unsigned voffA[2], voffB[2]; int Rg[2], Cg[2];
#pragma unroll
    for (int i = 0; i < 2; ++i) { int R, C; stage_rc(tid * 16 + i * 8192, R, C); const int Rb = Perm16<Epi>::v ? perm16x(R) : Epi::PERM ? ((R & ~31) + perm32(R & 31)) : R;
        voffA[i] = (unsigned)(R * K + C) * 2u; voffB[i] = (unsigned)(Rb * K + C) * 2u; Rg[i] = R; Cg[i] = C; }
    const size_t kstep = (size_t)(BK * 2);
    const size_t hstep = (size_t)HALF * K * 2;
    const size_t tstep = 2 * hstep;
    const unsigned ldsw = (unsigned)wid * 1024u;
    const int aoff = lds_byte(wr * 64 + fr, fq * 8), boff = lds_byte(wc * 32 + fr, fq * 8);
    unsigned vAc[2][2], vAn[2][2];
#define PG8_SA(b, h) (((b) * 2 + (h)) * HTB)
#define PG8_SB(b, h) ((4 + (b) * 2 + (h)) * HTB)
#define PG8_STAGE2(bufoff, gbase, v0, v1) do { \
        __builtin_amdgcn_global_load_lds((const unsigned*)((const char*)(gbase) + (v0)), (LAS unsigned*)(lds + (bufoff) + ldsw), 16, 0, 0); \
        __builtin_amdgcn_global_load_lds((const unsigned*)((const char*)(gbase) + (v1)), (LAS unsigned*)(lds + (bufoff) + ldsw + 8192), 16, 0, 0); } while (0)
#define PG8_STA(bufoff, ap, h, usen) do { if constexpr (GATHER) { const unsigned o0_ = (usen) ? vAn[h][0] : vAc[h][0], o1_ = (usen) ? vAn[h][1] : vAc[h][1]; PG8_STAGE2(bufoff, ap, o0_, o1_); } \
        else { PG8_STAGE2(bufoff, (ap) + (h) * hstep, voffA[0], voffA[1]); } } while (0)
#define PG8_STB(bufoff, bp, h) PG8_STAGE2(bufoff, (bp) + (h) * (Perm16<Epi>::v ? (size_t)8 * K * 2 : hstep), voffB[0], voffB[1])
#define PG8_ROWS(u, v) do { _Pragma("unroll") for (int h_ = 0; h_ < 2; ++h_) _Pragma("unroll") for (int i_ = 0; i_ < 2; ++i_) { const int rr_ = h_ * HALF + Rg[i_]; \
        const int idx_ = (rr_ < (u).nvalid) ? g.rows[(u).lrow + rr_] : 0; v[h_][i_] = (unsigned)((idx_ >> 2) * K + Cg[i_]) * 2u; } \
        asm volatile("" : "+v"(v[0][0]), "+v"(v[0][1]), "+v"(v[1][0]), "+v"(v[1][1])); } while (0)
#define PG8_LDA(dst, b, h) do { _Pragma("unroll") for (int m = 0; m < 4; ++m) _Pragma("unroll") for (int k = 0; k < 2; ++k) dst[m][k] = *(const LAS bf16x8*)(lds + PG8_SA(b, h) + aoff + m * 2048 + k * 1024); } while (0)
#define PG8_LDB(dst, b, h) do { _Pragma("unroll") for (int n = 0; n < 2; ++n) _Pragma("unroll") for (int k = 0; k < 2; ++k) dst[n][k] = *(const LAS bf16x8*)(lds + PG8_SB(b, h) + boff + n * 2048 + k * 1024); } while (0)
#define PG8_CAT(x, y) __builtin_shufflevector(__builtin_bit_cast(v4i_t, x), __builtin_bit_cast(v4i_t, y), 0, 1, 2, 3, 4, 5, 6, 7)
#define PG8_MMA(ai, bj, At, Bt) do { __builtin_amdgcn_s_setprio(1); if constexpr (F8) { \
        _Pragma("unroll") for (int m = 0; m < 4; ++m) _Pragma("unroll") for (int n = 0; n < 2; ++n) \
            { const v8i_t b8_ = PG8_CAT(Bt[n][0], Bt[n][1]), a8_ = PG8_CAT(At[m][0], At[m][1]);     \
              asm volatile("v_mfma_scale_f32_16x16x128_f8f6f4 %0, %1, %2, %0, %3, %3 op_sel_hi:[0,0,0]" : "+v"(acc[ai][bj][m][n]) : "v"(b8_), "v"(a8_), "v"(f8one)); } \
        } else { _Pragma("unroll") for (int m = 0; m < 4; ++m) _Pragma("unroll") for (int n = 0; n < 2; ++n) _Pragma("unroll") for (int k = 0; k < 2; ++k) \
        acc[ai][bj][m][n] = __builtin_amdgcn_mfma_f32_16x16x32_bf16(Bt[n][k], At[m][k], acc[ai][bj][m][n], 0, 0, 0); } __builtin_amdgcn_s_setprio(0); } while (0)
#define PG8_WAIT_V(n) asm volatile("s_waitcnt vmcnt(" #n ")" ::: "memory")
#define PG8_WAIT_L(n) asm volatile("s_waitcnt lgkmcnt(" #n ")" ::: "memory")
#define PG8_BAR __builtin_amdgcn_s_barrier()
#define PG8_SCHED __builtin_amdgcn_sched_barrier(0)
    Unit cur, nxt; int ui = 0;
    if (!S.next(0, cur)) return;
    f32x4 acc[2][2][4][2];
#pragma unroll
    for (int a = 0; a < 2; ++a)
#pragma unroll
        for (int b = 0; b < 2; ++b)
#pragma unroll
            for (int m = 0; m < 4; ++m)
#pragma unroll
                for (int n = 0; n < 2; ++n) acc[a][b][m][n] = (f32x4){0.f, 0.f, 0.f, 0.f};
    bf16x8 At[4][2], B0[2][2], B1[2][2];
    const int f8one = 0x7f7f7f7f;
    const char* cA = GATHER ? (const char*)g.A : (const char*)g.A + (size_t)cur.pm * tstep;
    const char* cB = (const char*)g.Bt + ((size_t)cur.e * g.estride) * 2 + (size_t)cur.pn * tstep;
    if constexpr (GATHER) { PG8_ROWS(cur, vAc); }
    PG8_STB(PG8_SB(0, 0), cB, 0); PG8_STB(PG8_SB(0, 1), cB, 1); PG8_STA(PG8_SA(0, 0), cA, 0, false); PG8_STA(PG8_SA(0, 1), cA, 1, false);
    if (wr == 1) PG8_BAR;
    PG8_WAIT_V(2); PG8_BAR;
    PG8_STB(PG8_SB(1, 0), cB + kstep, 0); PG8_STA(PG8_SA(1, 0), cA + kstep, 0, false); PG8_STB(PG8_SB(1, 1), cB + kstep, 1);
    PG8_WAIT_V(6); PG8_BAR;
    for (;;) {
        const bool has_next = S.next(ui + 1, nxt);
        const char* nA = GATHER ? (const char*)g.A : (has_next ? (const char*)g.A + (size_t)nxt.pm * tstep : cA);
        const char* nB = has_next ? (const char*)g.Bt + ((size_t)nxt.e * g.estride) * 2 + (size_t)nxt.pn * tstep : cB;
        if constexpr (GATHER) { if (has_next) { PG8_ROWS(nxt, vAn); } else {
#pragma unroll
            for (int h = 0; h < 2; ++h) { vAn[h][0] = vAc[h][0]; vAn[h][1] = vAc[h][1]; } } }
        for (int t = 0; t < nt; t += 2) {
            const bool last = (t == nt - 2);
            const char* a1 = cA + (size_t)(t + 1) * kstep;
            const char* a2 = last ? nA : cA + (size_t)(t + 2) * kstep; const char* b2 = last ? nB : cB + (size_t)(t + 2) * kstep;
            const char* a3 = a2 + kstep; const char* b3 = b2 + kstep;
            PG8_LDB(B0, 0, 0); PG8_LDB(B1, 0, 1); PG8_SCHED; PG8_LDA(At, 0, 0); PG8_STA(PG8_SA(1, 1), a1, 1, false);
            PG8_WAIT_V(8); PG8_WAIT_L(0); PG8_BAR; PG8_MMA(0, 0, At, B0); PG8_MMA(0, 1, At, B1); PG8_BAR; PG8_SCHED;
            PG8_LDA(At, 0, 1); PG8_STB(PG8_SB(0, 0), b2, 0); PG8_STB(PG8_SB(0, 1), b2, 1); PG8_STA(PG8_SA(0, 0), a2, 0, last);
            PG8_WAIT_V(8); PG8_WAIT_L(0); PG8_BAR; PG8_MMA(1, 0, At, B0); PG8_MMA(1, 1, At, B1); PG8_BAR; PG8_SCHED;
            PG8_LDB(B0, 1, 0); PG8_LDB(B1, 1, 1); PG8_SCHED; PG8_LDA(At, 1, 0); PG8_STA(PG8_SA(0, 1), a2, 1, last);
            PG8_WAIT_V(8); PG8_WAIT_L(0); PG8_BAR; PG8_MMA(0, 0, At, B0); PG8_MMA(0, 1, At, B1); PG8_BAR; PG8_SCHED;
            PG8_LDA(At, 1, 1); PG8_STB(PG8_SB(1, 0), b3, 0); PG8_STB(PG8_SB(1, 1), b3, 1); PG8_STA(PG8_SA(1, 0), a3, 0, last);
            PG8_WAIT_V(8); PG8_WAIT_L(0); PG8_BAR; PG8_MMA(1, 0, At, B0); PG8_MMA(1, 1, At, B1); PG8_BAR; PG8_SCHED;
        }
        if constexpr (ALIGN_EPI) { if (wr == 0) PG8_BAR; }
        if constexpr (F8) asm volatile("s_nop 15\n\ts_nop 15" ::: "memory");
        if constexpr (PFA) {
            const auto q_ = E.pre(cur, wr, wc, fr, fq);
            PG8_SCHED;
            if (has_next) { LAS unsigned* dump_ = (LAS unsigned*)(lds + STAGE_BYTES + 8192 + ldsw / 4);
                for (int kb = 0; kb < nt * 128; kb += 1024) if (kb > 0 || Cg[0] >= 16) {
#pragma unroll
                    for (int h = 0; h < 2; ++h)
#pragma unroll
                        for (int i = 0; i < 2; ++i) { const char* pa_ = GATHER ? nA + vAn[h][i] : nA + h * hstep + voffA[i];
                            __builtin_amdgcn_global_load_lds((const unsigned*)(pa_ + Cg[i] * 14 + kb), dump_, 4, 0, 0); } } }
            PG8_SCHED;
            E.post(acc, q_, cur, wr, wc, fr, fq);
        } else E(acc, cur, wr, wc, fr, fq);
        if (!has_next) break;
#pragma unroll
        for (int a = 0; a < 2; ++a)
#pragma unroll
            for (int b = 0; b < 2; ++b)
#pragma unroll
                for (int m = 0; m < 4; ++m)
#pragma unroll
                    for (int n = 0; n < 2; ++n) acc[a][b][m][n] = (f32x4){0.f, 0.f, 0.f, 0.f};
        cur = nxt; cA = nA; cB = nB; ++ui;
        if constexpr (GATHER) {
#pragma unroll
            for (int h = 0; h < 2; ++h) { vAc[h][0] = vAn[h][0]; vAc[h][1] = vAn[h][1]; } }
        if constexpr (ALIGN_EPI) { if (wr == 1) PG8_BAR; }
    }
    PG8_WAIT_V(0);
    if constexpr (!ALIGN_EPI) { if (wr == 0) PG8_BAR; }
    PG8_BAR;
#undef PG8_SA
#undef PG8_SB
#undef PG8_STAGE2
#undef PG8_STA
#undef PG8_STB
#undef PG8_ROWS
#undef PG8_LDA
#undef PG8_LDB
#undef PG8_MMA
#undef PG8_CAT
#undef PG8_WAIT_V
#undef PG8_WAIT_L
#undef PG8_BAR
#undef PG8_SCHED
}
}
namespace attn_body {
using bf16x8 = __attribute__((ext_vector_type(8))) short;
using s16x4 = __attribute__((ext_vector_type(4))) short;
using f32x16 = __attribute__((ext_vector_type(16))) float;
constexpr int NW = 8, QBLK = 32, QB = QBLK * NW, KVBLK = 64;
__device__ __forceinline__ int crow(int r, int hi) { return (r & 3) + 8 * (r >> 2) + 4 * hi; }
#define SBAR() __builtin_amdgcn_sched_barrier(0)
constexpr int NSLOT = 4, SLOTK = 8192, SLOTV = 16384;
constexpr int LDS_K = 0, LDS_V = NSLOT * SLOTK, LDS_WS = LDS_V + NSLOT * SLOTV, LDS_TAB = LDS_WS + NW * 64 * 4, TAB_N = 640, LDS_BYTES = LDS_TAB + TAB_N * 4;
__device__ __forceinline__ void glds16(const void* gsrc, unsigned lds_dst) { unsigned keep;
  asm volatile("s_mov_b32 %0, m0\n\ts_mov_b32 m0, %2\n\ts_nop 0\n\tglobal_load_lds_dwordx4 %1, off\n\ts_mov_b32 m0, %0" : "=&s"(keep) : "v"(gsrc), "s"(lds_dst) : "memory"); }
typedef float f32x2_t __attribute__((ext_vector_type(2))); typedef __bf16 bf16x2_t __attribute__((ext_vector_type(2)));
__device__ __forceinline__ unsigned cvtpk_s(float lo, float hi) { f32x2_t v = {lo, hi}; bf16x2_t b = __builtin_convertvector(v, bf16x2_t); return __builtin_bit_cast(unsigned, b); }
#define WAIT_BAR(N) asm volatile("s_waitcnt vmcnt(" #N ") lgkmcnt(0)\n\ts_barrier" ::: "memory")

__device__ __forceinline__ void kload8(bf16x8* kf, const LAS char* Kslot, int r32, int hi);
__device__ __forceinline__ void qkt_r(f32x16& p0, f32x16& p1, const bf16x8* kf, const bf16x8* qr, const f32x16& negm);
__device__ __forceinline__ void qkt(f32x16& p0, f32x16& p1, const LAS char* Kslot, const bf16x8* qr, const f32x16& negm, int r32, int hi) { bf16x8 kf[8]; kload8(kf, Kslot, r32, hi); qkt_r(p0, p1, kf, qr, negm); }
__device__ __forceinline__ float fadd_s(float a, float b) { float r; asm("v_add_f32_e32 %0, %1, %2" : "=v"(r) : "v"(a), "v"(b)); return r; }
__device__ __forceinline__ void kload8(bf16x8* kf, const LAS char* Kslot, int r32, int hi) {
  const unsigned a0 = (unsigned)(uintptr_t)Kslot + r32 * 128 + ((hi ^ ((r32 >> 1) & 7)) << 4);
  #pragma unroll
  for (int d0 = 0; d0 < 4; ++d0) { const LAS char* kb = (const LAS char*)(uintptr_t)(a0 ^ (d0 << 5)); kf[2 * d0] = *(const LAS bf16x8*)(kb); kf[2 * d0 + 1] = *(const LAS bf16x8*)(kb + 4096); }
}
__device__ __forceinline__ void qkt_r(f32x16& p0, f32x16& p1, const bf16x8* kf, const bf16x8* qr, const f32x16& negm) {
  asm volatile("v_mfma_f32_32x32x16_bf16 %0, %1, %2, %3" : "=&v"(p0) : "v"(kf[0]), "v"(qr[0]), "v"(negm));
  asm volatile("v_mfma_f32_32x32x16_bf16 %0, %1, %2, %3" : "=&v"(p1) : "v"(kf[1]), "v"(qr[0]), "v"(negm));
  #pragma unroll
  for (int d0 = 1; d0 < 4; ++d0) {
    asm volatile("v_mfma_f32_32x32x16_bf16 %0, %1, %2, %0" : "+v"(p0) : "v"(kf[2 * d0]), "v"(qr[d0]));
    asm volatile("v_mfma_f32_32x32x16_bf16 %0, %1, %2, %0" : "+v"(p1) : "v"(kf[2 * d0 + 1]), "v"(qr[d0])); }
}
#define MX3(a, b, c) __builtin_fmaxf(__builtin_fmaxf((a), (b)), (c))
__device__ __forceinline__ float rowmax(const f32x16& p0, const f32x16& p1) {
  float a = MX3(p0[0], p0[1], p1[0]), b = MX3(p0[2], p0[3], p1[1]); a = MX3(a, p1[2], p1[3]);
  #pragma unroll
  for (int r = 4; r < 16; r += 4) { a = MX3(a, p0[r], p0[r + 1]); b = MX3(b, p0[r + 2], p0[r + 3]); a = MX3(a, p1[r], p1[r + 1]); b = MX3(b, p1[r + 2], p1[r + 3]); }
  float rm = __builtin_fmaxf(a, b);
  auto rr = __builtin_amdgcn_permlane32_swap(__float_as_uint(rm), __float_as_uint(rm), false, false);
  return __builtin_fmaxf(__uint_as_float(rr[0]), __uint_as_float(rr[1]));
}
__device__ __forceinline__ void bmask(f32x16& p0, f32x16& p1, int jb, int qrel, int hi, const LAS float* tab) {
  const unsigned ta = (unsigned)(uintptr_t)(tab + (255 + qrel - 64 * jb - 4 * hi - 59));
  #pragma unroll
  for (int g = 0; g < 4; ++g) {
    float a0, a1, a2, a3, b0, b1, b2, b3;
    asm volatile("ds_read_b32 %0, %8 offset:%c9\n\tds_read_b32 %1, %8 offset:%c10\n\tds_read_b32 %2, %8 offset:%c11\n\tds_read_b32 %3, %8 offset:%c12\n\t"
                 "ds_read_b32 %4, %8 offset:%c13\n\tds_read_b32 %5, %8 offset:%c14\n\tds_read_b32 %6, %8 offset:%c15\n\tds_read_b32 %7, %8 offset:%c16\n\ts_waitcnt lgkmcnt(0)"
                 : "=&v"(a0), "=&v"(a1), "=&v"(a2), "=&v"(a3), "=&v"(b0), "=&v"(b1), "=&v"(b2), "=&v"(b3)
                 : "v"(ta), "i"(4 * (59 - 8 * g)), "i"(4 * (59 - 8 * g - 1)), "i"(4 * (59 - 8 * g - 2)), "i"(4 * (59 - 8 * g - 3)),
                   "i"(4 * (59 - 8 * g - 32)), "i"(4 * (59 - 8 * g - 33)), "i"(4 * (59 - 8 * g - 34)), "i"(4 * (59 - 8 * g - 35)) : "memory");
    p0[4 * g] += a0; p0[4 * g + 1] += a1; p0[4 * g + 2] += a2; p0[4 * g + 3] += a3;
    p1[4 * g] += b0; p1[4 * g + 1] += b1; p1[4 * g + 2] += b2; p1[4 * g + 3] += b3;
  }
}
template <int ND>
__device__ __forceinline__ void pv(f32x16* o, int vb, bf16x8 pa0, bf16x8 pa1, bf16x8 pa2, bf16x8 pa3) {
  #pragma unroll
  for (int d0 = 0; d0 < ND; d0 += 2) { s16x4 lo[2][4], hi[2][4];
    #pragma unroll
    for (int e = 0; e < 2; ++e)
      #pragma unroll
      for (int ks = 0; ks < 4; ++ks) {
        asm volatile("ds_read_b64_tr_b16 %0,%1 offset:%c2" : "=&v"(lo[e][ks]) : "v"(vb), "i"((d0 + e) * 4096 + ks * 1024) : "memory");
        asm volatile("ds_read_b64_tr_b16 %0,%1 offset:%c2" : "=&v"(hi[e][ks]) : "v"(vb), "i"((d0 + e) * 4096 + ks * 1024 + 512) : "memory"); }
    asm volatile("s_waitcnt lgkmcnt(0)" ::: "memory"); SBAR();
    #define PK(e, k) (bf16x8){lo[e][k][0], lo[e][k][1], lo[e][k][2], lo[e][k][3], hi[e][k][0], hi[e][k][1], hi[e][k][2], hi[e][k][3]}
    o[d0]     = __builtin_amdgcn_mfma_f32_32x32x16_bf16(pa0, PK(0, 0), o[d0], 0, 0, 0);
    o[d0 + 1] = __builtin_amdgcn_mfma_f32_32x32x16_bf16(pa0, PK(1, 0), o[d0 + 1], 0, 0, 0);
    o[d0]     = __builtin_amdgcn_mfma_f32_32x32x16_bf16(pa1, PK(0, 1), o[d0], 0, 0, 0);
    o[d0 + 1] = __builtin_amdgcn_mfma_f32_32x32x16_bf16(pa1, PK(1, 1), o[d0 + 1], 0, 0, 0);
    o[d0]     = __builtin_amdgcn_mfma_f32_32x32x16_bf16(pa2, PK(0, 2), o[d0], 0, 0, 0);
    o[d0 + 1] = __builtin_amdgcn_mfma_f32_32x32x16_bf16(pa2, PK(1, 2), o[d0 + 1], 0, 0, 0);
    o[d0]     = __builtin_amdgcn_mfma_f32_32x32x16_bf16(pa3, PK(0, 3), o[d0], 0, 0, 0);
    o[d0 + 1] = __builtin_amdgcn_mfma_f32_32x32x16_bf16(pa3, PK(1, 3), o[d0 + 1], 0, 0, 0);
    #undef PK
    SBAR();
  }
}

#ifndef MK_TIM
#define MK_TIM 0
#endif
#if MK_TIM
__device__ unsigned long long g_tim[2];
#endif
template <int THRL, int PQ, int PO, int NV>
__device__ __forceinline__ void attn_unit(const bf16_t* Qp, const bf16_t* __restrict__ Kp, const bf16_t* __restrict__ Vp, bf16_t* Op, const int NT, const float mfloor, const float sink2, char* shm, const int dbg = 0,
                                          const bf16_t* O1p = nullptr, const float lam = 0.f, const float* gsub = nullptr, const float post = 0.f) {
  constexpr int ND = 2 * NV;
  int tid = threadIdx.x; asm volatile("" : "+v"(tid));
  const int lane = tid & 63, r32 = lane & 31, hi = lane >> 5; const int wid = __builtin_amdgcn_readfirstlane(tid >> 6);
  const unsigned lds0 = (unsigned)(uintptr_t)shm;
  const LAS char* shm3 = (const LAS char*)shm;
  LAS float* wsf = (LAS float*)((LAS char*)shm + LDS_WS) + wid * 64;
  const LAS float* tab = (const LAS float*)((LAS char*)shm + LDS_TAB);
  const bf16_t* Qw = Qp + (long)(wid * QBLK) * PQ;
  bf16x8 qr[4];
  #pragma unroll
  for (int d0 = 0; d0 < 4; ++d0) qr[d0] = *reinterpret_cast<const bf16x8*>(&Qw[(long)r32 * PQ + d0 * 16 + hi * 8]);
  const bf16_t* ksrc = Kp + (long)(8 * wid + (lane >> 3)) * PQ + (((lane & 7) ^ ((4 * wid + (lane >> 4)) & 7)) * 8);
  const bf16_t* vsrc = Vp + (long)(8 * wid + (lane >> 3)) * PQ + ((((lane >> 2) ^ (lane >> 4)) & 1) * 32) + (lane & 3) * 8;
  const unsigned kdst = lds0 + LDS_K + wid * 1024, vdst = lds0 + LDS_V + wid * 1024;
  #define DMA_K(t, sl) glds16(ksrc + (long)(t) * KVBLK * PQ, (unsigned)__builtin_amdgcn_readfirstlane(kdst + (sl) * SLOTK))
#ifndef MK_DMAX
#define MK_DMAX 0
#endif
  #define DMA_V(t, sl) do { if (MK_DMAX == 1) break; if (MK_DMAX == 2) { const long go_ = (long)(t) * KVBLK * PQ; asm volatile("global_load_lds_dwordx4 %0, off\n\tglobal_load_lds_dwordx4 %1, off" :: "v"(vsrc + go_), "v"(vsrc + go_ + 64) : "memory"); break; } \
      if (MK_DMAX == 3) { const long go_ = (long)(t) * KVBLK * PQ; asm volatile("s_mov_b32 m0, %1\n\ts_nop 0\n\tglobal_load_lds_dwordx4 %0, off" :: "v"(vsrc + go_), "s"((unsigned)__builtin_amdgcn_readfirstlane(vdst + (sl) * SLOTV)) : "memory"); \
        asm volatile("s_mov_b32 m0, %1\n\ts_nop 0\n\tglobal_load_lds_dwordx4 %0, off" :: "v"(vsrc + go_ + 64), "s"((unsigned)__builtin_amdgcn_readfirstlane(vdst + (sl) * SLOTV + 8192)) : "memory"); break; } \
      DMA_V_(t, sl); } while (0)
  #define DMA_V_(t, sl) do { const long go_ = (long)(t) * KVBLK * PQ; glds16(vsrc + go_, (unsigned)__builtin_amdgcn_readfirstlane(vdst + (sl) * SLOTV)); \
      if (NV == 2) glds16(vsrc + go_ + 64, (unsigned)__builtin_amdgcn_readfirstlane(vdst + (sl) * SLOTV + 8192)); } while (0)
  const int vb0 = (int)(lds0 + LDS_V) + (4 * hi + ((lane & 15) >> 2)) * 128 + ((lane >> 3) & 1) * 64 + ((lane >> 4) & 1) * 32 + (lane & 3) * 8;
  float mhat = mfloor, l_reg = 0.f; f32x16 o[ND], negm;
  { float zf = 0.f; asm volatile("" : "+v"(zf));
    _Pragma("unroll") for (int r = 0; r < 16; ++r) { _Pragma("unroll") for (int d = 0; d < ND; ++d) o[d][r] = zf; negm[r] = -mhat; } }
  const int qrel = wid * QBLK + r32;
  DMA_K(0, 0); DMA_V(0, 3); DMA_K(1, 1); DMA_V(0, 0); DMA_K(2, 2); DMA_V(1, 1);
  asm volatile("" :: "v"(qr[0]), "v"(qr[1]), "v"(qr[2]), "v"(qr[3]));
  const int grp = wid >> 2;
  u32x4 pw0, pw1, pw2, pw3; pw0 = pw1 = pw2 = pw3 = (u32x4){0u, 0u, 0u, 0u};
  bool resc = false;
  f32x16 c0, c1;
#ifndef ATT_STAGGER
#define ATT_STAGGER 0
#endif
  if (ATT_STAGGER && grp == 1) { if (NV == 2) WAIT_BAR(6); else WAIT_BAR(4); }
  bf16x8 kf[8];
#ifndef ATT_QKAHEAD
#define ATT_QKAHEAD 0
#endif
  if (!ATT_STAGGER) { if (NV == 2) WAIT_BAR(8); else WAIT_BAR(5); kload8(kf, shm3 + LDS_K, r32, hi); if (ATT_QKAHEAD) { qkt_r(c0, c1, kf, qr, negm); SBAR(); } }
#if MK_TIM
  unsigned long long tim_a = 0ull; unsigned tim_sum = 0u, tim_cnt = 0u; bool tim_have = false;
  #define TIM_AT(k) do { if (NV == 2 && ((k) == MK_TIM_A || (k) == MK_TIM_B)) { unsigned long long tn_; asm volatile("s_memtime %0\n\ts_waitcnt lgkmcnt(0)" : "=s"(tn_) :: "memory"); \
      if ((k) == MK_TIM_B && tim_have) { tim_sum += (unsigned)(tn_ - tim_a); ++tim_cnt; } \
      if ((k) == MK_TIM_A) { tim_a = tn_; tim_have = true; } } } while (0)
#else
  #define TIM_AT(k) do { } while (0)
#endif
#ifndef ATT_SPREAD
#define ATT_SPREAD 0
#endif
#ifndef ATT_DMAPT
#define ATT_DMAPT 1
#endif
  #define DMA_PT(k) do { if ((NV == 2 && ATT_SPREAD) ? (wid == (k)) : ((k) == ATT_DMAPT)) { const int tk_ = t + 3 < NT ? t + 3 : NT - 1, tv_ = t + 2 < NT ? t + 2 : NT - 1; DMA_K(tk_, (t + 3) & 3); DMA_V(tv_, (t + 2) & 3); } } while (0)
  #pragma unroll 1
  for (int t = 0; t <= NT; ++t) {
    TIM_AT(0);
    if (dbg & 32) { } else if (ATT_STAGGER) { if (NV == 2) WAIT_BAR(6); else WAIT_BAR(4); } else { if (NV == 2) WAIT_BAR(5); else WAIT_BAR(3); }
    TIM_AT(1);
    DMA_PT(0);
    TIM_AT(2);
    if (ATT_QKAHEAD) { kload8(kf, shm3 + LDS_K + ((t + 1) & 3) * SLOTK, r32, hi); SBAR(); TIM_AT(3); DMA_PT(1); }
    else { qkt_r(c0, c1, kf, qr, negm); SBAR(); TIM_AT(3); kload8(kf, shm3 + LDS_K + ((t + 1) & 3) * SLOTK, r32, hi); SBAR(); DMA_PT(1); }
    SBAR();
    const int jb = t - (NT - 4);
    if (jb >= -2 && jb <= 3) bmask(c0, c1, jb, qrel, hi, tab);
    const float rm = rowmax(c0, c1);
    if (t < NT && __any(rm > (float)THRL)) {
      const float dl = __builtin_fmaxf(rm, 0.f);
      mhat += dl;
      #pragma unroll
      for (int r = 0; r < 16; ++r) { c0[r] -= dl; c1[r] -= dl; negm[r] = -mhat; }
      const float f = __builtin_amdgcn_exp2f(-dl); l_reg *= f;
      if (hi == 0) wsf[r32] = f;
      resc = true;
    }
    if ((dbg & 32) || !ATT_STAGGER) { } else if (NV == 2) WAIT_BAR(5); else WAIT_BAR(3);
    if (ATT_STAGGER) { const int tk = t + 3 < NT ? t + 3 : NT - 1, tv = t + 2 < NT ? t + 2 : NT - 1;
      if (!(dbg & 4)) { DMA_K(tk, (t + 3) & 3); DMA_V(tv, (t + 2) & 3); } }
    { const int vb = vb0 + ((t + 3) & 3) * SLOTV, vbo = vb ^ 64;
      s16x4 lo[2][4], hi_[2][4];
      #define RD(b, d0) do { _Pragma("unroll") for (int ks = 0; ks < 4; ++ks) { \
          asm volatile("ds_read_b64_tr_b16 %0,%1 offset:%c2" : "=v"(lo[b][ks]) : "v"(((d0) & 1) ? vbo : vb), "i"(((d0) >> 1) * 8192 + ks * 2048) : "memory"); \
          asm volatile("ds_read_b64_tr_b16 %0,%1 offset:%c2" : "=v"(hi_[b][ks]) : "v"(((d0) & 1) ? vbo : vb), "i"(((d0) >> 1) * 8192 + ks * 2048 + 1024) : "memory"); } } while (0)
      #define WT(b) asm volatile("s_waitcnt lgkmcnt(0)" : "+v"(lo[b][0]), "+v"(lo[b][1]), "+v"(lo[b][2]), "+v"(lo[b][3]), "+v"(hi_[b][0]), "+v"(hi_[b][1]), "+v"(hi_[b][2]), "+v"(hi_[b][3]) :: "memory")
      #define PK(b, k) (bf16x8){lo[b][k][0], lo[b][k][1], lo[b][k][2], lo[b][k][3], hi_[b][k][0], hi_[b][k][1], hi_[b][k][2], hi_[b][k][3]}
      #define EXQ(e) do { if (dbg & 1) { if ((e) < 16) c0[(e)] = 0.25f; else c1[(e) - 16] = 0.25f; } else if ((e) < 16) { c0[(e)] = __builtin_amdgcn_exp2f(c0[(e)]); } else { c1[(e) - 16] = __builtin_amdgcn_exp2f(c1[(e) - 16]); } } while (0)
      #define CE(e) ((e) < 16 ? c0[(e) & 15] : c1[(e) & 15])
      #define SUMQ(e) do { if ((e) >= 0) { if ((e) & 1) so_ = fadd_s(so_, CE(e)); else se_ = fadd_s(se_, CE(e)); } } while (0)
      constexpr int EPM = 32 / (4 * ND);
      #define MM(b, d0) do { _Pragma("unroll") for (int k = 0; k < 4; ++k) { \
          const bf16x8 pa_ = __builtin_bit_cast(bf16x8, k == 0 ? pw0 : k == 1 ? pw1 : k == 2 ? pw2 : pw3); \
          if (!(dbg & 2)) o[d0] = __builtin_amdgcn_mfma_f32_32x32x16_bf16(pa_, PK(b, k), o[d0], 0, 0, 0); \
          _Pragma("unroll") for (int x = 0; x < EPM; ++x) EXQ(((d0) * 4 + k) * EPM + x); \
          _Pragma("unroll") for (int x = 0; x < EPM; ++x) SUMQ(((d0) * 4 + k) * EPM + x - EPM); \
          asm volatile("" : "+v"(c0), "+v"(c1)); SBAR(); } } while (0)
      DMA_PT(2);
      float se_ = 0.f, so_ = 0.f;
      if (!(dbg & 16)) { RD(0, 0); WT(0); } else { _Pragma("unroll") for (int b_ = 0; b_ < 2; ++b_) _Pragma("unroll") for (int k_ = 0; k_ < 4; ++k_) { lo[b_][k_] = (s16x4){0, 0, 0, 0}; hi_[b_][k_] = (s16x4){0, 0, 0, 0}; } }
      #pragma unroll
      for (int d0 = 0; d0 < ND; ++d0) {
        if (d0 + 1 < ND && !(dbg & 16)) { if ((d0 & 1) == 0) RD(1, d0 + 1); else RD(0, d0 + 1); }
        SBAR();
        if (ND == 4) DMA_PT(3 + d0);
        if ((d0 & 1) == 0) MM(0, d0); else MM(1, d0);
        if (d0 + 1 < ND && !(dbg & 16)) { if ((d0 & 1) == 0) WT(1); else WT(0); }
      }
      _Pragma("unroll") for (int x = 0; x < EPM; ++x) SUMQ(32 - EPM + x);
      if (t < NT) l_reg += se_ + so_;
      DMA_PT(7);
      #undef RD
      #undef WT
      #undef PK
      #undef EXQ
      #undef MM
      #undef SUMQ
      #undef CE
    }
    TIM_AT(5);
    if (resc) { resc = false;
      asm volatile("s_waitcnt lgkmcnt(0)" ::: "memory");
      #pragma unroll
      for (int c8 = 0; c8 < 2; ++c8) { float fr_[8];
        #pragma unroll
        for (int r = 0; r < 8; ++r) fr_[r] = wsf[crow(8 * c8 + r, hi)];
        asm volatile("s_waitcnt lgkmcnt(0)" ::: "memory");
        #pragma unroll
        for (int r = 0; r < 8; ++r)
          #pragma unroll
          for (int d = 0; d < ND; ++d) o[d][8 * c8 + r] *= fr_[r]; } }
    if (t < NT) {
      #define PKW(P, B) cvtpk_s(P[B], P[B + 1])
      pw0 = (u32x4){PKW(c0, 0), PKW(c0, 2), PKW(c0, 4), PKW(c0, 6)}; pw1 = (u32x4){PKW(c0, 8), PKW(c0, 10), PKW(c0, 12), PKW(c0, 14)};
      pw2 = (u32x4){PKW(c1, 0), PKW(c1, 2), PKW(c1, 4), PKW(c1, 6)}; pw3 = (u32x4){PKW(c1, 8), PKW(c1, 10), PKW(c1, 12), PKW(c1, 14)};
      #undef PKW
      if (ATT_QKAHEAD) { SBAR(); qkt_r(c0, c1, kf, qr, negm); SBAR(); }
    }
  }
  if (ATT_STAGGER && grp == 0) asm volatile("s_barrier" ::: "memory");
#if MK_TIM
  if (NV == 2 && lane == 0 && tim_cnt) { atomicAdd(&g_tim[0], (unsigned long long)tim_sum); atomicAdd(&g_tim[1], (unsigned long long)tim_cnt); }
#endif
  { auto rr = __builtin_amdgcn_permlane32_swap(__float_as_uint(l_reg), __float_as_uint(l_reg), false, false); l_reg = __uint_as_float(rr[0]) + __uint_as_float(rr[1]); }
  l_reg += __builtin_amdgcn_exp2f(sink2 - mhat);
  if (hi == 0) wsf[32 + r32] = l_reg;
  asm volatile("s_waitcnt vmcnt(0) lgkmcnt(0)\n\ts_barrier" ::: "memory");
  float rli[16];
  #pragma unroll
  for (int c8 = 0; c8 < 2; ++c8) {
    #pragma unroll
    for (int r = 0; r < 8; ++r) rli[8 * c8 + r] = wsf[32 + crow(8 * c8 + r, hi)];
    asm volatile("s_waitcnt lgkmcnt(0)" ::: "memory"); }
  #pragma unroll
  for (int r = 0; r < 16; ++r) rli[r] = __builtin_amdgcn_rcpf(rli[r]);
  bf16_t* Ow = Op + (long)(wid * QBLK) * PO;
  { LAS bf16_t* stg = (LAS bf16_t*)((LAS char*)shm) + wid * (32 * 64 * NV);
    #pragma unroll
    for (int r = 0; r < 16; ++r) { const int orow = crow(r, hi);
      #pragma unroll
      for (int d0 = 0; d0 < ND; ++d0) stg[orow * (64 * NV) + d0 * 32 + r32] = (bf16_t)(cvtpk_s(o[d0][r] * rli[r], 0.f) & 0xffffu); }
    asm volatile("s_waitcnt lgkmcnt(0)" ::: "memory");
    constexpr int CPR = 8 * NV, RPI = 64 / CPR;
    if (NV == 2 && O1p != nullptr) {
      const bf16_t* O1w = O1p + (long)(wid * QBLK) * PO; const int ch = lane % CPR;
      float gv[8];
      { const f32x4 ga = *(const f32x4*)(gsub + ch * 8), gb = *(const f32x4*)(gsub + ch * 8 + 4);
        gv[0] = ga[0] * post; gv[1] = ga[1] * post; gv[2] = ga[2] * post; gv[3] = ga[3] * post; gv[4] = gb[0] * post; gv[5] = gb[1] * post; gv[6] = gb[2] * post; gv[7] = gb[3] * post; }
      #pragma unroll
      for (int i = 0; i < 32 / RPI; ++i) { const int row = i * RPI + lane / CPR;
        const u32x4 q = *(const LAS u32x4*)(stg + row * (64 * NV) + ch * 8); const u32x4 p = *(const u32x4*)(O1w + (long)row * PO + ch * 8);
        float x[8];
        x[0] = bf_lo(p.x) - lam * bf_lo(q.x); x[1] = bf_hi(p.x) - lam * bf_hi(q.x); x[2] = bf_lo(p.y) - lam * bf_lo(q.y); x[3] = bf_hi(p.y) - lam * bf_hi(q.y);
        x[4] = bf_lo(p.z) - lam * bf_lo(q.z); x[5] = bf_hi(p.z) - lam * bf_hi(q.z); x[6] = bf_lo(p.w) - lam * bf_lo(q.w); x[7] = bf_hi(p.w) - lam * bf_hi(q.w);
        float ss = 0.f;
        #pragma unroll
        for (int k = 0; k < 8; ++k) ss += x[k] * x[k];
        #pragma unroll
        for (int sh = 1; sh < 16; sh <<= 1) ss += __int_as_float(__builtin_amdgcn_ds_bpermute((lane ^ sh) << 2, __float_as_int(ss)));
        const float rn = 1.0f / sqrtf(ss * (1.0f / 128.0f) + SUBLN_EPS);
        u32x4 w; w.x = cvtpk_s(x[0] * rn * gv[0], x[1] * rn * gv[1]); w.y = cvtpk_s(x[2] * rn * gv[2], x[3] * rn * gv[3]);
        w.z = cvtpk_s(x[4] * rn * gv[4], x[5] * rn * gv[5]); w.w = cvtpk_s(x[6] * rn * gv[6], x[7] * rn * gv[7]);
        *(u32x4*)(Ow + (long)row * PO + ch * 8) = w; }
    } else {
    #pragma unroll
    for (int i = 0; i < 32 / RPI; ++i) { const int row = i * RPI + lane / CPR, ch = lane % CPR; const u32x4 v = *(const LAS u32x4*)(stg + row * (64 * NV) + ch * 8); *(u32x4*)(Ow + (long)row * PO + ch * 8) = v; } } }
  asm volatile("s_waitcnt lgkmcnt(0)\n\ts_barrier" ::: "memory");
  #undef DMA_K
  #undef DMA_V
}
#undef SBAR
#undef WAIT_BAR
#undef MX3
}
#ifndef XC_SLOT
#define XC_SLOT(b) (2)
#endif
constexpr size_t MiB = 1u << 20;
constexpr size_t WS_CTL = 0, CTL_ZERO_BYTES = 1 * MiB;
constexpr size_t WS_MOD = 1 * MiB;
constexpr size_t WS_LAM = WS_MOD + 512 * 1024;
constexpr size_t WS_WIN = 2 * MiB;
constexpr size_t WS_WOA = 20 * MiB, WS_WOB = 22 * MiB;
constexpr size_t WS_WR = 24 * MiB;
constexpr size_t WS_WGU = 32 * MiB;
constexpr size_t WS_WD = 288 * MiB;
constexpr size_t WS_H = 416 * MiB;
constexpr size_t WS_P = 480 * MiB;
constexpr size_t WS_OA = 752 * MiB, WS_OD = 784 * MiB, WS_OB = 848 * MiB;
constexpr size_t WS_YA = 880 * MiB, WS_Y = 944 * MiB;
constexpr size_t WS_LOG = 1008 * MiB;
constexpr size_t WS_LIST = 1012 * MiB;
constexpr size_t WS_WSLOT = 1016 * MiB;
constexpr size_t WS_LISTW = 1017 * MiB;
constexpr size_t WS_ACT = 1024 * MiB;
constexpr size_t WS_YS = 1296 * MiB;
constexpr size_t WS_SPOS = 1021 * MiB;
constexpr size_t WS_H8 = 1568 * MiB;
constexpr size_t WS_H8M = 1600 * MiB;
constexpr size_t WS_WIN8 = 14 * MiB;
constexpr size_t WS_END = 1632 * MiB;
static_assert((size_t)ACT_ROWS * D * 2 <= WS_H8 - WS_YS && (size_t)ACT_ROWS * FF * 2 <= WS_YS - WS_ACT && (size_t)M * INW * 2 <= WS_OA - WS_P, "ws map");
constexpr int CW_BAR = 4096;
constexpr int CW_CNT = 8192;
constexpr int CW_Q = 16384;

constexpr int RING_OFF = 0, RING_BYTES = 131072;
constexpr int LDSCTL_OFF = RING_BYTES;
constexpr int LW_TOFF = 64, LW_CL = 128, LW_LCNT = 192, LW_LBASE = 256, LW_QK = 320;
constexpr int LDS_BYTES = 147456;
static_assert(attn_body::LDS_BYTES <= RING_BYTES && pg8::STAGE_BYTES <= RING_BYTES, "ring");

#define RLX_AGENT __ATOMIC_RELAXED, __HIP_MEMORY_SCOPE_AGENT
#define LDS_WAIT() asm volatile("s_waitcnt lgkmcnt(0)" ::: "memory")
__device__ __forceinline__ unsigned f2bf(float f) { unsigned u = __builtin_bit_cast(unsigned, f); return (u + 0x7fffu + ((u >> 16) & 1u)) >> 16; }
__device__ __forceinline__ unsigned pk2(float lo, float hi) { return f2bf(lo) | (f2bf(hi) << 16); }

#define XB_TMO      128
#define XB_XCNT(j)  (256  + 64 * (j))
#define XB_XSUB(j)  (1280 + 64 * (j))
#define XB_XGEN(j)  (2304 + 64 * (j))
#define XB_TOP      3328
#define XB_TOPGEN   3392
#define XCD_BAR_WORDS 3456
#define XB_SPIN_CAP (1u << 18)
__device__ __forceinline__ unsigned xb_ld(unsigned* p)              { return __hip_atomic_load(p, __ATOMIC_RELAXED, __HIP_MEMORY_SCOPE_AGENT); }
__device__ __forceinline__ unsigned xb_add(unsigned* p, unsigned v) { return __hip_atomic_fetch_add(p, v, __ATOMIC_RELAXED, __HIP_MEMORY_SCOPE_AGENT); }
__device__ __forceinline__ unsigned xb_xcc_id() { return (unsigned)__builtin_amdgcn_s_getreg((3 << 11) | 20) & 0xFu; }
#define XB_SPIN(cond, bar) do { unsigned _sp = 0; while (cond) { __builtin_amdgcn_s_sleep(1); \
    if ((++_sp & 255u) == 0u) { if (xb_ld(&(bar)[XB_TMO])) break; if (_sp > XB_SPIN_CAP) { atomicAdd(&(bar)[XB_TMO], 1u); break; } } } } while (0)
struct XcdBarrier { unsigned* bar; unsigned x; volatile LAS unsigned* st; };
__device__ __forceinline__ XcdBarrier xcd_barrier_post(unsigned* bar, volatile LAS unsigned* st) {
    XcdBarrier b; b.bar = bar; b.x = xb_xcc_id(); b.st = st;
    if (threadIdx.x == 0) (void)xb_add(&bar[XB_XCNT(b.x)], 1u);
    return b;
}
__device__ __forceinline__ void xcd_barrier_complete(unsigned* bar, unsigned x, unsigned& nloc, unsigned& nx) {
    const unsigned G = gridDim.x * gridDim.y * gridDim.z;
    unsigned sum, cnt, mine, sp = 0u;
    for (;;) {
        sum = 0u; cnt = 0u; mine = 0u;
#pragma unroll
        for (unsigned j = 0; j < 16; ++j) { const unsigned c = xb_ld(&bar[XB_XCNT(j)]); sum += c; cnt += (c > 0u) ? 1u : 0u; mine = (j == x) ? c : mine; }
        if (sum == G) break;
        __builtin_amdgcn_s_sleep(1);
        if ((++sp & 255u) == 0u) { if (xb_ld(&bar[XB_TMO])) break; if (sp > XB_SPIN_CAP) { atomicAdd(&bar[XB_TMO], 1u); break; } }
    }
    nloc = mine > 0u ? mine : 1u; nx = cnt > 0u ? cnt : 1u;
}
__device__ __forceinline__ void xcd_barrier(const XcdBarrier& b) {
    asm volatile("s_waitcnt vmcnt(0)" ::: "memory");
    __syncthreads();
    if (threadIdx.x == 0) {
        unsigned* bar = b.bar; unsigned bx_ = b.x;
        asm volatile("" : "+s"(bar), "+s"(bx_));
        __builtin_amdgcn_s_waitcnt(0);
        unsigned nloc = b.st[0], nx = b.st[1];
        if (nloc == 0u) { xcd_barrier_complete(bar, bx_, nloc, nx); b.st[0] = nloc; b.st[1] = nx; }
        const unsigned old = xb_add(&bar[XB_XSUB(bx_)], 1u);
        const unsigned gen = old / nloc;
        if (old + 1u == (gen + 1u) * nloc) {
            __builtin_amdgcn_fence(__ATOMIC_RELEASE, "agent");
            asm volatile("s_waitcnt vmcnt(0)" ::: "memory");
            const unsigned og = xb_add(&bar[XB_TOP], 1u);
            const unsigned tg = og / nx;
            if (og + 1u == (tg + 1u) * nx) xb_add(&bar[XB_TOPGEN], 1u);
            else XB_SPIN(xb_ld(&bar[XB_TOPGEN]) == tg, bar);
            __builtin_amdgcn_fence(__ATOMIC_ACQUIRE, "agent");
            xb_add(&bar[XB_XGEN(bx_)], 1u);
            asm volatile("s_waitcnt vmcnt(0)" ::: "memory");
        } else {
            XB_SPIN(xb_ld(&bar[XB_XGEN(bx_)]) == gen, bar);
            __builtin_amdgcn_fence(__ATOMIC_ACQUIRE, "agent");
            asm volatile("s_waitcnt vmcnt(0)" ::: "memory");
        }
    }
    __syncthreads();
}

struct Args { const float* in[20]; float* out; unsigned char* ws; };
typedef const __attribute__((address_space(4))) Args* CArgs;
__device__ __forceinline__ CArgs launder(CArgs p) { asm volatile("" : "+s"(p)); return p; }
__device__ __forceinline__ Args load_args(CArgs p) { Args a;
#pragma unroll
    for (int i = 0; i < 20; ++i) a.in[i] = p->in[i];
    a.out = p->out; a.ws = p->ws; return a; }
constexpr int NWAVES = 8;
__device__ __forceinline__ int tid_now() { int t = threadIdx.x; asm volatile("" : "+v"(t)); return t; }
__device__ __forceinline__ float shfl_xor_l(float v, int o, int lane) { return __int_as_float(__builtin_amdgcn_ds_bpermute((lane ^ o) << 2, __float_as_int(v))); }
__device__ __forceinline__ float wave_sum(float v, int lane) {
#pragma unroll
    for (int o = 1; o < 64; o <<= 1) v += shfl_xor_l(v, o, lane);
    return v;
}
__device__ __forceinline__ float dpp_f(float v, const int ctrl_qp_b1, const int which) {
    const int i = __float_as_int(v);
    const int r = which == 0 ? __builtin_amdgcn_update_dpp(i, i, 0xB1, 0xF, 0xF, false) : which == 1 ? __builtin_amdgcn_update_dpp(i, i, 0x4E, 0xF, 0xF, false)
                : which == 2 ? __builtin_amdgcn_update_dpp(i, i, 0x141, 0xF, 0xF, false) : __builtin_amdgcn_update_dpp(i, i, 0x140, 0xF, 0xF, false);
    (void)ctrl_qp_b1; return __int_as_float(r); }
__device__ __forceinline__ float wave_sum_dpp(float v) {
    v += dpp_f(v, 0, 0); v += dpp_f(v, 0, 1); v += dpp_f(v, 0, 2); v += dpp_f(v, 0, 3);
    { auto rr = __builtin_amdgcn_permlane16_swap(__float_as_uint(v), __float_as_uint(v), false, false); v = __uint_as_float(rr[0]) + __uint_as_float(rr[1]); }
    { auto rr = __builtin_amdgcn_permlane32_swap(__float_as_uint(v), __float_as_uint(v), false, false); v = __uint_as_float(rr[0]) + __uint_as_float(rr[1]); }
    return v;
}
__device__ __forceinline__ float lam_init_of(int l) { return 0.8f - 0.6f * expf(-0.3f * (float)l); }
__device__ __forceinline__ int t5_bucket(int n) {
    if (n < 16) return n;
    const float v = logf((float)n / 16.0f) / 2.0794415416798357f * 16.0f;
    const int lg = 16 + (int)v; return lg < 31 ? lg : 31;
}
__device__ __forceinline__ void p0_transpose_item(const float* W, int K, int N, bf16_t* WT, int drow0, float scale, LAS float* scr, int kb, int nb, int lane) {
    const int k0 = 64 * kb, n0 = 32 * nb;
#pragma unroll 8
    for (int i = 0; i < 32; ++i) { const int kk = 2 * i + (lane >> 5); scr[kk * 33 + (lane & 31)] = W[(size_t)(k0 + kk) * N + n0 + (lane & 31)] * scale; }
    LDS_WAIT(); asm volatile("" ::: "memory");
    const int c = lane & 7;
#pragma unroll
    for (int j = 0; j < 4; ++j) { const int n = (lane >> 3) + 8 * j; const LAS float* s = scr + (8 * c) * 33 + n;
        u32x4 o; o.x = pk2(s[0 * 33], s[1 * 33]); o.y = pk2(s[2 * 33], s[3 * 33]); o.z = pk2(s[4 * 33], s[5 * 33]); o.w = pk2(s[6 * 33], s[7 * 33]);
        *(u32x4*)(WT + (size_t)(drow0 + n) * K + k0 + 8 * c) = o; }
    LDS_WAIT(); asm volatile("" ::: "memory");
}

__device__ __forceinline__ void p0_transpose64(const float* W, int K, int N, bf16_t* WT, int drow0, float scale, LAS unsigned* scr, int kb, int nb, int lane) {
    const int k0 = 64 * kb, n0 = 64 * nb, q = lane & 15, kk = lane >> 4;
    f32x4 v[16];
#pragma unroll
    for (int t = 0; t < 16; ++t) { const int k = 8 * (t >> 1) + 2 * kk + (t & 1); v[t] = *(const f32x4*)(W + (size_t)(k0 + k) * N + n0 + 4 * q); }
#pragma unroll
    for (int u = 0; u < 8; ++u)
#pragma unroll
        for (int i = 0; i < 4; ++i) scr[(4 * q + i) * 33 + 4 * u + kk] = cvt_pk_bf16(v[2 * u][i] * scale, v[2 * u + 1][i] * scale);
    LDS_WAIT(); asm volatile("" ::: "memory");
    const int nr = lane >> 3, c = lane & 7;
#pragma unroll
    for (int p = 0; p < 8; ++p) { const int n = 8 * p + nr; const LAS unsigned* s_ = scr + n * 33 + 4 * c;
        u32x4 o; o.x = s_[0]; o.y = s_[1]; o.z = s_[2]; o.w = s_[3];
        *(u32x4*)(WT + (size_t)(drow0 + n) * K + k0 + 8 * c) = o; }
    LDS_WAIT(); asm volatile("" ::: "memory");
}

template <bool NTL>
__device__ __forceinline__ void t64f8_load(f32x4 (&v)[16], const float* W, int N, int kb, int nb, int lane) {
    const int k0 = 64 * kb, n0 = 64 * nb, q = lane & 15, kk = lane >> 4;
#pragma unroll
    for (int t = 0; t < 16; ++t) { const int k = 16 * (t >> 2) + 4 * kk + (t & 3); const f32x4* p_ = (const f32x4*)(W + (size_t)(k0 + k) * N + n0 + 4 * q); v[t] = NTL ? __builtin_nontemporal_load(p_) : *p_; }
}
__device__ __forceinline__ void t64f8_proc(const f32x4 (&v)[16], int K, unsigned char* WT, int drow0, float scale, LAS unsigned* scr, int kb, int lane) {
    const int k0 = 64 * kb, q = lane & 15, kk = lane >> 4;
#pragma unroll
    for (int u = 0; u < 4; ++u)
#pragma unroll
        for (int i = 0; i < 4; ++i) scr[(4 * q + i) * 17 + 4 * u + kk] = pk4_fp8(v[4 * u][i] * scale, v[4 * u + 1][i] * scale, v[4 * u + 2][i] * scale, v[4 * u + 3][i] * scale);
    LDS_WAIT(); asm volatile("" ::: "memory");
    const int nr = lane >> 2, c = lane & 3;
#pragma unroll
    for (int p = 0; p < 4; ++p) { const int n = 16 * p + nr; const LAS unsigned* s_ = scr + n * 17 + 4 * c;
        u32x4 o; o.x = s_[0]; o.y = s_[1]; o.z = s_[2]; o.w = s_[3];
        *(u32x4*)(WT + (size_t)(drow0 + n) * K + k0 + 16 * c) = o; }
    LDS_WAIT(); asm volatile("" ::: "memory");
}
template <bool NTL = false>
__device__ __forceinline__ void p0_transpose64_f8(const float* W, int K, int N, unsigned char* WT, int drow0, float scale, LAS unsigned* scr, int kb, int nb, int lane) {
    f32x4 v[16]; t64f8_load<NTL>(v, W, N, kb, nb, lane); t64f8_proc(v, K, WT, drow0, scale, scr, kb, lane);
}

template <int MODE>
__device__ __forceinline__ void row_pass(CArgs ap, int l, int vcu, int G, const LAS int* toffl = nullptr) {
    ap = launder(ap); const int tid_ = tid_now(), lane = tid_ & 63, wave = __builtin_amdgcn_readfirstlane(tid_ >> 6); const Args a = load_args(ap);
    unsigned char* ws = a.ws;
    const float* mod = (const float*)(ws + WS_MOD);
    const bf16_t* Y = (const bf16_t*)(ws + WS_Y); const bf16_t* YS = (const bf16_t*)(ws + WS_YS); bf16_t* H = (bf16_t*)(ws + WS_H);
    const float* xin = (MODE == 0 || (MODE == 1 && l == 0)) ? a.in[0] : a.out;
    const bool need_h = (MODE != 2) || (l + 1 < DEPTH);
    const int lh = (MODE == 2) ? l + 1 : l;
    const float* gpre = (MODE == 1) ? a.in[7] + (size_t)l * D : a.in[5] + (size_t)(lh < DEPTH ? lh : 0) * D;
    const float* gpost = (MODE == 1) ? a.in[6] + (size_t)l * D : a.in[8] + (size_t)l * D;
    const int gw = vcu * NWAVES + wave, NGW = G * NWAVES, RPW = (M + NGW - 1) / NGW;
    int m0 = gw * RPW, m1 = m0 + RPW; if (m1 > M) m1 = M;
    f32x4 a_r[4], a_h[4], s_h[4]; int curb = -1;
#ifndef ROWS_PER_STEP
#define ROWS_PER_STEP 2
#endif
    constexpr int RR = ROWS_PER_STEP;
    for (int mb_ = m0; mb_ < m1; mb_ += RR) {
        const int b = mb_ / SEQ;
        if (b != curb) { curb = b;
            const float* mb = mod + (size_t)((l * BATCH + b) * 6) * D; const float* mh = mod + (size_t)(((lh < DEPTH ? lh : 0) * BATCH + b) * 6) * D;
#pragma unroll
            for (int j = 0; j < 4; ++j) { const int c = 4 * lane + 256 * j;
                if (MODE == 1) { a_r[j] = *(const f32x4*)(mb + 2 * D + c) * *(const f32x4*)(gpost + c); a_h[j] = *(const f32x4*)(gpre + c) * (*(const f32x4*)(mb + 4 * D + c) + 1.0f); s_h[j] = *(const f32x4*)(mb + 3 * D + c); }
                else { if (MODE == 2) a_r[j] = *(const f32x4*)(mb + 5 * D + c) * *(const f32x4*)(gpost + c);
                       a_h[j] = *(const f32x4*)(gpre + c) * (*(const f32x4*)(mh + 1 * D + c) + 1.0f); s_h[j] = *(const f32x4*)(mh + 0 * D + c); } } }
        f32x4 xv[RR][4], yv[RR][4]; int mrow[RR];
#pragma unroll
        for (int r = 0; r < RR; ++r) { mrow[r] = (mb_ + r < m1) ? mb_ + r : m1 - 1;
#pragma unroll
            for (int j = 0; j < 4; ++j) xv[r][j] = *(const f32x4*)(xin + (size_t)mrow[r] * D + 4 * lane + 256 * j); }
        if (MODE != 0) {
            if (MODE == 1) {
#pragma unroll
                for (int r = 0; r < RR; ++r)
#pragma unroll
                    for (int j = 0; j < 4; ++j) { const u32x2 w = *(const u32x2*)(Y + (size_t)mrow[r] * D + 4 * lane + 256 * j); yv[r][j] = (f32x4){bf_lo(w.x), bf_hi(w.x), bf_lo(w.y), bf_hi(w.y)}; }
            } else {
                u32x4 sp[RR];
#pragma unroll
                for (int r = 0; r < RR; ++r) sp[r] = *(const u32x4*)(ws + WS_SPOS + (size_t)mrow[r] * TOPK * 4);
                unsigned w8[RR][TOPK][4];
#pragma unroll
                for (int r = 0; r < RR; ++r) { int srow[TOPK];
                    srow[0] = toffl[sp[r].x >> 16] * 256 + (int)(sp[r].x & 0xffffu); srow[1] = toffl[sp[r].y >> 16] * 256 + (int)(sp[r].y & 0xffffu);
                    srow[2] = toffl[sp[r].z >> 16] * 256 + (int)(sp[r].z & 0xffffu); srow[3] = toffl[sp[r].w >> 16] * 256 + (int)(sp[r].w & 0xffffu);
#pragma unroll
                    for (int k = 0; k < TOPK; ++k)
#pragma unroll
                        for (int j = 0; j < 4; ++j) w8[r][k][j] = *(const unsigned*)((const unsigned char*)YS + (size_t)srow[k] * D + 4 * lane + 256 * j); }
#pragma unroll
                for (int r = 0; r < RR; ++r)
#pragma unroll
                    for (int j = 0; j < 4; ++j) { yv[r][j] = (f32x4){0.f, 0.f, 0.f, 0.f};
#pragma unroll
                        for (int k = 0; k < TOPK; ++k) { const auto lo2 = __builtin_amdgcn_cvt_pk_f32_fp8(w8[r][k][j], false), hi2 = __builtin_amdgcn_cvt_pk_f32_fp8(w8[r][k][j], true); yv[r][j] += (f32x4){lo2[0], lo2[1], hi2[0], hi2[1]}; }
                        yv[r][j] = yv[r][j] * (1.0f / F8_SY); }
            }
            float ss[RR];
#pragma unroll
            for (int r = 0; r < RR; ++r) { ss[r] = 0.f;
#pragma unroll
                for (int j = 0; j < 4; ++j) ss[r] += (yv[r][j].x * yv[r][j].x + yv[r][j].y * yv[r][j].y) + (yv[r][j].z * yv[r][j].z + yv[r][j].w * yv[r][j].w); }
#pragma unroll
            for (int r = 0; r < RR; ++r) { const float rn = 1.0f / sqrtf(wave_sum_dpp(ss[r]) * (1.0f / D) + NORM_EPS);
#pragma unroll
                for (int j = 0; j < 4; ++j) { xv[r][j] = xv[r][j] + a_r[j] * (yv[r][j] * rn); *(f32x4*)(a.out + (size_t)mrow[r] * D + 4 * lane + 256 * j) = xv[r][j]; } }
        }
        if (need_h) {
            float ss[RR];
#pragma unroll
            for (int r = 0; r < RR; ++r) { ss[r] = 0.f;
#pragma unroll
                for (int j = 0; j < 4; ++j) ss[r] += (xv[r][j].x * xv[r][j].x + xv[r][j].y * xv[r][j].y) + (xv[r][j].z * xv[r][j].z + xv[r][j].w * xv[r][j].w); }
#pragma unroll
            for (int r = 0; r < RR; ++r) { const float rn = 1.0f / sqrtf(wave_sum_dpp(ss[r]) * (1.0f / D) + NORM_EPS);
#pragma unroll
                for (int j = 0; j < 4; ++j) { const f32x4 h = (xv[r][j] * rn) * a_h[j] + s_h[j]; u32x2 w; w.x = cvt_pk_bf16(h.x, h.y); w.y = cvt_pk_bf16(h.z, h.w);
                    *(u32x2*)(H + (size_t)mrow[r] * D + 4 * lane + 256 * j) = w;
                    *(unsigned*)(ws + (MODE == 1 ? WS_H8 : WS_H8M) + (size_t)mrow[r] * D + 4 * lane + 256 * j) = pk4_fp8(h.x * F8_SH, h.y * F8_SH, h.z * F8_SH, h.w * F8_SH); } }
        }
    }
}

__device__ __forceinline__ void diff_combine(CArgs ap, int l, int vcu, int G) {
    ap = launder(ap); const int tid_ = tid_now(), lane = tid_ & 63, wave = __builtin_amdgcn_readfirstlane(tid_ >> 6);
    unsigned char* ws = ap->ws; struct { const float* in[14]; } a; a.in[13] = ap->in[13];
    const bf16_t* O1 = (const bf16_t*)(ws + WS_OD); const bf16_t* O2 = O1 + (size_t)M * 512; bf16_t* OB = (bf16_t*)(ws + WS_OB);
    const float lam = ((const float*)(ws + WS_LAM))[l]; const float post = 1.0f - lam_init_of(l);
    const float* g = a.in[13] + (size_t)l * 128 + (8 * lane) % 128;
    float gv[8];
#pragma unroll
    for (int i = 0; i < 8; ++i) gv[i] = g[i] * post;
    const int gw = vcu * NWAVES + wave, NGW = G * NWAVES;
    for (int m = gw; m < M; m += NGW) {
        const u32x4 p = *(const u32x4*)(O1 + (size_t)m * 512 + 8 * lane), q = *(const u32x4*)(O2 + (size_t)m * 512 + 8 * lane);
        float o[8];
        o[0] = bf_lo(p.x) - lam * bf_lo(q.x); o[1] = bf_hi(p.x) - lam * bf_hi(q.x); o[2] = bf_lo(p.y) - lam * bf_lo(q.y); o[3] = bf_hi(p.y) - lam * bf_hi(q.y);
        o[4] = bf_lo(p.z) - lam * bf_lo(q.z); o[5] = bf_hi(p.z) - lam * bf_hi(q.z); o[6] = bf_lo(p.w) - lam * bf_lo(q.w); o[7] = bf_hi(p.w) - lam * bf_hi(q.w);
        float ss = 0.f;
#pragma unroll
        for (int i = 0; i < 8; ++i) ss += o[i] * o[i];
        ss += shfl_xor_l(ss, 1, lane); ss += shfl_xor_l(ss, 2, lane); ss += shfl_xor_l(ss, 4, lane); ss += shfl_xor_l(ss, 8, lane);
        const float r = 1.0f / sqrtf(ss * (1.0f / 128.0f) + SUBLN_EPS);
        u32x4 w; w.x = cvt_pk_bf16(o[0] * r * gv[0], o[1] * r * gv[1]); w.y = cvt_pk_bf16(o[2] * r * gv[2], o[3] * r * gv[3]);
        w.z = cvt_pk_bf16(o[4] * r * gv[4], o[5] * r * gv[5]); w.w = cvt_pk_bf16(o[6] * r * gv[6], o[7] * r * gv[7]);
        *(u32x4*)(OB + (size_t)m * 512 + 8 * lane) = w;
    }
}

__device__ __forceinline__ void topk_lists(CArgs ap, int l, int G, volatile LAS unsigned* LW) {
    ap = launder(ap);
    unsigned char* ws = ap->ws;
    const float* LOG = (const float*)(ws + WS_LOG); int* LIST = (int*)(ws + WS_LIST); float* WSLOT = (float*)(ws + WS_WSLOT);
    unsigned* CNT = (unsigned*)(ws + WS_CTL) + CW_CNT + l * NE;
    int tid = threadIdx.x; asm volatile("" : "+v"(tid)); const int TPW = (M + G - 1) / G;
    for (int base = blockIdx.x * TPW, done = 0; done < TPW; done += 512) {
        if (tid < NE) LW[LW_LCNT + tid] = 0u;
        __syncthreads();
        const int m = base + done + tid; const bool act = (done + tid < TPW) && (m < M);
        int ek[TOPK]; float wk[TOPK]; unsigned lp[TOPK];
        if (act) {
            float v[NE];
#pragma unroll
            for (int q = 0; q < NE / 4; ++q) { const f32x4 t = *(const f32x4*)(LOG + (size_t)m * NE + 4 * q); v[4 * q] = t.x; v[4 * q + 1] = t.y; v[4 * q + 2] = t.z; v[4 * q + 3] = t.w; }
            unsigned taken = 0u;
#pragma unroll
            for (int k = 0; k < TOPK; ++k) { float best = -INFINITY; int bi = 0;
#pragma unroll
                for (int e = 0; e < NE; ++e) { const bool ok = !((taken >> e) & 1u) && (v[e] > best); best = ok ? v[e] : best; bi = ok ? e : bi; }
                taken |= 1u << bi; ek[k] = bi; wk[k] = best; }
            float s = 0.f; const float mx = wk[0];
#pragma unroll
            for (int k = 0; k < TOPK; ++k) { wk[k] = expf(wk[k] - mx > -80.f ? wk[k] - mx : -80.f); s += wk[k]; }
#pragma unroll
            for (int k = 0; k < TOPK; ++k) { wk[k] = wk[k] / s; lp[k] = __hip_atomic_fetch_add((LAS unsigned*)&LW[LW_LCNT + ek[k]], 1u, __ATOMIC_RELAXED, __HIP_MEMORY_SCOPE_WORKGROUP); }
        }
        __syncthreads();
        if (tid < NE) { const unsigned c = LW[LW_LCNT + tid]; LW[LW_LBASE + tid] = c ? __hip_atomic_fetch_add(CNT + tid, c, RLX_AGENT) : 0u; }
        __syncthreads();
        if (act) {
#pragma unroll
            for (int k = 0; k < TOPK; ++k) { const unsigned pos = LW[LW_LBASE + ek[k]] + lp[k]; __hip_atomic_store(LIST + (size_t)ek[k] * CAP + pos, m * TOPK + k, RLX_AGENT);
                __hip_atomic_store((float*)(ws + WS_LISTW) + (size_t)ek[k] * CAP + pos, wk[k], RLX_AGENT);
                ((unsigned*)(ws + WS_SPOS))[(size_t)m * TOPK + k] = ((unsigned)ek[k] << 16) | pos; }
        }
        __syncthreads();
    }
}

__device__ __forceinline__ void p0_prologue(CArgs ap, LAS unsigned char* lds, int vcu, int G) {
    ap = launder(ap); const Args a = load_args(ap);
    unsigned char* ws = a.ws; const int tid = tid_now(), lane = tid & 63, wave = __builtin_amdgcn_readfirstlane(tid >> 6);
    LAS float* ca = (LAS float*)(lds + RING_OFF); LAS float* red = (LAS float*)(lds + RING_OFF + 8192);
    for (int i = tid; i < BATCH * D; i += NWAVES * 64) { const float v = a.in[1][i]; ca[i] = v / (1.0f + expf(-v)); }
    __syncthreads();
    float* mod = (float*)(ws + WS_MOD);
    for (int it = blockIdx.x; it < DEPTH * (6 * D / 32); it += G) {
        const int l = it / (6 * D / 32), cg = it % (6 * D / 32), c = tid & 31, kc = tid >> 5;
        const float* w = a.in[3] + (size_t)l * D * 6 * D + cg * 32 + c;
        float s0 = 0.f, s1 = 0.f;
#pragma unroll 8
        for (int k = kc * 64; k < kc * 64 + 64; ++k) { const float wv = w[(size_t)k * 6 * D]; s0 += ca[k] * wv; s1 += ca[D + k] * wv; }
        red[(kc * 32 + c) * 2] = s0; red[(kc * 32 + c) * 2 + 1] = s1;
        __syncthreads();
        if (tid < 64) { const int cc = tid & 31, b = tid >> 5; float s = 0.f;
#pragma unroll
            for (int k = 0; k < 16; ++k) s += red[(k * 32 + cc) * 2 + b];
            mod[(size_t)(l * BATCH + b) * 6 * D + cg * 32 + cc] = s + a.in[4][(size_t)l * 6 * D + cg * 32 + cc]; }
        __syncthreads();
    }
    if (blockIdx.x == 0 && wave == 0) {
        for (int l = 0; l < DEPTH; ++l) { const float* lp = a.in[12] + (size_t)l * 256;
            const float s01 = wave_sum(lp[lane] * lp[64 + lane], lane), s23 = wave_sum(lp[128 + lane] * lp[192 + lane], lane);
            if (lane == 0) ((float*)(ws + WS_LAM))[l] = expf(s01) - expf(s23) + lam_init_of(l); }
    }
    { u32x4* z = (u32x4*)(ws + WS_WR); const u32x4 zero = {0u, 0u, 0u, 0u};
      for (int l = 0; l < DEPTH; ++l) for (int i = blockIdx.x * NWAVES * 64 + tid; i < 224 * D * 2 / 16; i += G * NWAVES * 64) z[(size_t)l * (256 * D * 2 / 16) + 32 * D * 2 / 16 + i] = zero; }
    LAS float* scr = (LAS float*)(lds + RING_OFF + wave * 16384); LAS unsigned* scru = (LAS unsigned*)scr;
    const int gw = vcu * NWAVES + wave, NGW = G * NWAVES;
    constexpr int I_IN = 16 * (INW / 64), I_O = 8 * (D / 64), I_R = 16, I_GU1 = 16 * (2 * FF / 64), I_GU = NE * I_GU1, I_D1 = 16 * (D / 64), I_DN = NE * I_D1;
    constexpr int I_LAYER = I_IN + 2 * I_O + I_R + I_GU + I_DN;
    for (int it = gw; it < DEPTH * I_LAYER; it += NGW) {
        const int l = it / I_LAYER; int r = it - l * I_LAYER;
        if (r < I_IN) { const int nblk = INW / 64, kb = r / nblk, nb = r % nblk, n0 = 64 * nb;
            const float sc = (n0 < C_KA || (n0 >= C_QB && n0 < C_KB)) ? QSCALE : 1.0f;
            if (n0 < C_GZA) p0_transpose64(a.in[9] + (size_t)l * D * INW, D, INW, (bf16_t*)(ws + WS_WIN) + (size_t)l * C_GZA * D, n0, sc, scru, kb, nb, lane);
            else p0_transpose64_f8(a.in[9] + (size_t)l * D * INW, D, INW, ws + WS_WIN8 + (size_t)l * (INW - C_GZA) * D, n0 - C_GZA, F8_SW, scru, kb, nb, lane);
            continue; }
        r -= I_IN;
        if (r < 2 * I_O) { const int half = r / I_O; r -= half * I_O; const int nblk = D / 64, kb = r / nblk, nb = r % nblk;
            p0_transpose64(a.in[10] + (size_t)l * D * D + (size_t)half * 512 * D, 512, D, (bf16_t*)(ws + (half ? WS_WOB : WS_WOA)) + (size_t)l * D * 512, 64 * nb, 1.0f, scru, kb, nb, lane); continue; }
        r -= 2 * I_O;
        if (r < I_R) { p0_transpose_item(a.in[14] + (size_t)l * D * NE, D, NE, (bf16_t*)(ws + WS_WR) + (size_t)l * 256 * D, 0, 1.0f, scr, r, 0, lane); continue; }
    }
}

__device__ __forceinline__ void expert_convert(CArgs ap, int l, LAS unsigned char* lds, int c, int G) {
    ap = launder(ap); const Args a = load_args(ap);
    unsigned char* ws = a.ws; const int tid = tid_now(), lane = tid & 63, wave = __builtin_amdgcn_readfirstlane(tid >> 6);
    LAS unsigned* scru = (LAS unsigned*)(lds + RING_OFF + wave * 4608);
    constexpr int I_GU1 = 16 * (2 * FF / 64), I_GU = NE * I_GU1, I_D1 = 16 * (D / 64), I_DN = NE * I_D1;
    const int gw = c * NWAVES + wave, NGW = G * NWAVES;
    struct Dsc { const float* W; unsigned char* WT; int K, N, drow0, kb, nb; };
    auto dsc = [&](int it) { int r = it; Dsc d;
        if (r < I_GU) { const int e = r / I_GU1; r -= e * I_GU1; const int nblk = 2 * FF / 64, kb = r / nblk, nb = r % nblk, n0 = 64 * nb; const int j = n0 % FF;
            d.W = a.in[16] + ((size_t)l * NE + e) * D * 2 * FF; d.WT = ws + WS_WGU + ((size_t)l * NE + e) * 2 * FF * D; d.K = D; d.N = 2 * FF; d.drow0 = (j / 128) * 256 + (n0 >= FF ? 128 : 0) + (j % 128); d.kb = kb; d.nb = nb; }
        else { r -= I_GU; const int e = r / I_D1; r -= e * I_D1; const int nblk = D / 64, kb = r / nblk, nb = r % nblk;
            d.W = a.in[18] + ((size_t)l * NE + e) * FF * D; d.WT = ws + WS_WD + ((size_t)l * NE + e) * D * FF; d.K = FF; d.N = D; d.drow0 = 64 * nb; d.kb = kb; d.nb = nb; }
        return d; };
    constexpr int NIT = I_GU + I_DN;
    int i0 = gw;
    if (i0 < NIT) { f32x4 va[16], vb[16]; Dsc d0 = dsc(i0); t64f8_load<true>(va, d0.W, d0.N, d0.kb, d0.nb, lane);
#pragma unroll 1
        for (;;) {
            const int i1 = i0 + NGW; Dsc d1 = d0;
            if (i1 < NIT) { d1 = dsc(i1); t64f8_load<true>(vb, d1.W, d1.N, d1.kb, d1.nb, lane); }
            t64f8_proc(va, d0.K, d0.WT, d0.drow0, F8_SW, scru, d0.kb, lane);
            if (i1 >= NIT) break;
            i0 = i1 + NGW;
            if (i0 < NIT) { d0 = dsc(i0); t64f8_load<true>(va, d0.W, d0.N, d0.kb, d0.nb, lane); }
            t64f8_proc(vb, d1.K, d1.WT, d1.drow0, F8_SW, scru, d1.kb, lane);
            if (i0 >= NIT) break;
        } }
    __syncthreads();
}

__device__ __forceinline__ void attn_fill_tab(const float* rel, int col, bool swa, LAS float* tab) {
    for (int j = tid_now(); j < attn_body::TAB_N; j += NWAVES * 64) {
        const int dist = j - 255; float v;
        if (dist < 0) v = -INFINITY;
        else if (swa) v = dist >= 128 ? -INFINITY : rel[t5_bucket(dist) * NBH + col] * LOG2E;
        else v = (rel[t5_bucket(dist < 127 ? dist : 127) * NBH + col] - rel[31 * NBH + col]) * LOG2E;
        tab[j] = v;
    }
}
#ifndef MK_ADBG
#define MK_ADBG 0
#endif
__device__ __forceinline__ void attn_phase(CArgs ap, int l, char* lds, int vcu, int G, int rep = 0) {
    ap = launder(ap);
    unsigned char* ws = ap->ws; struct { const float* in[14]; } a; a.in[2] = ap->in[2]; a.in[11] = ap->in[11]; a.in[13] = ap->in[13];
    const int dbg = rep ? MK_ADBG : 0;
    const bf16_t* P = (const bf16_t*)(ws + WS_P); bf16_t* OA = (bf16_t*)(ws + (rep ? WS_YA : WS_OA)); bf16_t* OD = (bf16_t*)(ws + (rep ? WS_YA + 32 * MiB : WS_OD)); bf16_t* OBo = (bf16_t*)(ws + (rep ? WS_Y : WS_OB));
    LAS float* tab = (LAS float*)((LAS char*)lds + attn_body::LDS_TAB);
    const float* rel = a.in[2];
    for (int v = vcu; v < 256; v += G) {
        const int u = v & 31, h = (v >> 5) & 3, b = v >> 7;
        attn_fill_tab(rel, HA + h, false, tab);
        const float lam = ((const float*)(ws + WS_LAM))[l], post = 1.0f - lam_init_of(l);
        const float* gsub = a.in[13] + (size_t)l * 128;
#pragma unroll 1
        for (int i = 0; i < 4; ++i) {
            const int mp = i & 1, qb = (i >> 1) ? u : 63 - u;
            const size_t row0 = (size_t)b * SEQ + (size_t)qb * 256;
            const bf16_t* Kp = P + (size_t)b * SEQ * PITCH + C_KB + h * 128 + mp * 64;
            const bf16_t* Vp = P + (size_t)b * SEQ * PITCH + C_VB + h * 128;
            bf16_t* O1 = OD + row0 * 512 + h * 128;
            attn_body::attn_unit<8, PITCH, 512, 2>(P + row0 * PITCH + C_QB + h * 128 + mp * 64, Kp, Vp, mp ? OBo + row0 * 512 + h * 128 : O1,
                                                   (dbg & 64) ? 4 : 4 * (qb + 1), -30.0f, -INFINITY, lds, dbg, mp ? O1 : nullptr, lam, gsub, post);
            if (!rep && i == XC_SLOT(blockIdx.x)) expert_convert(ap, l, (LAS unsigned char*)((LAS char*)lds - RING_OFF), blockIdx.x, G);
        }
        if (G == 256) {
            unsigned* Q = (unsigned*)(ws + WS_CTL) + CW_Q + (l * 2 + (rep ? 1 : 0)) * 8;
            volatile LAS unsigned* LWq = (volatile LAS unsigned*)((LAS char*)lds + LDSCTL_OFF - RING_OFF) + LW_QK;
            int qx = blockIdx.x & 7, tries = 0, cur_ha = -1, k0 = 0, kn = 0;
#pragma unroll 1
            for (;;) {
                if (k0 >= kn) {
                    if (tries >= 8) break;
                    const unsigned take = tries == 0 ? 2u : 1u;
                    if (tid_now() == 0) LWq[0] = __hip_atomic_fetch_add(Q + qx, take, RLX_AGENT);
                    __syncthreads(); k0 = (int)LWq[0]; __syncthreads();
                    kn = k0 + (int)take; kn = kn > 128 ? 128 : kn;
                    if (k0 >= 128) { qx = (qx + 1) & 7; ++tries; k0 = kn = 0; continue; }
                }
                const int id = qx * 128 + k0; ++k0;
                const int qb = id & 63, ha = (id >> 6) & 7, bb = id >> 9;
                if (ha != cur_ha) { attn_fill_tab(rel, ha, true, tab); cur_ha = ha; }
                const size_t row0 = (size_t)bb * SEQ + (size_t)qb * 256, krow = row0 - (qb ? 128 : 0);
                const float sink2 = a.in[11][l * HA + ha] * LOG2E;
                attn_body::attn_unit<8, PITCH, 512, 1>(P + row0 * PITCH + C_QA + ha * 64, P + krow * PITCH + C_KA + (ha >> 2) * 64, P + krow * PITCH + C_VA + (ha >> 2) * 64,
                                                       OA + row0 * 512 + ha * 64, qb ? 6 : 4, sink2, sink2, lds, dbg);
            }
        } else {
#pragma unroll 1
        for (int i = 0; i < 4; ++i) {
            const int id = v * 4 + i, qb = id & 63, ha = (id >> 6) & 7, bb = id >> 9;
            if (i == 0) attn_fill_tab(rel, ha, true, tab);
            const size_t row0 = (size_t)bb * SEQ + (size_t)qb * 256, krow = row0 - (qb ? 128 : 0);
            const float sink2 = a.in[11][l * HA + ha] * LOG2E;
            attn_body::attn_unit<8, PITCH, 512, 1>(P + row0 * PITCH + C_QA + ha * 64, P + krow * PITCH + C_KA + (ha >> 2) * 64, P + krow * PITCH + C_VA + (ha >> 2) * 64,
                                                   OA + row0 * 512 + ha * 64, qb ? 6 : 4, sink2, sink2, lds, dbg);
        } }
    }
}

#ifndef MK_PROBE
#define MK_PROBE 0
#endif
#ifndef MK_PFA
#define MK_PFA 0
#endif
constexpr bool PFA_ON = MK_PFA != 0;
#ifndef MK_DUP
#define MK_DUP 0
#endif
constexpr int CW_DIG = 12288;
__device__ __forceinline__ void probe_rows(CArgs ap, const bf16_t* base, int nrows_total, bool by_tile, const LAS int* toff, const LAS int* cl, int vcu, int G) {
    unsigned* DIG = (unsigned*)(launder(ap)->ws + WS_CTL) + CW_DIG;
    const int tid = tid_now(), lane = tid & 63, wave = tid >> 6;
    if (by_tile) {
        const int ntile = toff[NE];
        for (int gt = vcu; gt < ntile; gt += G) {
            int e = 0;
            for (int k = 16; k >= 1; k >>= 1) if (toff[e + k] <= gt) e += k;
            const int rt = gt - toff[e]; int nv = cl[e] - rt * 256; nv = nv > 256 ? 256 : nv;
            unsigned s = 0u;
            for (int r = wave; r < nv; r += NWAVES) { const u32x4* p = (const u32x4*)(base + ((size_t)gt * 256 + r) * 1024 + lane * 16); const u32x4 a = p[0], b = p[1];
                s += (a.x & 0xffffu) + (a.x >> 16) + (a.y & 0xffffu) + (a.y >> 16) + (a.z & 0xffffu) + (a.z >> 16) + (a.w & 0xffffu) + (a.w >> 16);
                s += (b.x & 0xffffu) + (b.x >> 16) + (b.y & 0xffffu) + (b.y >> 16) + (b.z & 0xffffu) + (b.z >> 16) + (b.w & 0xffffu) + (b.w >> 16); }
            __hip_atomic_fetch_add(DIG + e, s, RLX_AGENT);
        }
    } else {
        for (int r = vcu * NWAVES + wave; r < nrows_total; r += G * NWAVES) { const u32x4* p = (const u32x4*)(base + (size_t)r * 1024 + lane * 16); const u32x4 a = p[0], b = p[1];
            unsigned s = (a.x & 0xffffu) + (a.x >> 16) + (a.y & 0xffffu) + (a.y >> 16) + (a.z & 0xffffu) + (a.z >> 16) + (a.w & 0xffffu) + (a.w >> 16);
            s += (b.x & 0xffffu) + (b.x >> 16) + (b.y & 0xffffu) + (b.y >> 16) + (b.z & 0xffffu) + (b.z >> 16) + (b.w & 0xffffu) + (b.w >> 16);
            __hip_atomic_fetch_add(DIG + (r & 31), s, RLX_AGENT); }
    }
}
__device__ __forceinline__ void probe_lists(CArgs ap, int l, int vcu, int G) {
    unsigned char* ws = launder(ap)->ws; unsigned* DIG = (unsigned*)(ws + WS_CTL) + CW_DIG; const int* LIST = (const int*)(ws + WS_LIST);
    const int tid = tid_now();
    for (int e = vcu; e < NE; e += G) { const int cnt = (int)__hip_atomic_load((unsigned*)(ws + WS_CTL) + CW_CNT + l * NE + e, RLX_AGENT);
        unsigned s1 = 0u, s2 = 0u;
        for (int i = tid; i < cnt; i += NWAVES * 64) { const unsigned v = (unsigned)LIST[(size_t)e * CAP + i]; s1 += v; s2 += (v * 2654435761u) >> 9; }
        __hip_atomic_fetch_add(DIG + e, s1, RLX_AGENT); __hip_atomic_fetch_add(DIG + 32 + e, s2 + (unsigned)cnt * 7919u, RLX_AGENT); }
}
__device__ __forceinline__ void probe_dump(CArgs ap) {
    const CArgs aq = launder(ap); const unsigned* DIG = (const unsigned*)(aq->ws + WS_CTL) + CW_DIG; float* out = aq->out; const int tid = tid_now();
    if (blockIdx.x == 0 && tid < 64) out[tid] = (float)(__hip_atomic_load((unsigned*)DIG + tid, RLX_AGENT) & 0x7fffffu) * (1.0f / 65536.0f);
}

__device__ __forceinline__ void probe_region(CArgs ap, size_t off, size_t nwords, int G) {
    unsigned char* ws = launder(ap)->ws; unsigned* DIG = (unsigned*)(ws + WS_CTL) + CW_DIG; const unsigned* src = (const unsigned*)(ws + off);
    const int t = tid_now(); unsigned sacc = 0u;
    for (size_t i = (size_t)blockIdx.x * NWAVES * 64 + t; i < nwords; i += (size_t)G * NWAVES * 64) { const unsigned v = src[i]; sacc += (v & 0xffffu) + (v >> 16); }
    __hip_atomic_fetch_add(DIG + (t & 63), sacc, RLX_AGENT);
}
#define PROBE_AT(id, off, nwords) do { if (MK_PROBE == (id)) { probe_region(ap, off, nwords, G); GRID_BAR(); probe_dump(ap); return; } } while (0)

__global__ void __launch_bounds__(NWAVES * 64, 2) mk_fwd(Args a) {
    extern __shared__ __attribute__((aligned(16))) unsigned char lds_raw[];
    LAS unsigned char* lds = (LAS unsigned char*)lds_raw;
    volatile LAS unsigned* LW = (volatile LAS unsigned*)(lds + LDSCTL_OFF);
    const int tid = tid_now();
    const int G = gridDim.x; const int bx = blockIdx.x; const int vcu = (G % 8 == 0) ? (bx % 8) * (G / 8) + bx / 8 : bx;
    const CArgs ap = (CArgs)__builtin_amdgcn_kernarg_segment_ptr();
    for (int u = tid; u < (LDS_BYTES - LDSCTL_OFF) / 4; u += NWAVES * 64) ((LAS unsigned*)(lds + LDSCTL_OFF))[u] = 0u;
    __syncthreads();
    XcdBarrier bar = xcd_barrier_post((unsigned*)(ap->ws + WS_CTL) + CW_BAR, LW + 8);
#define GRID_BAR() xcd_barrier(bar)

#ifndef PH_MASK
#define PH_MASK 0xFFFF
#endif
#define PH(k) ((PH_MASK >> (k)) & 1)
#pragma unroll 1
    for (int rep = 0; rep < ((MK_DUP & 1) ? 2 : 1); ++rep) {
    if (PH(0)) p0_prologue(ap, lds, vcu, G);
    GRID_BAR(); }
    PROBE_AT(10, WS_MOD, (size_t)DEPTH * BATCH * 6 * D);
    PROBE_AT(11, WS_WIN, (size_t)DEPTH * INW * D / 2);
    PROBE_AT(12, WS_WOA, (size_t)4 * MiB / 4);
    if (PH(0)) row_pass<0>(ap, 0, vcu, G);
    GRID_BAR();
    PROBE_AT(13, WS_H, (size_t)M * D / 2);

#pragma unroll 1
    for (int l = 0; l < DEPTH; ++l) {
#pragma unroll 1
        for (int rep = 0; rep < ((MK_DUP & 2) ? 2 : 1); ++rep) {
        if (PH(1)) { unsigned char* ws = launder(ap)->ws; bf16_t* H = (bf16_t*)(ws + WS_H); bf16_t* P = (bf16_t*)(ws + WS_P);
          { pg8::Gemm g{H, (const bf16_t*)(ws + WS_WIN) + (size_t)l * C_GZA * D, D, 0, nullptr}; pg8::StaticOrder S; S.init(M, C_GZA, G, bx);
            pg8::EpiBf16 E{P, PITCH, 1.0f};
            pg8::gemm_phase<pg8::EpiBf16, pg8::StaticOrder, false, true>(lds + RING_OFF, g, S, E); }
          { pg8::Gemm g{(const bf16_t*)(ws + WS_H8M), (const bf16_t*)(ws + WS_WIN8 + (size_t)l * (INW - C_GZA) * D), D / 2, 0, nullptr}; pg8::StaticOrder S; S.init(M, INW - C_GZA, G, bx, 1);
            pg8::EpiBf16 E{P + C_GZA, PITCH, 1.0f / (F8_SH * F8_SW)};
            pg8::gemm_phase<pg8::EpiBf16, pg8::StaticOrder, false, true, true>(lds + RING_OFF, g, S, E); } }
        GRID_BAR(); }
        PROBE_AT(14, WS_P, (size_t)M * INW / 2);
#pragma unroll 1
        for (int rep = 0; rep < ((MK_DUP & 4) ? 2 : 1); ++rep) {
        if (PH(2)) attn_phase(ap, l, (char*)lds_raw + RING_OFF, vcu, G, rep);
        GRID_BAR(); }
        PROBE_AT(15, WS_OA, (size_t)M * 512 / 2);
        PROBE_AT(16, WS_OD, (size_t)M * 512);
        PROBE_AT(17, WS_OB, (size_t)M * 512 / 2);
        if (PH(4)) { unsigned char* ws = launder(ap)->ws; bf16_t* P = (bf16_t*)(ws + WS_P); pg8::Gemm g{(const bf16_t*)(ws + WS_OA), (const bf16_t*)(ws + WS_WOA) + (size_t)l * D * 512, 512, 0, nullptr}; pg8::StaticOrder S; S.init(M, D, G, bx);
          pg8::EpiGate<true> E{(bf16_t*)(ws + WS_YA), nullptr, P, C_GZA};
          pg8::gemm_phase<pg8::EpiGate<true>, pg8::StaticOrder, false, true>(lds + RING_OFF, g, S, E); }
        GRID_BAR();
        PROBE_AT(18, WS_YA, (size_t)M * D / 2);
        if (PH(5)) { unsigned char* ws = launder(ap)->ws; bf16_t* P = (bf16_t*)(ws + WS_P); pg8::Gemm g{(const bf16_t*)(ws + WS_OB), (const bf16_t*)(ws + WS_WOB) + (size_t)l * D * 512, 512, 0, nullptr}; pg8::StaticOrder S; S.init(M, D, G, bx);
          pg8::EpiGate<false> E{(bf16_t*)(ws + WS_Y), (const bf16_t*)(ws + WS_YA), P, C_GZB};
          pg8::gemm_phase<pg8::EpiGate<false>, pg8::StaticOrder, false, true>(lds + RING_OFF, g, S, E); }
        GRID_BAR();
        PROBE_AT(19, WS_Y, (size_t)M * D / 2);
        if (PH(6)) row_pass<1>(ap, l, vcu, G);
        if (MK_STOP == 1 || (MK_STOP == 3 && l == 1)) return;
        GRID_BAR();
        if (PH(7)) { const CArgs aq = launder(ap); unsigned char* ws = aq->ws; bf16_t* H = (bf16_t*)(ws + WS_H); pg8::Gemm g{H, (const bf16_t*)(ws + WS_WR) + (size_t)l * 256 * D, D, 0, nullptr}; pg8::StaticOrder S; S.init(M, 256, G, bx);
          pg8::EpiRouter E{(float*)(ws + WS_LOG), aq->in[15] + (size_t)l * NE};
          pg8::gemm_phase<pg8::EpiRouter, pg8::StaticOrder, false, true>(lds + RING_OFF, g, S, E); }
        GRID_BAR();
        if (MK_PROBE == 4 || MK_PROBE == 5) { unsigned char* ws = launder(ap)->ws; unsigned* DIG = (unsigned*)(ws + WS_CTL) + CW_DIG; const unsigned* src = (const unsigned*)(ws + (MK_PROBE == 4 ? WS_LOG : WS_H));
            const int n = MK_PROBE == 4 ? M * NE : M * D / 2; const int t = tid_now(); unsigned sacc = 0u;
            for (int i = blockIdx.x * NWAVES * 64 + t; i < n; i += G * NWAVES * 64) { const unsigned v = src[i]; sacc += (v & 0xffffu) + (v >> 16); }
            __hip_atomic_fetch_add(DIG + (t & 63), sacc, RLX_AGENT); GRID_BAR(); probe_dump(ap); return; }
        if (PH(8)) topk_lists(ap, l, G, LW);
        GRID_BAR();
        if (MK_PROBE == 1) { probe_lists(ap, l, vcu, G); GRID_BAR(); probe_dump(ap); return; }
        { unsigned char* ws = launder(ap)->ws; const int tid = tid_now(); if (tid < NE) LW[LW_CL + tid] = __hip_atomic_load((unsigned*)(ws + WS_CTL) + CW_CNT + l * NE + tid, RLX_AGENT);
          __syncthreads();
          if (tid == 0) { unsigned acc = 0u; for (int e = 0; e < NE; ++e) { LW[LW_TOFF + e] = acc; acc += (LW[LW_CL + e] + 255u) >> 8; } LW[LW_TOFF + NE] = acc; }
          __syncthreads(); }
#pragma unroll 1
        for (int rep = 0; rep < ((MK_DUP & 32) ? 2 : 1); ++rep) {
        if (PH(9)) { const CArgs aq = launder(ap); unsigned char* ws = aq->ws; bf16_t* H = (bf16_t*)(ws + WS_H); pg8::Gemm g{(const bf16_t*)(ws + WS_H8), (const bf16_t*)(ws + WS_WGU + (size_t)l * NE * 2 * FF * D), D / 2, (size_t)2 * FF * D / 2, (const int*)(ws + WS_LIST)};
          pg8::MoeOrder S{(const LAS int*)(lds + LDSCTL_OFF) + LW_TOFF, (const LAS int*)(lds + LDSCTL_OFF) + LW_CL, 2 * FF / 256, G, bx};
          pg8::EpiSwiglu8 E{ws + WS_ACT, aq->in[17] + (size_t)l * NE * 2 * FF};
          pg8::gemm_phase<pg8::EpiSwiglu8, pg8::MoeOrder, true, true, true, PFA_ON>(lds + RING_OFF, g, S, E); }
        GRID_BAR(); }
        if (MK_PROBE == 2) { probe_rows(ap, (const bf16_t*)(launder(ap)->ws + WS_ACT), 0, true, (const LAS int*)(lds + LDSCTL_OFF) + LW_TOFF, (const LAS int*)(lds + LDSCTL_OFF) + LW_CL, vcu, G); GRID_BAR(); probe_dump(ap); return; }
#pragma unroll 1
        for (int rep = 0; rep < ((MK_DUP & 64) ? 2 : 1); ++rep) {
        if (PH(10)) { const CArgs aq = launder(ap); unsigned char* ws = aq->ws; pg8::Gemm g{(const bf16_t*)(ws + WS_ACT), (const bf16_t*)(ws + WS_WD + (size_t)l * NE * D * FF), FF / 2, (size_t)D * FF / 2, nullptr};
          pg8::MoeOrder S{(const LAS int*)(lds + LDSCTL_OFF) + LW_TOFF, (const LAS int*)(lds + LDSCTL_OFF) + LW_CL, D / 256, G, bx};
          pg8::EpiDown8 E{ws + WS_YS, aq->in[19] + (size_t)l * NE * D, (const float*)(ws + WS_LISTW), 1.0f / (F8_SACT * F8_SW)};
#if defined(MK_EPIX)
          if (rep == 0 && (MK_DUP & 64)) { pg8::EpiDownX<MK_EPIX> EX{(bf16_t*)(ws + WS_YS), aq->in[19] + (size_t)l * NE * D, (const float*)(ws + WS_LISTW), 1.0f / (F8_SACT * F8_SW)}; pg8::gemm_phase<pg8::EpiDownX<MK_EPIX>, pg8::MoeOrder, false, true, true>(lds + RING_OFF, g, S, EX); } else
#elif defined(MK_NULLEPI)
          if (rep) { pg8::EpiNull EN; pg8::gemm_phase<pg8::EpiNull, pg8::MoeOrder, false, true, true>(lds + RING_OFF, g, S, EN); } else
#endif
          pg8::gemm_phase<pg8::EpiDown8, pg8::MoeOrder, false, true, true, PFA_ON>(lds + RING_OFF, g, S, E); }
        GRID_BAR(); }
        if (MK_PROBE == 3) { probe_rows(ap, (const bf16_t*)(launder(ap)->ws + WS_YS), M * TOPK, false, nullptr, nullptr, vcu, G); GRID_BAR(); probe_dump(ap); return; }
        if (PH(11)) row_pass<2>(ap, l, vcu, G, (const LAS int*)(lds + LDSCTL_OFF) + LW_TOFF);
        if (MK_STOP == 2) return;
        if (l + 1 < DEPTH) GRID_BAR();
    }
#if MK_TIM
    GRID_BAR();
    { const CArgs aq = launder(ap); const float* x = aq->in[0]; float* out = aq->out; const int t = tid_now();
      const unsigned long long s_ = __hip_atomic_load(&attn_body::g_tim[0], RLX_AGENT), c_ = __hip_atomic_load(&attn_body::g_tim[1], RLX_AGENT);
      float sc = (float)((double)s_ / (double)(c_ ? c_ : 1ull)) * (1.0f / MK_TIM);
#ifdef MK_TIM_Q
      sc = MK_TIM_Q * floorf(sc / MK_TIM_Q + 0.5f);
#endif
      for (size_t i = (size_t)blockIdx.x * NWAVES * 64 + t; i < (size_t)M * D; i += (size_t)G * NWAVES * 64) out[i] = x[i] * sc; }
#endif
}

extern "C" void kernel_launch(void* const* d_in, const int* in_sizes, int n_in, void* d_out, int out_size, void* d_ws, size_t ws_size, hipStream_t stream) {
    static int grid = 0;
    if (grid == 0) {
        if (n_in != 20 || in_sizes[0] != M * D || out_size != M * D || ws_size < WS_END) { fprintf(stderr, "kernel_launch: unexpected shapes (n_in %d, in0 %d, out %d, ws %zu < %zu); nothing launched\n", n_in, n_in > 0 ? in_sizes[0] : -1, out_size, ws_size, (size_t)WS_END); grid = -1; return; }
        int dev = 0, cus = 0, per_cu = 0;
        if (hipGetDevice(&dev) != hipSuccess || hipDeviceGetAttribute(&cus, hipDeviceAttributeMultiprocessorCount, dev) != hipSuccess) { grid = -1; return; }
        if (hipFuncSetAttribute((const void*)mk_fwd, hipFuncAttributeMaxDynamicSharedMemorySize, LDS_BYTES) != hipSuccess) { fprintf(stderr, "kernel_launch: hipFuncSetAttribute failed\n"); grid = -1; return; }
        if (hipOccupancyMaxActiveBlocksPerMultiprocessor(&per_cu, (const void*)mk_fwd, NWAVES * 64, LDS_BYTES) != hipSuccess || per_cu < 1)
            fprintf(stderr, "kernel_launch: note: occupancy query reports %d workgroups per CU\n", per_cu);
        (void)hipGetLastError();
        grid = cus > 256 ? 256 : cus;
    }
    if (grid < 0) return;
    if (hipMemsetAsync((char*)d_ws + WS_CTL, 0, CTL_ZERO_BYTES, stream) != hipSuccess) return;
    Args a{};
    for (int i = 0; i < 20; ++i) a.in[i] = (const float*)d_in[i];
    a.out = (float*)d_out; a.ws = (unsigned char*)d_ws;
    hipLaunchKernelGGL(mk_fwd, dim3(grid), dim3(NWAVES * 64), LDS_BYTES, stream, a);
}
```
